# Optimizing an MI355X kernel written in HIP

```python
import math
import jax, jax.numpy as jnp
from jax import lax
import numpy as np

D_MODEL = 2048
BATCH = 4
SEQ = 4096
DEPTH = 2

MIX_WIDTH = D_MODEL
HEAD_DIM = 128
ROPE_DIM = HEAD_DIM // 4
ROPE_THETA = 500000.0
EPS = 1e-6

MOBA_HEADS = 4
MOBA_WIDTH = MOBA_HEADS * HEAD_DIM
MOBA_BLOCK = 256
MOBA_TOPK = 3
MOBA_Q_CHUNK = 32

NSA_HEADS = 4
NSA_WIDTH = NSA_HEADS * HEAD_DIM
NSA_KV_WIDTH = HEAD_DIM
NSA_CMP_LEN = 32
NSA_CMP_STRIDE = 16
NSA_SEL_BLOCK = 64
NSA_SEL_TOPN = 16
NSA_WINDOW = 512
NSA_Q_CHUNK = 64

S5_WIDTH = 1024
S5_GROUP = 16
S5_GROUPS = S5_WIDTH // S5_GROUP
S5_STATE = 64

IN_SPLITS = (MOBA_WIDTH, MOBA_WIDTH, MOBA_WIDTH, MOBA_WIDTH,
             NSA_WIDTH,
             NSA_KV_WIDTH, NSA_KV_WIDTH, NSA_KV_WIDTH, NSA_KV_WIDTH,
             NSA_KV_WIDTH, NSA_KV_WIDTH,
             NSA_HEADS * 3, NSA_WIDTH,
             S5_WIDTH, S5_WIDTH)
IN_WIDTH = 4 * MOBA_WIDTH + 2 * NSA_WIDTH + 6 * NSA_KV_WIDTH + NSA_HEADS * 3 + 2 * S5_WIDTH

kernel_name = "hybrid_moba_nsa_s5_parallel_heads"


def rms_norm(x, w):
    xf = x.astype(jnp.float32)
    y = xf * lax.rsqrt(jnp.mean(xf * xf, axis=-1, keepdims=True) + EPS)
    return (y * w.astype(jnp.float32)).astype(x.dtype)


def rope_tables(pos):
    inv = ROPE_THETA ** (-jnp.arange(0, ROPE_DIM, 2, dtype=jnp.float32) / ROPE_DIM)
    ang = pos.astype(jnp.float32)[:, None] * inv[None, :]
    return jnp.cos(ang), jnp.sin(ang)


def apply_rope(x, cos, sin):
    half = ROPE_DIM // 2
    x1, x2, xp = x[..., :half], x[..., half:ROPE_DIM], x[..., ROPE_DIM:]
    c, s = cos.astype(x.dtype), sin.astype(x.dtype)
    return jnp.concatenate([x1 * c - x2 * s, x2 * c + x1 * s, xp], axis=-1)


def moba_attention(q, k, v):
    b, h, s, dh = q.shape
    nb = -(-s // MOBA_BLOCK)
    pad = nb * MOBA_BLOCK - s
    kp = jnp.pad(k, ((0, 0), (0, 0), (0, pad), (0, 0)))
    vp = jnp.pad(v, ((0, 0), (0, 0), (0, pad), (0, 0)))
    kb = kp.reshape(b, h, nb, MOBA_BLOCK, dh)
    vb = vp.reshape(b, h, nb, MOBA_BLOCK, dh)
    k_mean = jnp.mean(kb.astype(jnp.float32), axis=3)
    topk = min(MOBA_TOPK, nb)
    n_sel = topk * MOBA_BLOCK
    scale = dh ** -0.5
    bi = jnp.arange(b)[:, None, None, None]
    hi = jnp.arange(h)[None, :, None, None]
    blk = jnp.arange(nb)

    def chunk(c):
        start = c * MOBA_Q_CHUNK
        t = start + jnp.arange(MOBA_Q_CHUNK)
        own = start // MOBA_BLOCK
        qc = lax.dynamic_slice_in_dim(q, start, MOBA_Q_CHUNK, axis=2)
        gate = jnp.einsum('bhqd,bhnd->bhqn', qc.astype(jnp.float32), k_mean)
        gate = jnp.where(blk < own, gate, -jnp.inf)
        _, idx = lax.top_k(gate, topk)
        keep = idx < own
        k_sel = kb[bi, hi, idx]
        v_sel = vb[bi, hi, idx]
        s_sel = jnp.einsum('bhqd,bhqnkd->bhqnk', qc, k_sel).astype(jnp.float32) * scale
        s_sel = jnp.where(keep[..., None], s_sel, -jnp.inf).reshape(b, h, MOBA_Q_CHUNK, n_sel)
        k_own = lax.dynamic_slice_in_dim(kp, own * MOBA_BLOCK, MOBA_BLOCK, axis=2)
        v_own = lax.dynamic_slice_in_dim(vp, own * MOBA_BLOCK, MOBA_BLOCK, axis=2)
        s_own = jnp.einsum('bhqd,bhkd->bhqk', qc, k_own).astype(jnp.float32) * scale
        kpos = own * MOBA_BLOCK + jnp.arange(MOBA_BLOCK)
        s_own = jnp.where(kpos[None, :] <= t[:, None], s_own, -jnp.inf)
        p = jax.nn.softmax(jnp.concatenate([s_sel, s_own], axis=-1), axis=-1).astype(v.dtype)
        p_sel = p[..., :n_sel].reshape(b, h, MOBA_Q_CHUNK, topk, MOBA_BLOCK)
        return (jnp.einsum('bhqnk,bhqnkd->bhqd', p_sel, v_sel)
                + jnp.einsum('bhqk,bhkd->bhqd', p[..., n_sel:], v_own))

    out = lax.map(chunk, jnp.arange(s // MOBA_Q_CHUNK))
    return out.transpose(1, 2, 0, 3, 4).reshape(b, h, s, dh)


def nsa_attention(q, kc_tok, vc_tok, ks, vs, kw, vw, gates, kc_norm, pe_k, pe_v,
                  ck_w1, ck_w2, cv_w1, cv_w2):
    b, h, s, dh = q.shape
    scale = dh ** -0.5
    t_all = jnp.arange(s)
    n_cmp = (s - NSA_CMP_LEN) // NSA_CMP_STRIDE + 1
    tok = np.arange(n_cmp)[:, None] * NSA_CMP_STRIDE + np.arange(NSA_CMP_LEN)[None, :]
    end = tok[:, -1]

    def compress(x_tok, pe, w1, w2):
        blocks = (x_tok[:, tok] + pe).reshape(b, n_cmp, NSA_CMP_LEN * dh)
        return jax.nn.gelu(blocks @ w1) @ w2

    k_cmp = compress(kc_tok, pe_k, ck_w1, ck_w2)
    v_cmp = compress(vc_tok, pe_v, cv_w1, cv_w2)
    cos_c, sin_c = rope_tables(jnp.asarray(end, jnp.float32))
    k_cmp = apply_rope(rms_norm(k_cmp, kc_norm), cos_c, sin_c)
    valid = jnp.asarray(end)[None, :] <= t_all[:, None]
    s_cmp = jnp.einsum('bhsd,bnd->bhsn', q, k_cmp).astype(jnp.float32) * scale
    p_cmp = jax.nn.softmax(jnp.where(valid, s_cmp, jnp.float32(-1e30)), axis=-1)
    p_cmp = jnp.where(valid, p_cmp, 0.0)
    o_cmp = jnp.einsum('bhsn,bnd->bhsd', p_cmp.astype(v_cmp.dtype), v_cmp)
    n_sel = s // NSA_SEL_BLOCK
    ci = np.arange(n_cmp)[:, None] * NSA_CMP_STRIDE
    sj = np.arange(n_sel)[None, :] * NSA_SEL_BLOCK
    overlap = ((ci < sj + NSA_SEL_BLOCK) & (ci + NSA_CMP_LEN > sj)).astype(np.float32)
    imp = jnp.einsum('bhsn,nj->bsj', p_cmp, jnp.asarray(overlap))
    n_top = min(NSA_SEL_TOPN, n_sel)
    ks_b = ks.reshape(b, n_sel, NSA_SEL_BLOCK, dh)
    vs_b = vs.reshape(b, n_sel, NSA_SEL_BLOCK, dh)
    kw_pad = jnp.pad(kw, ((0, 0), (NSA_WINDOW, 0), (0, 0)))
    vw_pad = jnp.pad(vw, ((0, 0), (NSA_WINDOW, 0), (0, 0)))
    bi = jnp.arange(b)[:, None, None]
    sel_ids = jnp.arange(n_sel)[None, :]

    def chunk(c):
        start = c * NSA_Q_CHUNK
        t = start + jnp.arange(NSA_Q_CHUNK)
        qc = lax.dynamic_slice_in_dim(q, start, NSA_Q_CHUNK, axis=2)
        cur = (t // NSA_SEL_BLOCK)[:, None]
        score = lax.dynamic_slice_in_dim(imp, start, NSA_Q_CHUNK, axis=1)
        score = jnp.where(sel_ids <= cur, score, -jnp.inf)
        forced = (sel_ids == 0) | (sel_ids == cur) | (sel_ids == cur - 1)
        score = jnp.where(forced, jnp.inf, score)
        _, idx = lax.top_k(score, n_top)
        kpos = idx[..., None] * NSA_SEL_BLOCK + jnp.arange(NSA_SEL_BLOCK)
        smask = kpos <= t[None, :, None, None]
        k_g = ks_b[bi, idx]
        v_g = vs_b[bi, idx]
        s_sel = jnp.einsum('bhqd,bqnkd->bhqnk', qc, k_g).astype(jnp.float32) * scale
        s_sel = jnp.where(smask[:, None], s_sel, -jnp.inf).reshape(b, h, NSA_Q_CHUNK, n_top * NSA_SEL_BLOCK)
        p_sel = jax.nn.softmax(s_sel, axis=-1).astype(vs.dtype).reshape(b, h, NSA_Q_CHUNK, n_top, NSA_SEL_BLOCK)
        o_sel = jnp.einsum('bhqnk,bqnkd->bhqd', p_sel, v_g)
        k_win = lax.dynamic_slice_in_dim(kw_pad, start, NSA_WINDOW + NSA_Q_CHUNK, axis=1)
        v_win = lax.dynamic_slice_in_dim(vw_pad, start, NSA_WINDOW + NSA_Q_CHUNK, axis=1)
        wpos = start - NSA_WINDOW + jnp.arange(NSA_WINDOW + NSA_Q_CHUNK)
        wmask = ((wpos[None, :] <= t[:, None]) & (wpos[None, :] > t[:, None] - NSA_WINDOW)
                 & (wpos[None, :] >= 0))
        s_win = jnp.einsum('bhqd,bkd->bhqk', qc, k_win).astype(jnp.float32) * scale
        p_win = jax.nn.softmax(jnp.where(wmask, s_win, -jnp.inf), axis=-1).astype(vw.dtype)
        o_win = jnp.einsum('bhqk,bkd->bhqd', p_win, v_win)
        return o_sel, o_win

    o_sel, o_win = lax.map(chunk, jnp.arange(s // NSA_Q_CHUNK))
    o_sel = o_sel.transpose(1, 2, 0, 3, 4).reshape(b, h, s, dh)
    o_win = o_win.transpose(1, 2, 0, 3, 4).reshape(b, h, s, dh)
    g = gates.astype(q.dtype)
    return g[..., 0:1] * o_cmp + g[..., 1:2] * o_sel + g[..., 2:3] * o_win


def _complex_affine_combine(e1, e2):
    a1r, a1i, b1r, b1i = e1
    a2r, a2i, b2r, b2i = e2
    return (a2r * a1r - a2i * a1i,
            a2r * a1i + a2i * a1r,
            a2r * b1r - a2i * b1i + b2r,
            a2r * b1i + a2i * b1r + b2i)


def s5_ssm(u, a_re, a_im, b_re, b_im, c_re, c_im, d, log_dt):
    bsz, s, _ = u.shape
    uf = u.astype(jnp.float32)
    ug = uf.reshape(bsz, s, S5_GROUPS, S5_GROUP)
    dt = jnp.exp(log_dt.astype(jnp.float32))[:, None]
    ar, ai = a_re.astype(jnp.float32), a_im.astype(jnp.float32)
    mag = jnp.exp(dt * ar)
    ang = dt * ai
    abar_r, abar_i = mag * jnp.cos(ang), mag * jnp.sin(ang)
    nr, ni = abar_r - 1.0, abar_i
    den = ar * ar + ai * ai
    fr = (nr * ar + ni * ai) / den
    fi = (ni * ar - nr * ai) / den
    br, bim = b_re.astype(jnp.float32), b_im.astype(jnp.float32)
    bbar_r = fr[..., None] * br - fi[..., None] * bim
    bbar_i = fr[..., None] * bim + fi[..., None] * br
    bu_r = jnp.einsum('bsgc,gpc->sbgp', ug, bbar_r)
    bu_i = jnp.einsum('bsgc,gpc->sbgp', ug, bbar_i)
    a_r = jnp.broadcast_to(abar_r, (s, 1, S5_GROUPS, S5_STATE))
    a_i = jnp.broadcast_to(abar_i, (s, 1, S5_GROUPS, S5_STATE))
    _, _, x_r, x_i = lax.associative_scan(_complex_affine_combine, (a_r, a_i, bu_r, bu_i), axis=0)
    y = (jnp.einsum('sbgp,gcp->bsgc', x_r, c_re.astype(jnp.float32))
         - jnp.einsum('sbgp,gcp->bsgc', x_i, c_im.astype(jnp.float32)))
    y = y.reshape(bsz, s, S5_WIDTH) + d.astype(jnp.float32) * uf
    return y.astype(u.dtype)


def hybrid_layer(x, norm_w, w_in, w_out, moba_q_norm, moba_k_norm, nsa_q_norm, nsa_kc_norm,
                 nsa_ks_norm, nsa_kw_norm, nsa_pe_k, nsa_pe_v, nsa_cmp_k_w1, nsa_cmp_k_w2,
                 nsa_cmp_v_w1, nsa_cmp_v_w2, s5_a_re, s5_a_im, s5_b_re, s5_b_im, s5_c_re, s5_c_im,
                 s5_d, s5_log_dt, s5_glu_w):
    b, s, _ = x.shape
    hdn = rms_norm(x, norm_w)
    proj = hdn @ w_in
    offsets = np.cumsum(IN_SPLITS)[:-1].tolist()
    (mq, mk, mv, mz, nq, nkc, nvc, nks, nvs, nkw, nvw, ng, nz, su, sz) = jnp.split(proj, offsets, axis=-1)
    cos, sin = rope_tables(jnp.arange(s, dtype=jnp.float32))

    def heads(t, n):
        return t.reshape(b, s, n, HEAD_DIM).transpose(0, 2, 1, 3)

    mq = apply_rope(rms_norm(heads(mq, MOBA_HEADS), moba_q_norm), cos, sin)
    mk = apply_rope(rms_norm(heads(mk, MOBA_HEADS), moba_k_norm), cos, sin)
    o_moba = moba_attention(mq, mk, heads(mv, MOBA_HEADS))
    o_moba = o_moba.transpose(0, 2, 1, 3).reshape(b, s, MOBA_WIDTH)
    nq = apply_rope(rms_norm(heads(nq, NSA_HEADS), nsa_q_norm), cos, sin)
    nks = apply_rope(rms_norm(nks, nsa_ks_norm), cos, sin)
    nkw = apply_rope(rms_norm(nkw, nsa_kw_norm), cos, sin)
    gates = jax.nn.sigmoid(ng).reshape(b, s, NSA_HEADS, 3).transpose(0, 2, 1, 3)
    o_nsa = nsa_attention(nq, nkc, nvc, nks, nvs, nkw, nvw, gates, nsa_kc_norm, nsa_pe_k, nsa_pe_v,
                          nsa_cmp_k_w1, nsa_cmp_k_w2, nsa_cmp_v_w1, nsa_cmp_v_w2)
    o_nsa = o_nsa.transpose(0, 2, 1, 3).reshape(b, s, NSA_WIDTH)
    y5 = jax.nn.gelu(s5_ssm(su, s5_a_re, s5_a_im, s5_b_re, s5_b_im, s5_c_re, s5_c_im, s5_d, s5_log_dt))
    o_s5 = y5 * jax.nn.sigmoid(y5 @ s5_glu_w)
    mixed = jnp.concatenate([o_moba * jax.nn.silu(mz), o_nsa * jax.nn.silu(nz), o_s5 * jax.nn.silu(sz)], axis=-1)
    return x + mixed @ w_out


def setup_inputs(seed: int = 0) -> dict:
    key = jax.random.key(seed)
    k = jax.random.split(key, 32)
    f32 = jnp.float32
    L = DEPTH

    def nrm(kk, shape, scale):
        return scale * jax.random.normal(kk, shape, f32)

    n_idx = jnp.arange(S5_STATE, dtype=f32)[None, None, :]
    return {
        "x": jax.random.normal(k[0], (BATCH, SEQ, D_MODEL), f32),
        "norm_w": 1.0 + nrm(k[1], (L, D_MODEL), 0.02),
        "w_in": nrm(k[2], (L, D_MODEL, IN_WIDTH), D_MODEL ** -0.5),
        "w_out": nrm(k[3], (L, MIX_WIDTH, D_MODEL), MIX_WIDTH ** -0.5),
        "moba_q_norm": 1.0 + nrm(k[4], (L, HEAD_DIM), 0.02),
        "moba_k_norm": 1.0 + nrm(k[5], (L, HEAD_DIM), 0.02),
        "nsa_q_norm": 1.0 + nrm(k[6], (L, HEAD_DIM), 0.02),
        "nsa_kc_norm": 1.0 + nrm(k[7], (L, HEAD_DIM), 0.02),
        "nsa_ks_norm": 1.0 + nrm(k[8], (L, HEAD_DIM), 0.02),
        "nsa_kw_norm": 1.0 + nrm(k[9], (L, HEAD_DIM), 0.02),
        "nsa_pe_k": nrm(k[10], (L, NSA_CMP_LEN, HEAD_DIM), 0.1),
        "nsa_pe_v": nrm(k[11], (L, NSA_CMP_LEN, HEAD_DIM), 0.1),
        "nsa_cmp_k_w1": nrm(k[12], (L, NSA_CMP_LEN * HEAD_DIM, HEAD_DIM), (NSA_CMP_LEN * HEAD_DIM) ** -0.5),
        "nsa_cmp_k_w2": nrm(k[13], (L, HEAD_DIM, HEAD_DIM), HEAD_DIM ** -0.5),
        "nsa_cmp_v_w1": nrm(k[14], (L, NSA_CMP_LEN * HEAD_DIM, HEAD_DIM), (NSA_CMP_LEN * HEAD_DIM) ** -0.5),
        "nsa_cmp_v_w2": nrm(k[15], (L, HEAD_DIM, HEAD_DIM), HEAD_DIM ** -0.5),
        "s5_a_re": -0.5 * jnp.exp(nrm(k[16], (L, S5_GROUPS, S5_STATE), 0.01)),
        "s5_a_im": math.pi * n_idx + nrm(k[17], (L, S5_GROUPS, S5_STATE), 0.01),
        "s5_b_re": nrm(k[18], (L, S5_GROUPS, S5_STATE, S5_GROUP), (2 * S5_GROUP) ** -0.5),
        "s5_b_im": nrm(k[19], (L, S5_GROUPS, S5_STATE, S5_GROUP), (2 * S5_GROUP) ** -0.5),
        "s5_c_re": nrm(k[20], (L, S5_GROUPS, S5_GROUP, S5_STATE), S5_STATE ** -0.5),
        "s5_c_im": nrm(k[21], (L, S5_GROUPS, S5_GROUP, S5_STATE), S5_STATE ** -0.5),
        "s5_d": nrm(k[22], (L, S5_WIDTH), 1.0),
        "s5_log_dt": jax.random.uniform(k[23], (L, S5_GROUPS), f32, math.log(0.001), math.log(0.1)),
        "s5_glu_w": nrm(k[24], (L, S5_WIDTH, S5_WIDTH), S5_WIDTH ** -0.5),
    }


def reference(x, norm_w, w_in, w_out, moba_q_norm, moba_k_norm, nsa_q_norm, nsa_kc_norm,
              nsa_ks_norm, nsa_kw_norm, nsa_pe_k, nsa_pe_v, nsa_cmp_k_w1, nsa_cmp_k_w2,
              nsa_cmp_v_w1, nsa_cmp_v_w2, s5_a_re, s5_a_im, s5_b_re, s5_b_im, s5_c_re, s5_c_im,
              s5_d, s5_log_dt, s5_glu_w):
    for l in range(DEPTH):
        x = hybrid_layer(x, norm_w[l], w_in[l], w_out[l], moba_q_norm[l], moba_k_norm[l],
                         nsa_q_norm[l], nsa_kc_norm[l], nsa_ks_norm[l], nsa_kw_norm[l],
                         nsa_pe_k[l], nsa_pe_v[l], nsa_cmp_k_w1[l], nsa_cmp_k_w2[l],
                         nsa_cmp_v_w1[l], nsa_cmp_v_w2[l], s5_a_re[l], s5_a_im[l], s5_b_re[l],
                         s5_b_im[l], s5_c_re[l], s5_c_im[l], s5_d[l], s5_log_dt[l], s5_glu_w[l])
    return x
```

```cpp
#include <hip/hip_runtime.h>
#include <stdint.h>
#include <cstdio>

typedef unsigned short bf16;
typedef short bf16x8 __attribute__((ext_vector_type(8)));
typedef float f32x4 __attribute__((ext_vector_type(4)));
typedef unsigned u32x4 __attribute__((ext_vector_type(4)));
typedef unsigned u32x2 __attribute__((ext_vector_type(2)));
#define LAS __attribute__((address_space(3)))
__device__ __forceinline__ int otid() { int t = threadIdx.x; asm volatile("" : "+v"(t)); return t; }

constexpr int NB = 4, SEQ = 4096, DM = 2048, NT = NB * SEQ, NL = 2;
constexpr int INW = 5900;
constexpr int NP = 5888;
constexpr int O_MQ = 0, O_MK = 512, O_MV = 1024, O_MZ = 1536, O_NQ = 2048, O_KC = 2560, O_VC = 2688, O_KS = 2816, O_VS = 2944,
              O_KW = 3072, O_VW = 3200, O_NZ = 3328, O_SU = 3840, O_SZ = 4864;
constexpr int SRC_NG = 3328;
constexpr int NCMP = 255;
constexpr float EPSN = 1e-6f;
constexpr float SCALE = 0.08838834764831845f;

constexpr size_t MiB = 1u << 20;
constexpr size_t WS_CTL = 0;
constexpr size_t WS_WIN = 1 * MiB;
constexpr size_t WIN_BYTES = (size_t)NP * DM * 2;
constexpr size_t WS_WOUT = WS_WIN + 2 * WIN_BYTES;
constexpr size_t WOUT_BYTES = (size_t)DM * DM * 2;
constexpr size_t WS_GLU = WS_WOUT + 2 * WOUT_BYTES;
constexpr size_t GLU_BYTES = (size_t)1024 * 1024 * 2;
constexpr size_t WS_XB = WS_GLU + 2 * GLU_BYTES;
constexpr size_t WS_PROJ = WS_XB + (size_t)NT * DM * 2;
constexpr size_t WS_MIXED = WS_PROJ + (size_t)NT * NP * 2;
constexpr size_t WS_Y5 = WS_MIXED + (size_t)NT * DM * 2;
constexpr size_t WS_SSQP = WS_Y5 + (size_t)NT * 1024 * 2;
constexpr size_t WS_GATES = WS_SSQP + (size_t)NT * 32 * 4;
constexpr size_t WS_ROPE = WS_GATES + 1 * MiB;
constexpr size_t WS_RS = WS_ROPE + 512 * 1024;
constexpr size_t WS_KMEAN = WS_ROPE + 1 * MiB;
constexpr size_t WS_CMP = WS_KMEAN + 1 * MiB;
constexpr size_t WS_HID = WS_CMP + 1 * MiB;
constexpr size_t WS_CMPB = WS_HID + 1 * MiB;
constexpr size_t WS_ORDER = WS_CMPB + 1 * MiB;
constexpr size_t WS_S5K = WS_ORDER + 1 * MiB;
constexpr size_t WS_S5P1 = WS_S5K + 5 * MiB;
constexpr size_t WS_S5P2 = WS_S5P1 + 32 * MiB;
constexpr size_t WS_S5AL = WS_S5P2 + 32 * MiB;
constexpr size_t WS_W1F = WS_S5AL + 1 * MiB;
constexpr size_t WS_CST = WS_W1F + 4 * MiB;
constexpr size_t WS_WGF = WS_CST + 1 * MiB;
constexpr size_t WS_W2F = WS_WGF + 1 * MiB;
constexpr size_t WS_END = WS_W2F + 1 * MiB;
static_assert(WS_END <= 536870912ull, "workspace map exceeds 512 MiB");
constexpr size_t SUG_OFF = (size_t)256 * 256 * 128;

__device__ const double INVF[16] = {1.0, 0.44036660267178046, 0.19392274474868576, 0.08539710028576561, 0.03760603093086393,
    0.016560440080994446, 0.007292664737217109, 0.003211445994752591, 0.001414213562373095, 0.000622772421914596,
    0.0002742481756762073, 0.00012076973741146504, 5.318295896944988e-05, 2.341999896140934e-05, 1.031338537721246e-05,
    4.5416704806078695e-06};

__device__ __forceinline__ void dsincos(double a, double& s, double& c) {
    const double k = rint(a * 0.63661977236758134308);
    double r = fma(-k, 1.57079632679489655800e+00, a);
    r = fma(-k, 6.12323399573676603587e-17, r);
    const double r2 = r * r;
    double sp = 1.0 / 6227020800.0;
    sp = fma(sp, r2, -1.0 / 39916800.0); sp = fma(sp, r2, 1.0 / 362880.0); sp = fma(sp, r2, -1.0 / 5040.0);
    sp = fma(sp, r2, 1.0 / 120.0); sp = fma(sp, r2, -1.0 / 6.0); sp = fma(sp, r2, 1.0);
    const double sn = sp * r;
    double cp = -1.0 / 87178291200.0;
    cp = fma(cp, r2, 1.0 / 479001600.0); cp = fma(cp, r2, -1.0 / 3628800.0); cp = fma(cp, r2, 1.0 / 40320.0);
    cp = fma(cp, r2, -1.0 / 720.0); cp = fma(cp, r2, 1.0 / 24.0); cp = fma(cp, r2, -0.5); cp = fma(cp, r2, 1.0);
    const long long q = (long long)k & 3;
    if (q == 0) { s = sn; c = cp; } else if (q == 1) { s = cp; c = -sn; } else if (q == 2) { s = -sn; c = -cp; } else { s = -cp; c = sn; }
}
__device__ __forceinline__ float wave_sum(float v) {
#pragma unroll
    for (int o = 1; o < 64; o <<= 1) v += __shfl_xor(v, o);
    return v;
}
__device__ __forceinline__ float wave_max(float v) {
#pragma unroll
    for (int o = 1; o < 64; o <<= 1) v = fmaxf(v, __shfl_xor(v, o));
    return v;
}
__device__ __forceinline__ float sigmoidf_(float x) { return __builtin_amdgcn_rcpf(1.0f + __builtin_amdgcn_exp2f(-1.4426950408889634f * x)); }
__device__ __forceinline__ float siluf_(float x) { return x * sigmoidf_(x); }
__device__ __forceinline__ float geluf_(float x) { return x * sigmoidf_(1.5957691216057308f * (x + 0.044715f * x * x * x)); }
__device__ __forceinline__ float bf2f(bf16 b) { return __uint_as_float((unsigned)b << 16); }
__device__ __forceinline__ unsigned f2bf(float f) { const unsigned u = __float_as_uint(f); return (u + 0x7fffu + ((u >> 16) & 1u)) >> 16; }
__device__ __forceinline__ unsigned pk2(float lo, float hi) { return f2bf(lo) | (f2bf(hi) << 16); }
__device__ __forceinline__ float2 ld2(const bf16* p, int lane) { const unsigned w = ((const unsigned*)p)[lane]; return make_float2(__uint_as_float(w << 16), __uint_as_float(w & 0xffff0000u)); }

namespace pg8 {
constexpr int BM = 256, BK = 64, HALF = 128, HTB = HALF * BK * 2, STAGE_BYTES = 8 * HTB, NXCD = 8, WGM = 8;
__host__ __device__ __forceinline__ int lds_byte(int r, int c) { const int st = (r >> 4) * 2 + (c >> 5), rr = r & 15, cc = c & 31, ob = rr * 64 + cc * 2; return st * 1024 + (ob ^ (((ob >> 9) & 1) << 5)); }
__host__ __device__ __forceinline__ void stage_rc(int b, int& R, int& C) { const int st = b / 1024, sb = b % 1024, swz = sb ^ (((sb >> 9) & 1) << 5); R = (st >> 1) * 16 + swz / 64; C = (st & 1) * 32 + (swz % 64) / 2; }
__host__ __device__ __forceinline__ int perm32(int rho) { const int n = rho >> 4, i = rho & 15; return 8 * (i >> 2) + 4 * n + (i & 3); }
struct Unit { int pm, pn; };
struct Gemm { const bf16* A; const bf16* Bt; int M, N, K, lda; };
struct StaticOrder {
    int nM, nN, nwg, G, c, permN;
    __host__ __device__ void init(int M, int N, int G_, int c_, int permN_ = 0) { nM = M / BM; nN = N / BM; nwg = nM * nN; G = G_; c = c_; permN = permN_; }
    __host__ __device__ bool next(int i, Unit& u) const {
        const long L = (long)i * G + c; if (L >= nwg) return false;
        int wgid = (int)L; { const int q = nwg / NXCD, r = nwg % NXCD, xcd = wgid % NXCD, off = wgid / NXCD; wgid = (xcd < r ? xcd * (q + 1) : r * (q + 1) + (xcd - r) * q) + off; }
        const int nig = WGM * nN, gid = wgid / nig, fm = gid * WGM, gsz = (nM - fm) < WGM ? (nM - fm) : WGM;
        u.pm = fm + ((wgid % nig) % gsz); u.pn = (wgid % nig) / gsz;
        if (permN) u.pn = (int)((u.pn < 12 ? (0x14dc50c9a403169ull >> (5 * u.pn)) : (0x5a2a456071d1e6ull >> (5 * (u.pn - 12)))) & 31ull);
        return true;
    }
};
__device__ __forceinline__ unsigned cvt_pk_bf16(float lo, float hi) { unsigned r; asm volatile("v_cvt_pk_bf16_f32 %0, %1, %2" : "=v"(r) : "v"(lo), "v"(hi)); return r; }

template <class Epi, class Sched>
__device__ __forceinline__ void gemm_phase(LAS unsigned char* lds, const Gemm g, const Sched& S, const Epi& E) {
    constexpr bool ALIGN_EPI = true;
    const int tid = otid(), wid = __builtin_amdgcn_readfirstlane(tid >> 6), lane = tid & 63, wr = wid >> 2, wc = wid & 3, fr = lane & 15, fq = lane >> 4;
    const int K = g.K, nt = K / BK;
    unsigned voffA[2], voffB[2];
#pragma unroll
    for (int i = 0; i < 2; ++i) { int R, C; stage_rc(tid * 16 + i * 8192, R, C); const int Rb = Epi::PERM ? ((R & ~31) + perm32(R & 31)) : R;
        voffA[i] = (unsigned)(R * g.lda + C) * 2u; voffB[i] = (unsigned)(Rb * K + C) * 2u; }
    const size_t kstep = (size_t)(BK * 2);
    const size_t hstepA = (size_t)HALF * g.lda * 2, hstepB = (size_t)HALF * K * 2;
    const size_t tstepA = 2 * hstepA, tstepB = 2 * hstepB;
    const unsigned ldsw = (unsigned)wid * 1024u;
    const int aoff = lds_byte(wr * 64 + fr, fq * 8), boff = lds_byte(wc * 32 + fr, fq * 8);
#define PG8_SA(b, h) (((b) * 2 + (h)) * HTB)
#define PG8_SB(b, h) ((4 + (b) * 2 + (h)) * HTB)
#define PG8_STAGE(bufoff, gbase, voff) do { _Pragma("unroll") for (int _i = 0; _i < 2; ++_i) \
        __builtin_amdgcn_global_load_lds((const unsigned*)((const char*)(gbase) + (voff)[_i]), (LAS unsigned*)(lds + (bufoff) + ldsw + _i * 8192), 16, 0, 0); } while (0)
#define PG8_LDA(dst, b, h) do { _Pragma("unroll") for (int m = 0; m < 4; ++m) _Pragma("unroll") for (int k = 0; k < 2; ++k) dst[m][k] = *(const LAS bf16x8*)(lds + PG8_SA(b, h) + aoff + m * 2048 + k * 1024); } while (0)
#define PG8_LDB(dst, b, h) do { _Pragma("unroll") for (int n = 0; n < 2; ++n) _Pragma("unroll") for (int k = 0; k < 2; ++k) dst[n][k] = *(const LAS bf16x8*)(lds + PG8_SB(b, h) + boff + n * 2048 + k * 1024); } while (0)
#define PG8_MMA(ai, bj, At, Bt) do { __builtin_amdgcn_s_setprio(1); _Pragma("unroll") for (int m = 0; m < 4; ++m) _Pragma("unroll") for (int n = 0; n < 2; ++n) _Pragma("unroll") for (int k = 0; k < 2; ++k) \
        acc[ai][bj][m][n] = __builtin_amdgcn_mfma_f32_16x16x32_bf16(Bt[n][k], At[m][k], acc[ai][bj][m][n], 0, 0, 0); __builtin_amdgcn_s_setprio(0); } while (0)
#define PG8_WAIT_V(n) asm volatile("s_waitcnt vmcnt(" #n ")" ::: "memory")
#define PG8_WAIT_L(n) asm volatile("s_waitcnt lgkmcnt(" #n ")" ::: "memory")
#define PG8_BAR __builtin_amdgcn_s_barrier()
#define PG8_SCHED __builtin_amdgcn_sched_barrier(0)
    Unit cur, nxt; int ui = 0;
    if (!S.next(0, cur)) return;
    typename Epi::Pre pre = E.pre(cur, wr), pren = pre;
    f32x4 acc[2][2][4][2];
#pragma unroll
    for (int a = 0; a < 2; ++a)
#pragma unroll
        for (int b = 0; b < 2; ++b)
#pragma unroll
            for (int m = 0; m < 4; ++m)
#pragma unroll
                for (int n = 0; n < 2; ++n) acc[a][b][m][n] = (f32x4){0.f, 0.f, 0.f, 0.f};
    bf16x8 At[4][2], B0[2][2], B1[2][2];
    const char* cA = (const char*)g.A + (size_t)cur.pm * tstepA; const char* cB = (const char*)g.Bt + (size_t)cur.pn * tstepB;
    PG8_STAGE(PG8_SB(0, 0), cB, voffB); PG8_STAGE(PG8_SB(0, 1), cB + hstepB, voffB); PG8_STAGE(PG8_SA(0, 0), cA, voffA); PG8_STAGE(PG8_SA(0, 1), cA + hstepA, voffA);
    if (wr == 1) PG8_BAR;
    PG8_WAIT_V(2); PG8_BAR;
    PG8_STAGE(PG8_SB(1, 0), cB + kstep, voffB); PG8_STAGE(PG8_SA(1, 0), cA + kstep, voffA); PG8_STAGE(PG8_SB(1, 1), cB + hstepB + kstep, voffB);
    PG8_WAIT_V(6); PG8_BAR;
    for (;;) {
        const bool has_next = S.next(ui + 1, nxt);
        const char* nA = has_next ? (const char*)g.A + (size_t)nxt.pm * tstepA : cA; const char* nB = has_next ? (const char*)g.Bt + (size_t)nxt.pn * tstepB : cB;
        for (int t = 0; t < nt; t += 2) {
            const bool last = (t == nt - 2);
            const char* a1 = cA + (size_t)(t + 1) * kstep;
            const char* a2 = last ? nA : cA + (size_t)(t + 2) * kstep; const char* b2 = last ? nB : cB + (size_t)(t + 2) * kstep;
            const char* a3 = a2 + kstep; const char* b3 = b2 + kstep;
            PG8_LDB(B0, 0, 0); PG8_LDB(B1, 0, 1); PG8_SCHED; PG8_LDA(At, 0, 0); PG8_STAGE(PG8_SA(1, 1), a1 + hstepA, voffA);
            PG8_WAIT_V(8); PG8_WAIT_L(0); PG8_BAR; PG8_MMA(0, 0, At, B0); PG8_MMA(0, 1, At, B1); PG8_BAR; PG8_SCHED;
            PG8_LDA(At, 0, 1); PG8_STAGE(PG8_SB(0, 0), b2, voffB); PG8_STAGE(PG8_SB(0, 1), b2 + hstepB, voffB); PG8_STAGE(PG8_SA(0, 0), a2, voffA);
            PG8_WAIT_V(8); PG8_WAIT_L(0); PG8_BAR; PG8_MMA(1, 0, At, B0); PG8_MMA(1, 1, At, B1); PG8_BAR; PG8_SCHED;
            PG8_LDB(B0, 1, 0); PG8_LDB(B1, 1, 1); PG8_SCHED; PG8_LDA(At, 1, 0); PG8_STAGE(PG8_SA(0, 1), a2 + hstepA, voffA);
            PG8_WAIT_V(8); PG8_WAIT_L(0); PG8_BAR; PG8_MMA(0, 0, At, B0); PG8_MMA(0, 1, At, B1); PG8_BAR; PG8_SCHED;
            PG8_LDA(At, 1, 1); PG8_STAGE(PG8_SB(1, 0), b3, voffB); PG8_STAGE(PG8_SB(1, 1), b3 + hstepB, voffB); PG8_STAGE(PG8_SA(1, 0), a3, voffA);
            PG8_WAIT_V(8); PG8_WAIT_L(0); PG8_BAR; PG8_MMA(1, 0, At, B0); PG8_MMA(1, 1, At, B1); PG8_BAR; PG8_SCHED;
        }
        if constexpr (ALIGN_EPI) { if (wr == 0) PG8_BAR; }
        if (has_next) pren = E.pre(nxt, wr);
        E(acc, cur, wr, wc, fr, fq, pre);
        if (!has_next) break;
        pre = pren;
#pragma unroll
        for (int a = 0; a < 2; ++a)
#pragma unroll
            for (int b = 0; b < 2; ++b)
#pragma unroll
                for (int m = 0; m < 4; ++m)
#pragma unroll
                    for (int n = 0; n < 2; ++n) acc[a][b][m][n] = (f32x4){0.f, 0.f, 0.f, 0.f};
        cur = nxt; cA = nA; cB = nB; ++ui;
        if constexpr (ALIGN_EPI) { if (wr == 1) PG8_BAR; }
    }
    PG8_WAIT_V(0);
    if constexpr (!ALIGN_EPI) { if (wr == 0) PG8_BAR; }
    PG8_BAR;
#undef PG8_SA
#undef PG8_SB
#undef PG8_STAGE
#undef PG8_LDA
#undef PG8_LDB
#undef PG8_MMA
#undef PG8_WAIT_V
#undef PG8_WAIT_L
#undef PG8_BAR
#undef PG8_SCHED
}
}

struct EpiProj {
    static constexpr bool PERM = true;
    bf16* O; bf16* ug; const float* rs; const float *nw0, *nw1, *nw2, *nw3, *nw4; const float2* cs; float* kmean; LAS unsigned char* xl;
    struct Pre { float r0, r1; };
    __device__ __forceinline__ Pre pre(const pg8::Unit& u, int wr) const { const float* p = rs + u.pm * 256 + 64 * wr + (otid() & 63); Pre q; q.r0 = p[0]; q.r1 = p[128]; return q; }
    __device__ __forceinline__ static int nid(int h) { return h < 4 ? 0 : h < 8 ? 1 : (h >= 16 && h < 20) ? 2 : h == 22 ? 3 : h == 24 ? 4 : -1; }
    __device__ __forceinline__ void operator()(const f32x4 (&acc)[2][2][4][2], const pg8::Unit& u, int wr, int wc, int fr, int fq, const Pre& pr) const {
        const float rsv[2] = {pr.r0, pr.r1};
        const int row0 = u.pm * 256 + wr * 64 + fr, col0 = u.pn * 256 + wc * 32 + 8 * fq;
        const int n0 = nid(2 * u.pn), n1 = nid(2 * u.pn + 1);
        if (n0 < 0 && n1 < 0) {
            const bool su = (u.pn >= O_SU / 256) && (u.pn < O_SZ / 256);
            const int cs0 = col0 - O_SU;
#pragma unroll
            for (int ai = 0; ai < 2; ++ai)
#pragma unroll
                for (int m = 0; m < 4; ++m) {
                    const float r = __shfl(rsv[ai], m * 16 + fr);
                    const int row = row0 + ai * 128 + m * 16;
                    bf16* rowp = su ? ug + (((size_t)((row >> 12) * 64 + (cs0 >> 4)) * SEQ + (row & (SEQ - 1))) * 16 + (cs0 & 8)) : O + (size_t)row * NP + col0;
                    const size_t bjs = su ? (size_t)8 * SEQ * 16 : (size_t)128;
#pragma unroll
                    for (int bj = 0; bj < 2; ++bj) { const f32x4 v0 = acc[ai][bj][m][0] * r, v1 = acc[ai][bj][m][1] * r;
                        u32x4 w; w.x = pg8::cvt_pk_bf16(v0[0], v0[1]); w.y = pg8::cvt_pk_bf16(v0[2], v0[3]); w.z = pg8::cvt_pk_bf16(v1[0], v1[1]); w.w = pg8::cvt_pk_bf16(v1[2], v1[3]);
                        *(u32x4*)(rowp + bj * bjs) = w; }
                }
            return;
        }
        LAS float* part = (LAS float*)xl;
        LAS float* ksum = (LAS float*)(xl + 8192);
#pragma unroll
        for (int ai = 0; ai < 2; ++ai)
#pragma unroll
            for (int m = 0; m < 4; ++m) {
                const float r = __shfl(rsv[ai], m * 16 + fr);
#pragma unroll
                for (int bj = 0; bj < 2; ++bj) { const f32x4 v0 = acc[ai][bj][m][0] * r, v1 = acc[ai][bj][m][1] * r;
                    float ss = (v0[0] * v0[0] + v0[1] * v0[1]) + (v0[2] * v0[2] + v0[3] * v0[3]) + (v1[0] * v1[0] + v1[1] * v1[1]) + (v1[2] * v1[2] + v1[3] * v1[3]);
                    ss += __shfl_xor(ss, 16); ss += __shfl_xor(ss, 32);
                    if (fq == 0) part[((ai * 128 + wr * 64 + m * 16 + fr) * 2 + bj) * 4 + wc] = ss; }
            }
        { const int t = otid(); if (t < 32) ((LAS float*)(xl + 10240))[t] = ((const float*)(cs + 16 * 16))[t]; }
        asm volatile("s_waitcnt lgkmcnt(0)" ::: "memory"); __builtin_amdgcn_s_barrier(); asm volatile("" ::: "memory");
        float csum[2][8];
#pragma unroll
        for (int bj = 0; bj < 2; ++bj)
#pragma unroll
            for (int e = 0; e < 8; ++e) csum[bj][e] = 0.f;
        f32x4 wq[2][2];
#pragma unroll
        for (int bj = 0; bj < 2; ++bj) { const int ni = bj ? n1 : n0;
            const float* wp = (ni <= 0 ? nw0 : ni == 1 ? nw1 : ni == 2 ? nw2 : ni == 3 ? nw3 : nw4) + wc * 32 + 8 * fq;
            wq[bj][0] = *(const f32x4*)wp; wq[bj][1] = *(const f32x4*)(wp + 4); }
        f32x4 ccur[4];
        const int ol = otid() & 63, ofr = ol & 15, ofq1 = (ol >> 4) & 1;
        { const f32x4* c4 = (const f32x4*)(cs + (size_t)((u.pm * 256 + wr * 64 + ofr) & (SEQ - 1)) * 16 + 8 * ofq1);
#pragma unroll
          for (int q = 0; q < 4; ++q) ccur[q] = c4[q]; }
        const LAS f32x4* rotl = (const LAS f32x4*)(xl + 10240) + 4 * ofq1;
#pragma unroll
        for (int ai = 0; ai < 2; ++ai)
#pragma unroll
            for (int m = 0; m < 4; ++m) {
                const float r = __shfl(rsv[ai], m * 16 + fr);
                const int rl = ai * 128 + wr * 64 + m * 16 + fr;
                bf16* rowp = O + (size_t)(u.pm * 256 + rl) * NP + col0;
#pragma unroll
                for (int bj = 0; bj < 2; ++bj) {
                    const int ni = bj ? n1 : n0;
                    float v[8];
#pragma unroll
                    for (int e = 0; e < 8; ++e) v[e] = ((e < 4) ? acc[ai][bj][m][0][e & 3] : acc[ai][bj][m][1][e & 3]) * r;
                    if (ni >= 0) {
                        const f32x4 p4 = *(const LAS f32x4*)(part + (rl * 2 + bj) * 4);
                        const float rn = 1.0f / sqrtf(((p4[0] + p4[1]) + (p4[2] + p4[3])) * (1.0f / 128.0f) + EPSN);
#pragma unroll
                        for (int e = 0; e < 8; ++e) v[e] *= rn * ((e < 4) ? wq[bj][0][e & 3] : wq[bj][1][e & 3]);
                        if (wc == 0) {
#pragma unroll
                            for (int e = 0; e < 8; ++e) { const float other = __shfl_xor(v[e], 32); const float cx = ccur[e >> 1][2 * (e & 1)], cy = ccur[e >> 1][2 * (e & 1) + 1];
                                v[e] = (fq < 2) ? (v[e] * cx - other * cy) : (v[e] * cx + other * cy); }
                        }
                        if (ni == 1) {
#pragma unroll
                            for (int e = 0; e < 8; ++e) csum[bj][e] += v[e];
                        }
                    }
                    u32x4 w; w.x = pg8::cvt_pk_bf16(v[0], v[1]); w.y = pg8::cvt_pk_bf16(v[2], v[3]); w.z = pg8::cvt_pk_bf16(v[4], v[5]); w.w = pg8::cvt_pk_bf16(v[6], v[7]);
                    *(u32x4*)(rowp + bj * 128) = w;
                }
                if (wc == 0 && ai * 4 + m < 7) {
                    const int steps = (ai == 0 && m == 3) ? 5 : 1;
#pragma unroll
                    for (int q = 0; q < 4; ++q) { const f32x4 rot = rotl[q];
#pragma unroll
                        for (int st = 0; st < steps; ++st)
#pragma unroll
                            for (int h = 0; h < 2; ++h) { const float c = ccur[q][2 * h], sn = ccur[q][2 * h + 1], rc = rot[2 * h], rsn = rot[2 * h + 1];
                                ccur[q][2 * h] = c * rc - sn * rsn; ccur[q][2 * h + 1] = sn * rc + c * rsn; } }
                }
                asm volatile("" ::: "memory");
            }
        if (n0 == 1) {
#pragma unroll
            for (int bj = 0; bj < 2; ++bj)
#pragma unroll
                for (int e = 0; e < 8; ++e) { float s = csum[bj][e]; s += __shfl_xor(s, 1); s += __shfl_xor(s, 2); s += __shfl_xor(s, 4); s += __shfl_xor(s, 8);
                    if (fr == 0) ksum[wr * 256 + bj * 128 + wc * 32 + 8 * fq + e] = s; }
            asm volatile("s_waitcnt lgkmcnt(0)" ::: "memory"); __builtin_amdgcn_s_barrier(); asm volatile("" ::: "memory");
            const int tid = otid();
            if (tid < 256) { const int h = 2 * u.pn + (tid >> 7) - 4, b = u.pm >> 4, n = u.pm & 15;
                kmean[((size_t)(b * 4 + h) * 16 + n) * 128 + (tid & 127)] = (ksum[tid] + ksum[256 + tid]) * (1.0f / 256.0f); }
        }
    }
};
struct EpiGlu {
    static constexpr bool PERM = true;
    bf16* mixed; const bf16* y5; const bf16* proj;
    struct Pre {};
    __device__ __forceinline__ Pre pre(const pg8::Unit&, int) const { return Pre{}; }
    __device__ __forceinline__ void operator()(const f32x4 (&acc)[2][2][4][2], const pg8::Unit& u, int wr, int wc, int fr, int fq, const Pre&) const {
        const int row0 = u.pm * 256 + wr * 64 + fr, col0 = u.pn * 256 + wc * 32 + 8 * fq;
#pragma unroll
        for (int ai = 0; ai < 2; ++ai) {
            u32x4 yv[4][2], zv[4][2];
#pragma unroll
            for (int m = 0; m < 4; ++m)
#pragma unroll
                for (int bj = 0; bj < 2; ++bj) { const size_t row = (size_t)(row0 + ai * 128 + m * 16); const int col = col0 + bj * 128;
                    yv[m][bj] = *(const u32x4*)(y5 + row * 1024 + col); zv[m][bj] = *(const u32x4*)(proj + row * NP + O_SZ + col); }
            asm volatile("" ::: "memory");
#pragma unroll
            for (int m = 0; m < 4; ++m) {
                const size_t row = (size_t)(row0 + ai * 128 + m * 16);
#pragma unroll
                for (int bj = 0; bj < 2; ++bj) {
                    const int col = col0 + bj * 128;
                    float o[8];
#pragma unroll
                    for (int e = 0; e < 8; ++e) {
                        const float a = (e < 4) ? acc[ai][bj][m][0][e & 3] : acc[ai][bj][m][1][e & 3];
                        const unsigned yw = yv[m][bj][e >> 1], zw = zv[m][bj][e >> 1];
                        const float y = (e & 1) ? __uint_as_float(yw & 0xffff0000u) : __uint_as_float(yw << 16);
                        const float z = (e & 1) ? __uint_as_float(zw & 0xffff0000u) : __uint_as_float(zw << 16);
                        o[e] = y * sigmoidf_(a) * siluf_(z);
                    }
                    u32x4 w; w.x = pg8::cvt_pk_bf16(o[0], o[1]); w.y = pg8::cvt_pk_bf16(o[2], o[3]); w.z = pg8::cvt_pk_bf16(o[4], o[5]); w.w = pg8::cvt_pk_bf16(o[6], o[7]);
                    *(u32x4*)(mixed + row * DM + 1024 + col) = w;
                }
            }
        }
    }
};
struct EpiOut {
    static constexpr bool PERM = true;
    float* out; bf16* xb; float* ssqp; int last; float* rs; unsigned* cnt; LAS unsigned* fl;
    struct Pre {};
    __device__ __forceinline__ Pre pre(const pg8::Unit&, int) const { return Pre{}; }
    __device__ __forceinline__ void operator()(const f32x4 (&acc)[2][2][4][2], const pg8::Unit& u, int wr, int wc, int fr, int fq, const Pre&) const {
        const int row0 = u.pm * 256 + wr * 64 + fr, col0 = u.pn * 256 + wc * 32 + 8 * fq;
        u32x4 xv[2][4][2];
#pragma unroll
        for (int ai = 0; ai < 2; ++ai)
#pragma unroll
            for (int m = 0; m < 4; ++m)
#pragma unroll
                for (int bj = 0; bj < 2; ++bj) xv[ai][m][bj] = *(const u32x4*)(xb + (size_t)(row0 + ai * 128 + m * 16) * DM + col0 + bj * 128);
        asm volatile("" ::: "memory");
#pragma unroll
        for (int ai = 0; ai < 2; ++ai) {
#pragma unroll
            for (int m = 0; m < 4; ++m) {
                const size_t row = (size_t)(row0 + ai * 128 + m * 16);
                float ss = 0.f;
#pragma unroll
                for (int bj = 0; bj < 2; ++bj) {
                    const size_t off = row * DM + col0 + bj * 128;
                    const u32x4 xw = xv[ai][m][bj];
                    f32x4 a, b;
                    a[0] = __uint_as_float(xw.x << 16) + acc[ai][bj][m][0][0]; a[1] = __uint_as_float(xw.x & 0xffff0000u) + acc[ai][bj][m][0][1];
                    a[2] = __uint_as_float(xw.y << 16) + acc[ai][bj][m][0][2]; a[3] = __uint_as_float(xw.y & 0xffff0000u) + acc[ai][bj][m][0][3];
                    b[0] = __uint_as_float(xw.z << 16) + acc[ai][bj][m][1][0]; b[1] = __uint_as_float(xw.z & 0xffff0000u) + acc[ai][bj][m][1][1];
                    b[2] = __uint_as_float(xw.w << 16) + acc[ai][bj][m][1][2]; b[3] = __uint_as_float(xw.w & 0xffff0000u) + acc[ai][bj][m][1][3];
                    if (last) { *(f32x4*)(out + off) = a; *(f32x4*)(out + off + 4) = b; }
                    else {
                        ss += ((a[0] * a[0] + a[1] * a[1]) + (a[2] * a[2] + a[3] * a[3])) + ((b[0] * b[0] + b[1] * b[1]) + (b[2] * b[2] + b[3] * b[3]));
                        u32x4 w; w.x = pg8::cvt_pk_bf16(a[0], a[1]); w.y = pg8::cvt_pk_bf16(a[2], a[3]); w.z = pg8::cvt_pk_bf16(b[0], b[1]); w.w = pg8::cvt_pk_bf16(b[2], b[3]);
                        *(u32x4*)(xb + off) = w;
                    }
                }
                if (!last) {
                    ss += __shfl_xor(ss, 16); ss += __shfl_xor(ss, 32);
                    if (fq == 0) ssqp[row * 32 + u.pn * 4 + wc] = ss;
                }
            }
        }
        if (!last) {
            const int tid = otid();
            asm volatile("s_waitcnt vmcnt(0)" ::: "memory"); __builtin_amdgcn_s_barrier();
            if (tid == 0) { __builtin_amdgcn_fence(__ATOMIC_RELEASE, "agent"); asm volatile("s_waitcnt vmcnt(0)" ::: "memory");
                const unsigned old = __hip_atomic_fetch_add(cnt + u.pm, 1u, __ATOMIC_RELAXED, __HIP_MEMORY_SCOPE_AGENT);
                if (old == 7u) { __builtin_amdgcn_fence(__ATOMIC_ACQUIRE, "agent"); asm volatile("s_waitcnt vmcnt(0)" ::: "memory"); }
                fl[0] = old; }
            asm volatile("s_waitcnt lgkmcnt(0)" ::: "memory"); __builtin_amdgcn_s_barrier(); asm volatile("" ::: "memory");
            if (fl[0] == 7u) { asm volatile("; last arriver" ::: "memory");
                if (tid < 256) { const f32x4* sp = (const f32x4*)(ssqp + (size_t)(u.pm * 256 + tid) * 32); float s = 0.f;
#pragma unroll
                    for (int i = 0; i < 8; ++i) { const f32x4 v = sp[i]; s += (v[0] + v[1]) + (v[2] + v[3]); }
                    rs[u.pm * 256 + tid] = 1.0f / sqrtf(s * (1.0f / DM) + EPSN); }
            }
        }
    }
};

struct Params {
    const float* in[25];
    float* out;
    unsigned char* ws;
    int ph_lo, ph_hi;
};
constexpr int LDS_BYTES = 147456;
constexpr int NWAVES = 8;

namespace a1 { __device__ __forceinline__ void prep_w1(const Params& P, LAS unsigned char* lds); }
namespace s5 { __device__ __forceinline__ void tables_task(const Params& P, LAS unsigned char* lds, const int l, const int g, const int part); }
__device__ __forceinline__ void p0_transpose_item(const float* W, int ldsrc, int srccol0, int K, const float* kscale, bf16* WT, int n0, int k0, LAS float* scr, int lane) {
    float tv[32];
#pragma unroll
    for (int i = 0; i < 32; ++i) tv[i] = W[(size_t)(k0 + 2 * i + (lane >> 5)) * ldsrc + srccol0 + (lane & 31)];
#pragma unroll
    for (int i = 0; i < 32; ++i) { const int kk = 2 * i + (lane >> 5); float v = tv[i]; if (kscale) v *= kscale[k0 + kk]; scr[kk * 33 + (lane & 31)] = v; }
    asm volatile("s_waitcnt lgkmcnt(0)" ::: "memory");
    const int c = lane & 7;
#pragma unroll
    for (int j = 0; j < 4; ++j) { const int n = (lane >> 3) + 8 * j; const LAS float* s = scr + (8 * c) * 33 + n;
        u32x4 o; o.x = pk2(s[0 * 33], s[1 * 33]); o.y = pk2(s[2 * 33], s[3 * 33]); o.z = pk2(s[4 * 33], s[5 * 33]); o.w = pk2(s[6 * 33], s[7 * 33]);
        *(u32x4*)(WT + (size_t)(n0 + n) * K + k0 + 8 * c) = o; }
    asm volatile("s_waitcnt lgkmcnt(0)" ::: "memory");
}
__device__ __forceinline__ void phase_prep(const Params& P, LAS unsigned char* lds) {
    const int tid = otid(), lane = tid & 63, wave = tid >> 6;
    LAS float* scr = (LAS float*)(lds + wave * 16384);
    const int gw = blockIdx.x * NWAVES + wave, NGW = gridDim.x * NWAVES;
    constexpr int I_IN = (DM / 64) * (NP / 32), I_OUT = (DM / 64) * (DM / 32), I_GLU = (1024 / 64) * (1024 / 32);
    constexpr int PER_L = I_IN + I_OUT + I_GLU;
    for (int pass = 0; pass < 2; ++pass) {
    if ((pass == 0) == ((blockIdx.x & 1) == 0)) {
    for (int it = gw; it < NL * PER_L; it += NGW) {
        const int l = it / PER_L; int r = it % PER_L;
        if (r < I_IN) { const int nb = r % (NP / 32), kb = r / (NP / 32), n0 = nb * 32, src = n0 + (n0 >= SRC_NG ? 12 : 0);
            p0_transpose_item(P.in[2] + (size_t)l * DM * INW, INW, src, DM, P.in[1] + l * DM, (bf16*)(P.ws + WS_WIN + l * WIN_BYTES), n0, kb * 64, scr, lane); continue; }
        r -= I_IN;
        if (r < I_OUT) { const int nb = r % (DM / 32), kb = r / (DM / 32);
            p0_transpose_item(P.in[3] + (size_t)l * DM * DM, DM, nb * 32, DM, nullptr, (bf16*)(P.ws + WS_WOUT + l * WOUT_BYTES), nb * 32, kb * 64, scr, lane); continue; }
        r -= I_OUT;
        { const int nb = r % 32, kb = r / 32;
            p0_transpose_item(P.in[24] + (size_t)l * 1024 * 1024, 1024, nb * 32, 1024, nullptr, (bf16*)(P.ws + WS_GLU + l * GLU_BYTES), nb * 32, kb * 64, scr, lane); }
    }
    const float* x = P.in[0]; bf16* xb = (bf16*)(P.ws + WS_XB); float* rs = (float*)(P.ws + WS_RS);
    for (int m = gw; m < NT; m += NGW) {
        const f32x4* xr = (const f32x4*)(x + (size_t)m * DM) + lane;
        u32x2* o8 = (u32x2*)(xb + (size_t)m * DM) + lane;
        float s = 0.f;
#pragma unroll
        for (int j = 0; j < 8; ++j) { const f32x4 v = xr[64 * j]; s += (v[0] * v[0] + v[1] * v[1]) + (v[2] * v[2] + v[3] * v[3]); u32x2 w; w.x = pk2(v[0], v[1]); w.y = pk2(v[2], v[3]); o8[64 * j] = w; }
        s = wave_sum(s);
        if (lane == 0) rs[m] = 1.0f / sqrtf(s * (1.0f / DM) + EPSN);
    }
    float2* cs = (float2*)(P.ws + WS_ROPE);
    for (int i = blockIdx.x * blockDim.x + tid; i < SEQ * 16; i += gridDim.x * blockDim.x) {
        double s, c; dsincos((double)(i >> 4) * INVF[i & 15], s, c); cs[i] = make_float2((float)c, (float)s);
    }
    } else {
        for (int t = blockIdx.x; t < NL * 64 * 4; t += gridDim.x) s5::tables_task(P, lds, t >> 8, (t >> 2) & 63, t & 3);
    }
    __syncthreads();
    }
    a1::prep_w1(P, lds);
    if (blockIdx.x == 0) {
        int* order = (int*)(P.ws + WS_ORDER);
        const int u = tid; const int cu = (u < 256) ? (2 * (u & 63) + 46) : (8 * ((u - 256) & 15) + 9);
        int rank = 0;
        for (int v = 0; v < 512; ++v) { const int cv = (v < 256) ? (2 * (v & 63) + 46) : (8 * ((v - 256) & 15) + 9); rank += (cv > cu || (cv == cu && v < u)) ? 1 : 0; }
        order[rank] = u;
    }
}

__device__ __forceinline__ void phase_gemm1(const Params& P, LAS unsigned char* lds, int l) {
    pg8::Gemm g{(const bf16*)(P.ws + WS_XB), (const bf16*)(P.ws + WS_WIN + l * WIN_BYTES), NT, NP, DM, DM};
    pg8::StaticOrder S; S.init(NT, NP, gridDim.x, blockIdx.x, 1);
    EpiProj E{(bf16*)(P.ws + WS_PROJ), (bf16*)(P.out + SUG_OFF), (const float*)(P.ws + WS_RS), P.in[4] + l * 128, P.in[5] + l * 128, P.in[6] + l * 128, P.in[8] + l * 128, P.in[9] + l * 128,
              (const float2*)(P.ws + WS_ROPE), (float*)(P.ws + WS_KMEAN), lds + 131072};
    pg8::gemm_phase<EpiProj, pg8::StaticOrder>(lds, g, S, E);
}
__device__ __forceinline__ void phase_out(const Params& P, LAS unsigned char* lds, int l) {
    pg8::Gemm g{(const bf16*)(P.ws + WS_MIXED), (const bf16*)(P.ws + WS_WOUT + l * WOUT_BYTES), NT, DM, DM, DM};
    pg8::StaticOrder S; S.init(NT, DM, gridDim.x, blockIdx.x);
    EpiOut E{P.out, (bf16*)(P.ws + WS_XB), (float*)(P.ws + WS_SSQP), l == NL - 1 ? 1 : 0, (float*)(P.ws + WS_RS), (unsigned*)(P.ws + WS_CTL) + 2048 + 64 * l, (LAS unsigned*)(lds + 131072 + 12288)};
    pg8::gemm_phase<EpiOut, pg8::StaticOrder>(lds, g, S, E);
}

namespace att {
typedef short s16x4 __attribute__((ext_vector_type(4)));
typedef float f32x16 __attribute__((ext_vector_type(16)));
constexpr int SHM_K = 16384, SHM_V = 16384;
constexpr int OFF_V = 0, OFF_K = 2 * SHM_V, OFF_WS = 2 * SHM_V + 2 * SHM_K;
constexpr int OFF_X = OFF_WS + 8 * 256;
constexpr unsigned WINF = 0x7fffffffu;
constexpr float THR = 8.f;
#define KSWZ(row, colB) ((row) * 256 + ((colB) ^ (((row) & 7) << 4)))
#define SBAR() __builtin_amdgcn_sched_barrier(0)
__device__ __forceinline__ int v_st(int k, int c) { const int kk = (k & ~0xC) | ((k & 4) << 1) | ((k & 8) >> 1); return ((kk >> 3) * 4 + (c >> 5)) * 512 + ((kk & 7) * 32 + (c & 31)) * 2; }
__device__ __forceinline__ int v_rd_base(int lane) { return ((lane & 3) << 3) | (((lane >> 2) & 3) << 6) | (((lane >> 4) & 1) << 5) | (((lane >> 5) & 1) << 8); }
constexpr int v_rd_off(int d0, int ks, int half) { return d0 * 512 + ks * 4096 + half * 2048; }
__device__ __forceinline__ int crow(int r, int hi) { return (r & 3) + 8 * (r >> 2) + 4 * hi; }
__device__ __forceinline__ unsigned cvtpk(float lo, float hi) { unsigned r; asm volatile("v_cvt_pk_bf16_f32 %0, %1, %2" : "=v"(r) : "v"(lo), "v"(hi)); return r; }

__device__ __forceinline__ void mask_tile(f32x16& p0, f32x16& p1, int dq, unsigned W) {
    const float NEG = -__builtin_inff();
#pragma unroll
    for (int r = 0; r < 16; ++r) {
        const int c = (r & 3) + 8 * (r >> 2);
        if ((unsigned)(dq - c) >= W) p0[r] = NEG;
        if ((unsigned)(dq - c - 32) >= W) p1[r] = NEG;
    }
}
__device__ __forceinline__ void qkt(f32x16& p0, f32x16& p1, LAS const unsigned char* Kb, int r32, int hi, const bf16x8* qr) {
    p0 = f32x16{}; p1 = f32x16{};
    const int ka0 = (int)(uintptr_t)(Kb + KSWZ(r32, (0 * 16 + hi * 8) * 2)), ka1 = (int)(uintptr_t)(Kb + KSWZ(r32, (1 * 16 + hi * 8) * 2));
    const int ka2 = (int)(uintptr_t)(Kb + KSWZ(r32, (2 * 16 + hi * 8) * 2)), ka3 = (int)(uintptr_t)(Kb + KSWZ(r32, (3 * 16 + hi * 8) * 2));
#define Q_KR(dst, addr, off) asm volatile("ds_read_b128 %0, %1 offset:%2" : "=&v"(dst) : "v"(addr), "i"(off) : "memory")
#define Q_KRD(F, kaa, kab, hoff) do { Q_KR(F[0], kaa, hoff); Q_KR(F[1], kaa, hoff + 8192); Q_KR(F[2], kab, hoff); Q_KR(F[3], kab, hoff + 8192); } while (0)
#define Q_WAIT() do { asm volatile("s_waitcnt lgkmcnt(0)" ::: "memory"); SBAR(); } while (0)
#define Q_QK(F, q0) do { \
        p0 = __builtin_amdgcn_mfma_f32_32x32x16_bf16(F[0], qr[q0], p0, 0, 0, 0); p1 = __builtin_amdgcn_mfma_f32_32x32x16_bf16(F[1], qr[q0], p1, 0, 0, 0); \
        p0 = __builtin_amdgcn_mfma_f32_32x32x16_bf16(F[2], qr[q0 + 1], p0, 0, 0, 0); p1 = __builtin_amdgcn_mfma_f32_32x32x16_bf16(F[3], qr[q0 + 1], p1, 0, 0, 0); } while (0)
    bf16x8 FA[4], FB[4];
    Q_KRD(FA, ka0, ka1, 0); Q_WAIT();
    Q_KRD(FB, ka2, ka3, 0); Q_QK(FA, 0); Q_WAIT();
    Q_KRD(FA, ka0, ka1, 128); Q_QK(FB, 2); Q_WAIT();
    Q_KRD(FB, ka2, ka3, 128); Q_QK(FA, 4); Q_WAIT();
    Q_QK(FB, 6);
#undef Q_KR
#undef Q_KRD
#undef Q_WAIT
#undef Q_QK
}
__device__ __forceinline__ void pv_tile(f32x16* o, int vb, bf16x8 pa0, bf16x8 pa1, bf16x8 pa2, bf16x8 pa3) {
#define TRRD(dst, off) asm volatile("ds_read_b64_tr_b16 %0, %1 offset:%2" : "=&v"(dst) : "v"(vb), "i"(off) : "memory")
#define PV_D0(d0) do { s16x4 l0, l1, l2, l3, h0, h1, h2, h3; constexpr int b_ = v_rd_off(d0, 0, 0); \
        TRRD(l0, b_); TRRD(h0, b_ + 2048); TRRD(l1, b_ + 4096); TRRD(h1, b_ + 6144); TRRD(l2, b_ + 8192); TRRD(h2, b_ + 10240); TRRD(l3, b_ + 12288); TRRD(h3, b_ + 14336); \
        asm volatile("s_waitcnt lgkmcnt(0)" ::: "memory"); SBAR(); \
        o[d0] = __builtin_amdgcn_mfma_f32_32x32x16_bf16(pa0, (bf16x8){l0[0], l0[1], l0[2], l0[3], h0[0], h0[1], h0[2], h0[3]}, o[d0], 0, 0, 0); \
        o[d0] = __builtin_amdgcn_mfma_f32_32x32x16_bf16(pa1, (bf16x8){l1[0], l1[1], l1[2], l1[3], h1[0], h1[1], h1[2], h1[3]}, o[d0], 0, 0, 0); \
        o[d0] = __builtin_amdgcn_mfma_f32_32x32x16_bf16(pa2, (bf16x8){l2[0], l2[1], l2[2], l2[3], h2[0], h2[1], h2[2], h2[3]}, o[d0], 0, 0, 0); \
        o[d0] = __builtin_amdgcn_mfma_f32_32x32x16_bf16(pa3, (bf16x8){l3[0], l3[1], l3[2], l3[3], h3[0], h3[1], h3[2], h3[3]}, o[d0], 0, 0, 0); } while (0)
    PV_D0(0); PV_D0(1); PV_D0(2); PV_D0(3);
#undef PV_D0
#undef TRRD
}

template <bool IMP>
__device__ __forceinline__ void attn_tiles(LAS unsigned char* lds, const bf16x8 (&qr)[8], const bf16* Kp, const bf16* Vp, const int kvs,
                                           unsigned long long tilemask, const int pos, const int wlo, const int whi, const unsigned W,
                                           const unsigned long long rowmask, const int shift,
                                           f32x16 (&o)[4], float& m_reg, float& l_reg, float (&imp)[32]) {
    const int tid = otid(), wid = __builtin_amdgcn_readfirstlane(tid >> 6), lane = tid & 63, r32 = lane & 31, hi = lane >> 5;
    LAS unsigned char* V_lds = lds + OFF_V; LAS unsigned char* K_lds = lds + OFF_K;
    LAS float* al_l = (LAS float*)(lds + OFF_WS) + wid * 64 + 32;
    const int sr = tid >> 4, sc = (tid & 15) * 8;
    const int vst0 = v_st(sr, sc), vst1 = v_st(32 + sr, sc), kws = KSWZ(sr, sc * 2);
    const int vb0 = (int)(uintptr_t)V_lds + v_rd_base(lane);
    const int qm = pos - 4 * hi;
    constexpr float C2 = 1.4426950408889634f * SCALE;
    bf16x8 st_k0, st_k1, st_v0, st_v1;
#define A_LOAD(j_) do { const size_t r0_ = (size_t)((j_) * 64 + sr) * kvs + sc, r1_ = r0_ + (size_t)32 * kvs; \
        st_v0 = *(const bf16x8*)(Vp + r0_); st_v1 = *(const bf16x8*)(Vp + r1_); st_k0 = *(const bf16x8*)(Kp + r0_); st_k1 = *(const bf16x8*)(Kp + r1_); } while (0)
#define A_WRITE(bf_) do { *(LAS bf16x8*)(K_lds + (bf_) * SHM_K + kws) = st_k0; *(LAS bf16x8*)(K_lds + (bf_) * SHM_K + kws + 32 * 256) = st_k1; \
        *(LAS bf16x8*)(V_lds + (bf_) * SHM_V + vst0) = st_v0; *(LAS bf16x8*)(V_lds + (bf_) * SHM_V + vst1) = st_v1; } while (0)
    if (tilemask == 0ull) return;
    int j = __ffsll((long long)tilemask) - 1; tilemask &= tilemask - 1;
    A_LOAD(j); A_WRITE(0);
    __syncthreads();
    int jn = -1;
    if (tilemask) { jn = __ffsll((long long)tilemask) - 1; tilemask &= tilemask - 1; A_LOAD(jn); }
    int buf = 0; float carry = 0.f;
    for (;;) {
        const int kb = j * 64;
        const bool act = (kb <= whi) && ((long long)kb + 63 + (long long)W > (long long)wlo);
        if (act) {
            f32x16 p0, p1;
            SBAR(); qkt(p0, p1, K_lds + buf * SHM_K, r32, hi, qr); SBAR();
            const bool needm = (kb + 63 > wlo) || ((long long)kb + (long long)W <= (long long)whi);
            if (needm) { asm volatile("; boundary tile" ::: "memory"); mask_tile(p0, p1, qm - kb, W); }
            const bool rowsel = ((rowmask >> (kb >> shift)) & 1ull) != 0ull;
            if (!__all(rowsel)) { asm volatile("; row-select mask" ::: "memory"); const float NEG = -__builtin_inff();
#pragma unroll
                for (int r = 0; r < 16; ++r) { p0[r] = rowsel ? p0[r] : NEG; p1[r] = rowsel ? p1[r] : NEG; } }
            float pmax;
            { float m0 = fmaxf(fmaxf(p0[0], p0[1]), p0[2]), m1 = fmaxf(fmaxf(p0[3], p0[4]), p0[5]), m2 = fmaxf(fmaxf(p0[6], p0[7]), p0[8]), m3 = fmaxf(fmaxf(p0[9], p0[10]), p0[11]);
              float m4 = fmaxf(fmaxf(p0[12], p0[13]), p0[14]), m5 = fmaxf(fmaxf(p0[15], p1[0]), p1[1]), m6 = fmaxf(fmaxf(p1[2], p1[3]), p1[4]), m7 = fmaxf(fmaxf(p1[5], p1[6]), p1[7]);
              float m8 = fmaxf(fmaxf(p1[8], p1[9]), p1[10]), m9 = fmaxf(fmaxf(p1[11], p1[12]), p1[13]), ma = fmaxf(p1[14], p1[15]);
              m0 = fmaxf(fmaxf(m0, m1), m2); m3 = fmaxf(fmaxf(m3, m4), m5); m6 = fmaxf(fmaxf(m6, m7), m8); m9 = fmaxf(m9, ma);
              pmax = fmaxf(fmaxf(m0, m3), fmaxf(m6, m9)); }
            { auto rr = __builtin_amdgcn_permlane32_swap(__float_as_uint(pmax), __float_as_uint(pmax), false, false);
              pmax = fmaxf(__uint_as_float(rr[0]), __uint_as_float(rr[1])); }
            float mn, alpha;
            if (__all((pmax - m_reg) * SCALE <= THR)) { mn = m_reg; alpha = 1.f; }
            else { mn = fmaxf(m_reg, pmax); alpha = __builtin_amdgcn_exp2f((m_reg - mn) * C2); m_reg = mn; }
            const float mnL = -mn * C2;
#pragma unroll
            for (int r = 0; r < 16; ++r) { p0[r] = __builtin_amdgcn_exp2f(fmaf(p0[r], C2, mnL)); p1[r] = __builtin_amdgcn_exp2f(fmaf(p1[r], C2, mnL)); }
            float ps;
            { float s0 = (p0[0] + p0[1]) + (p0[2] + p0[3]), s1 = (p0[4] + p0[5]) + (p0[6] + p0[7]), s2 = (p0[8] + p0[9]) + (p0[10] + p0[11]), s3 = (p0[12] + p0[13]) + (p0[14] + p0[15]);
              float s4 = (p1[0] + p1[1]) + (p1[2] + p1[3]), s5_ = (p1[4] + p1[5]) + (p1[6] + p1[7]), s6 = (p1[8] + p1[9]) + (p1[10] + p1[11]), s7 = (p1[12] + p1[13]) + (p1[14] + p1[15]);
              ps = ((s0 + s1) + (s2 + s3)) + ((s4 + s5_) + (s6 + s7)); }
            { auto rr = __builtin_amdgcn_permlane32_swap(__float_as_uint(ps), __float_as_uint(ps), false, false);
              ps = __uint_as_float(rr[0]) + __uint_as_float(rr[1]); }
            l_reg = l_reg * alpha + ps;
            if (__any(alpha < 1.f)) {
                asm volatile("; rescale" ::: "memory");
                if (hi == 0) al_l[r32] = alpha;
                asm volatile("s_waitcnt lgkmcnt(0)" ::: "memory");
#pragma unroll
                for (int r = 0; r < 16; ++r) { const float a = al_l[crow(r, hi)];
#pragma unroll
                    for (int d_ = 0; d_ < 4; ++d_) o[d_][r] *= a; }
            }
            if constexpr (IMP) {
                float e3[4], f3[4], s0[4], s1[4];
#pragma unroll
                for (int q = 0; q < 4; ++q) { e3[q] = __shfl_xor(p0[4 * q + 3], 32); f3[q] = __shfl_xor(p1[4 * q + 3], 32);
                    s0[q] = (p0[4 * q] + p0[4 * q + 1]) + (p0[4 * q + 2] + p0[4 * q + 3]); s1[q] = (p1[4 * q] + p1[4 * q + 1]) + (p1[4 * q + 2] + p1[4 * q + 3]); }
                carry *= alpha;
#pragma unroll
                for (int q = 0; q < 4; ++q) {
                    s0[q] += hi ? e3[q] : (q > 0 ? e3[q > 0 ? q - 1 : 0] : carry);
                    s1[q] += hi ? f3[q] : (q > 0 ? f3[q > 0 ? q - 1 : 0] : e3[3]);
                }
                carry = f3[3];
#pragma unroll
                for (int i = 0; i < 32; ++i) imp[i] *= alpha;
#pragma unroll
                for (int tt = 0; tt < 4; ++tt) if (j == tt) {
#pragma unroll
                    for (int q = 0; q < 4; ++q) { imp[(tt * 2 + 0) * 4 + q] += s0[q]; imp[(tt * 2 + 1) * 4 + q] += s1[q]; } }
            }
            bf16x8 pa0, pa1, pa2, pa3;
#define PK4(P_, B_, OUT) do { const unsigned a0 = cvtpk(P_[B_ + 0], P_[B_ + 1]), a1 = cvtpk(P_[B_ + 2], P_[B_ + 3]); \
        const unsigned b0 = cvtpk(P_[B_ + 4], P_[B_ + 5]), b1 = cvtpk(P_[B_ + 6], P_[B_ + 7]); \
        auto r0 = __builtin_amdgcn_permlane32_swap(a0, b0, false, false); auto r1 = __builtin_amdgcn_permlane32_swap(a1, b1, false, false); \
        u32x4 w = {r0[0], r1[0], r0[1], r1[1]}; OUT = *reinterpret_cast<bf16x8*>(&w); } while (0)
            PK4(p0, 0, pa0); PK4(p0, 8, pa1); PK4(p1, 0, pa2); PK4(p1, 8, pa3);
#undef PK4
            SBAR();
            pv_tile(o, vb0 + buf * SHM_V, pa0, pa1, pa2, pa3);
        } else if (IMP) carry = 0.f;
        if (jn < 0) break;
        A_WRITE(buf ^ 1);
        __syncthreads();
        j = jn; buf ^= 1;
        if (tilemask) { jn = __ffsll((long long)tilemask) - 1; tilemask &= tilemask - 1; A_LOAD(jn); } else jn = -1;
    }
    __syncthreads();
#undef A_LOAD
#undef A_WRITE
}

template <int BR>
__device__ __forceinline__ void nsa_epi(const f32x16 (&o)[4], const float il, LAS float* li_l, float* accb, const float* gt, int r32, int hi, bf16* mixed, const bf16* zb) {
    asm volatile("" : "+v"(r32), "+v"(hi));
    if (hi == 0) li_l[r32] = il;
    asm volatile("s_waitcnt lgkmcnt(0)" ::: "memory");
#pragma unroll
    for (int rh = 0; rh < 2; ++rh) {
        float sv[8], av[8][4], zv[8][4];
#pragma unroll
        for (int q = 0; q < 8; ++q) { const int r = rh * 8 + q, rw = crow(r, hi);
            sv[q] = li_l[rw] * gt[rw * 12 + BR];
#pragma unroll
            for (int d0 = 0; d0 < 4; ++d0) { const int col = d0 * 32 + r32;
                if (BR >= 1) av[q][d0] = accb[rw * 128 + col];
                if (BR == 2) zv[q][d0] = bf2f(zb[(size_t)rw * NP + col]); } }
#pragma unroll
        for (int q = 0; q < 8; ++q) { const int r = rh * 8 + q, rw = crow(r, hi);
#pragma unroll
            for (int d0 = 0; d0 < 4; ++d0) { const int col = d0 * 32 + r32;
                if (BR == 0) accb[rw * 128 + col] = o[d0][r] * sv[q];
                else if (BR == 1) accb[rw * 128 + col] = av[q][d0] + o[d0][r] * sv[q];
                else { const float v = (av[q][d0] + o[d0][r] * sv[q]) * siluf_(zv[q][d0]);
                    const float vn = __shfl_xor(v, 1);
                    if ((r32 & 1) == 0) *(unsigned*)(mixed + (size_t)rw * DM + col) = cvtpk(v, vn); } } }
        asm volatile("" ::: "memory");
    }
}

__device__ __forceinline__ void nsa_unit(const Params& P, LAS unsigned char* lds, const int b, const int c) {
    const int tid = otid(), wid = __builtin_amdgcn_readfirstlane(tid >> 6), lane = tid & 63, r32 = lane & 31, hi = lane >> 5;
    const int head = wid >> 1, half = wid & 1;
    const int t_base = c * 64, trow = t_base + half * 32, pos = trow + r32;
    const bf16* proj = (const bf16*)(P.ws + WS_PROJ);
    const bf16* pb = proj + (size_t)b * SEQ * NP;
    const bf16* prow = pb + (size_t)pos * NP;
    bf16x8 qr[8];
#pragma unroll
    for (int d0 = 0; d0 < 8; ++d0) qr[d0] = *(const bf16x8*)(prow + O_NQ + head * 128 + d0 * 16 + hi * 8);
    LAS float* li_l = (LAS float*)(lds + OFF_WS) + wid * 64;
    float* accb = P.out + ((size_t)blockIdx.x * 256 + wid * 32) * 128;
    const float* gt = (const float*)(P.ws + WS_GATES) + (size_t)(b * SEQ + trow) * 12 + head * 3;
    const bf16* cmpk = (const bf16*)(P.ws + WS_CMPB) + (size_t)(0 * NB + b) * 256 * 128;
    const bf16* cmpv = (const bf16*)(P.ws + WS_CMPB) + (size_t)(1 * NB + b) * 256 * 128;
    f32x16 o[4]; float m_reg, l_reg;
    float dummy[32];
    {
        float imp[32];
#pragma unroll
        for (int i = 0; i < 32; ++i) imp[i] = 0.f;
#pragma unroll
        for (int d = 0; d < 4; ++d) o[d] = f32x16{};
        m_reg = -1e30f; l_reg = 0.f;
        const int posc = (pos - 31) >> 4, wloc = (trow - 31) >> 4, whic = trow >> 4;
        const int maxc = (t_base + 32) >> 4;
        const int ntile = (maxc >> 6) + 1;
        attn_tiles<true>(lds, qr, cmpk, cmpv, 128, (1ull << ntile) - 1ull, posc, wloc, whic, WINF, ~0ull, 12, o, m_reg, l_reg, imp);
        const float il = l_reg > 0.f ? 1.f / l_reg : 0.f;
        nsa_epi<0>(o, il, li_l, accb, gt, r32, hi, nullptr, nullptr);
        LAS float* impH = (LAS float*)lds;
        LAS float* ih = impH + ((head * 64 + half * 32 + r32) * 64);
#pragma unroll
        for (int tt = 0; tt < 4; ++tt)
#pragma unroll
            for (int hh = 0; hh < 2; ++hh)
#pragma unroll
                for (int q = 0; q < 4; ++q) ih[tt * 16 + hh * 8 + 2 * q + hi] = imp[(tt * 2 + hh) * 4 + q] * il;
    }
    __syncthreads();
    LAS float* score = (LAS float*)(lds + OFF_X);
    LAS unsigned char* selb = lds + OFF_X + 64 * 65 * 4;
    LAS unsigned* un = (LAS unsigned*)(lds + OFF_X + 64 * 65 * 4 + 512);
    {
        const int row = tid >> 3, part = tid & 7;
        const LAS float* impH = (const LAS float*)lds;
#pragma unroll
        for (int e = 0; e < 8; ++e) { const int jj = part * 8 + e;
            float s = (impH[(0 * 64 + row) * 64 + jj] + impH[(1 * 64 + row) * 64 + jj]) + (impH[(2 * 64 + row) * 64 + jj] + impH[(3 * 64 + row) * 64 + jj]);
            if (jj > c) s = -__builtin_inff();
            if (jj == 0 || jj == c || jj == c - 1) s = __builtin_inff();
            score[row * 65 + jj] = s; }
        if (tid < 2) un[tid] = 0u;
        __syncthreads();
        float sv[64];
#pragma unroll
        for (int j2 = 0; j2 < 64; ++j2) sv[j2] = score[row * 65 + j2];
        unsigned byte = 0u;
#pragma unroll
        for (int e = 0; e < 8; ++e) { const int jj = part * 8 + e; const float sj = score[row * 65 + jj]; int rank = 0;
#pragma unroll
            for (int j2 = 0; j2 < 64; ++j2) rank += (sv[j2] > sj || (sv[j2] == sj && j2 < jj)) ? 1 : 0;
            if (rank < 16 && jj <= c) byte |= 1u << e; }
        selb[row * 8 + part] = (unsigned char)byte;
        __hip_atomic_fetch_or(&un[part >> 2], byte << (8 * (part & 3)), __ATOMIC_RELAXED, __HIP_MEMORY_SCOPE_WORKGROUP);
    }
    __syncthreads();
    const unsigned long long rowmask = *(const LAS unsigned long long*)(selb + (half * 32 + r32) * 8);
    const unsigned long long selt = (unsigned long long)un[0] | ((unsigned long long)un[1] << 32);
    {
#pragma unroll
        for (int d = 0; d < 4; ++d) o[d] = f32x16{};
        m_reg = -1e30f; l_reg = 0.f;
        attn_tiles<false>(lds, qr, pb + O_KS, pb + O_VS, NP, selt, pos, trow, trow + 31, WINF, rowmask, 6, o, m_reg, l_reg, dummy);
        nsa_epi<1>(o, 1.f / l_reg, li_l, accb, gt, r32, hi, nullptr, nullptr);
    }
    {
#pragma unroll
        for (int d = 0; d < 4; ++d) o[d] = f32x16{};
        m_reg = -1e30f; l_reg = 0.f;
        const int lo = c > 8 ? c - 8 : 0;
        const unsigned long long upto = (c == 63) ? ~0ull : ((1ull << (c + 1)) - 1ull);
        const unsigned long long wt = upto & ~((1ull << lo) - 1ull);
        attn_tiles<false>(lds, qr, pb + O_KW, pb + O_VW, NP, wt, pos, trow, trow + 31, 512u, ~0ull, 12, o, m_reg, l_reg, dummy);
        bf16* mixed = (bf16*)(P.ws + WS_MIXED) + (size_t)(b * SEQ + trow) * DM + 512 + head * 128;
        const bf16* zb = pb + (size_t)trow * NP + O_NZ + head * 128;
        nsa_epi<2>(o, 1.f / l_reg, li_l, accb, gt, r32, hi, mixed, zb);
    }
}

__device__ __forceinline__ void moba_unit(const Params& P, LAS unsigned char* lds, const int b, const int h, const int own) {
    const int tid = otid(), wid = __builtin_amdgcn_readfirstlane(tid >> 6), lane = tid & 63, r32 = lane & 31, hi = lane >> 5;
    const int trow = own * 256 + wid * 32, pos = trow + r32;
    const bf16* proj = (const bf16*)(P.ws + WS_PROJ);
    const bf16* pb = proj + (size_t)b * SEQ * NP;
    const bf16* prow = pb + (size_t)pos * NP;
    bf16x8 qr[8];
#pragma unroll
    for (int d0 = 0; d0 < 8; ++d0) qr[d0] = *(const bf16x8*)(prow + O_MQ + h * 128 + d0 * 16 + hi * 8);
    LAS float* li_l = (LAS float*)(lds + OFF_WS) + wid * 64;
    LAS float* kml = (LAS float*)(lds + OFF_X);
    LAS unsigned* un = (LAS unsigned*)(lds + OFF_X + 8192);
    {
        const f32x4* src = (const f32x4*)((const float*)(P.ws + WS_KMEAN) + (size_t)(b * 4 + h) * 16 * 128);
        ((LAS f32x4*)kml)[tid] = src[tid];
        if (tid == 0) un[0] = 0u;
    }
    __syncthreads();
    float g[15];
#pragma unroll
    for (int n = 0; n < 15; ++n) g[n] = 0.f;
#pragma unroll
    for (int d0 = 0; d0 < 8; ++d0) {
        float qf[8];
#pragma unroll
        for (int e = 0; e < 8; ++e) qf[e] = bf2f((bf16)qr[d0][e]);
#pragma unroll
        for (int n = 0; n < 15; ++n) if (n < own) {
            const f32x4 k0 = *(const LAS f32x4*)(kml + n * 128 + d0 * 16 + hi * 8), k1 = *(const LAS f32x4*)(kml + n * 128 + d0 * 16 + hi * 8 + 4);
            g[n] += (qf[0] * k0[0] + qf[1] * k0[1]) + (qf[2] * k0[2] + qf[3] * k0[3]) + (qf[4] * k1[0] + qf[5] * k1[1]) + (qf[6] * k1[2] + qf[7] * k1[3]);
        }
    }
#pragma unroll
    for (int n = 0; n < 15; ++n) { g[n] += __shfl_xor(g[n], 32); if (n >= own) g[n] = -__builtin_inff(); }
    unsigned sel = 1u << own;
#pragma unroll
    for (int n = 0; n < 15; ++n) { int rank = 0;
#pragma unroll
        for (int n2 = 0; n2 < 15; ++n2) rank += (g[n2] > g[n] || (g[n2] == g[n] && n2 < n)) ? 1 : 0;
        if (n < own && rank < 3) sel |= 1u << n; }
    __hip_atomic_fetch_or(&un[0], sel, __ATOMIC_RELAXED, __HIP_MEMORY_SCOPE_WORKGROUP);
    __syncthreads();
    const unsigned blocks = un[0];
    unsigned long long tmask = 0ull;
#pragma unroll
    for (int n = 0; n < 16; ++n) if ((blocks >> n) & 1u) tmask |= 0xFull << (4 * n);
    f32x16 o[4]; float m_reg = -1e30f, l_reg = 0.f; float dummy[32];
#pragma unroll
    for (int d = 0; d < 4; ++d) o[d] = f32x16{};
    attn_tiles<false>(lds, qr, pb + O_MK + h * 128, pb + O_MV + h * 128, NP, tmask, pos, trow, trow + 31, WINF, (unsigned long long)sel, 8, o, m_reg, l_reg, dummy);
    const float il = 1.f / l_reg;
    if (hi == 0) li_l[r32] = il;
    asm volatile("s_waitcnt lgkmcnt(0)" ::: "memory");
    bf16* mixed = (bf16*)(P.ws + WS_MIXED) + (size_t)(b * SEQ + trow) * DM + h * 128;
    const bf16* zb = pb + (size_t)trow * NP + O_MZ + h * 128;
#pragma unroll
    for (int rh = 0; rh < 2; ++rh) {
        float zv[8][4];
#pragma unroll
        for (int q = 0; q < 8; ++q) { const int rw = crow(rh * 8 + q, hi);
#pragma unroll
            for (int d0 = 0; d0 < 4; ++d0) zv[q][d0] = bf2f(zb[(size_t)rw * NP + d0 * 32 + r32]); }
#pragma unroll
        for (int q = 0; q < 8; ++q) { const int r = rh * 8 + q, rw = crow(r, hi); const float s = li_l[rw];
#pragma unroll
            for (int d0 = 0; d0 < 4; ++d0) { const int col = d0 * 32 + r32;
                const float v = o[d0][r] * s * siluf_(zv[q][d0]);
                const float vn = __shfl_xor(v, 1);
                if ((r32 & 1) == 0) *(unsigned*)(mixed + (size_t)rw * DM + col) = cvtpk(v, vn); } }
        asm volatile("" ::: "memory");
    }
}
#undef KSWZ
#undef SBAR
}

namespace s5 {
typedef float f32x16 __attribute__((ext_vector_type(16)));
typedef float f32x2 __attribute__((ext_vector_type(2)));
constexpr int KT_ELEMS = 65 * 256, KT_BYTES = KT_ELEMS * 2, PF_ELEMS = 131072;
constexpr int UCOL = 2064, XCOL = 272, SROW = 129;
constexpr int L_U = 0, L_KT = 32 * UCOL, L_S = L_KT + KT_BYTES, L_XB = L_S + 32 * SROW * 4, L_CARRY = L_XB + 32 * XCOL, L_END = L_CARRY + 512;
static_assert(L_END <= 147456 && (L_KT % 16) == 0 && (L_S % 16) == 0 && (L_XB % 16) == 0, "s5 lds map");

__device__ __forceinline__ void tables_task(const Params& P, LAS unsigned char* lds, const int l, const int g, const int part) {
    const int tid = otid();
    LAS f32x2* pw = (LAS f32x2*)lds;
    LAS f32x2* fz = (LAS f32x2*)(lds + 65 * 64 * 8);
    __syncthreads();
    if (tid < 64) {
        const int p = tid;
        const double dt = exp((double)P.in[23][l * 64 + g]);
        const double ar = P.in[16][l * 4096 + g * 64 + p], ai = P.in[17][l * 4096 + g * 64 + p];
        const double mag = exp(dt * ar);
        double sn, cs; dsincos(dt * ai, sn, cs);
        const double abr = mag * cs, abi = mag * sn;
        const double nr = abr - 1.0, ni = abi, den = ar * ar + ai * ai;
        fz[p] = (f32x2){(float)((nr * ar + ni * ai) / den), (float)((ni * ar - nr * ai) / den)};
        double pr = 1.0, pi = 0.0;
        for (int n = 0; n <= 64; ++n) { pw[n * 64 + p] = (f32x2){(float)pr, (float)pi}; const double t = pr * abr - pi * abi; pi = pr * abi + pi * abr; pr = t; }
        if (part == 0) ((f32x2*)(P.ws + WS_S5AL))[(l * 64 + g) * 64 + p] = pw[64 * 64 + p];
    }
    __syncthreads();
    LAS float* bre = (LAS float*)(lds + 65 * 64 * 8 + 512);
    LAS float* bim = bre + 1024;
    LAS float* cre = bim + 1024;
    LAS float* cim = cre + 1024;
    { const float* gb = P.in[18] + (size_t)l * 65536 + g * 1024; const float* gbi = P.in[19] + (size_t)l * 65536 + g * 1024;
      const float* gc = P.in[20] + (size_t)l * 65536 + g * 1024; const float* gci = P.in[21] + (size_t)l * 65536 + g * 1024;
      for (int i = tid; i < 1024; i += 512) { bre[i] = gb[i]; bim[i] = gbi[i]; cre[i] = gc[i]; cim[i] = gci[i]; } }
    __syncthreads();
    bf16* P1 = (bf16*)(P.ws + WS_S5P1) + (size_t)(l * 64 + g) * PF_ELEMS;
    bf16* P2 = (bf16*)(P.ws + WS_S5P2) + (size_t)(l * 64 + g) * PF_ELEMS;
    bf16* KT = (bf16*)(P.ws + WS_S5K) + (size_t)(l * 64 + g) * KT_ELEMS;
    if (part == 0) for (int fl = tid; fl < 16384; fl += 512) {
        const int lane = fl & 63, ks = (fl >> 6) & 63, mb = fl >> 12;
        const int row = 32 * mb + (lane & 31), p = row & 63, isim = row >> 6, c0 = 8 * (lane >> 5);
        const f32x2 w = pw[(63 - ks) * 64 + p], f = fz[p];
        const float zr = w.x * f.x - w.y * f.y, zi = w.x * f.y + w.y * f.x;
        float v[8];
#pragma unroll
        for (int j = 0; j < 8; ++j) { const float br = bre[p * 16 + c0 + j], bi = bim[p * 16 + c0 + j]; v[j] = isim ? (zr * bi + zi * br) : (zr * br - zi * bi); }
        u32x4 o; o.x = pg8::cvt_pk_bf16(v[0], v[1]); o.y = pg8::cvt_pk_bf16(v[2], v[3]); o.z = pg8::cvt_pk_bf16(v[4], v[5]); o.w = pg8::cvt_pk_bf16(v[6], v[7]);
        *(u32x4*)(P1 + (size_t)fl * 8) = o;
    }
    if (part == 1) for (int fl = tid; fl < 16384; fl += 512) {
        const int lane = fl & 63, ks = (fl >> 6) & 7, rb = fl >> 9;
        const int r = lane & 31, t = 2 * rb + (r >> 4), c = r & 15, kk0 = 16 * ks + 8 * (lane >> 5);
        float v[8];
#pragma unroll
        for (int j = 0; j < 8; ++j) { const int kk = kk0 + j, p = kk & 63; const f32x2 w = pw[(t + 1) * 64 + p];
            const float cr = cre[c * 64 + p], ci = cim[c * 64 + p];
            v[j] = (kk >> 6) ? -(cr * w.y + ci * w.x) : (cr * w.x - ci * w.y); }
        u32x4 o; o.x = pg8::cvt_pk_bf16(v[0], v[1]); o.y = pg8::cvt_pk_bf16(v[2], v[3]); o.z = pg8::cvt_pk_bf16(v[4], v[5]); o.w = pg8::cvt_pk_bf16(v[6], v[7]);
        *(u32x4*)(P2 + (size_t)fl * 8) = o;
    }
    if (part >= 2) for (int pr_ = (part - 2) * 512 + tid; pr_ < (part - 1) * 512; pr_ += 512) {
        const int tau = pr_ >> 4, c = pr_ & 15;
        float acc[16];
#pragma unroll
        for (int j = 0; j < 16; ++j) acc[j] = 0.f;
        for (int p = 0; p < 64; ++p) {
            const f32x2 w = pw[tau * 64 + p], f = fz[p];
            const float zr = w.x * f.x - w.y * f.y, zi = w.x * f.y + w.y * f.x;
            const float cr = cre[c * 64 + p], ci = cim[c * 64 + p];
            const float czr = cr * zr - ci * zi, czi = cr * zi + ci * zr;
#pragma unroll
            for (int q = 0; q < 4; ++q) { const f32x4 br4 = *(const LAS f32x4*)(bre + p * 16 + 4 * q), bi4 = *(const LAS f32x4*)(bim + p * 16 + 4 * q);
#pragma unroll
                for (int e = 0; e < 4; ++e) acc[4 * q + e] += czr * br4[e] - czi * bi4[e]; }
        }
        u32x4 o0, o1; o0.x = pg8::cvt_pk_bf16(acc[0], acc[1]); o0.y = pg8::cvt_pk_bf16(acc[2], acc[3]); o0.z = pg8::cvt_pk_bf16(acc[4], acc[5]); o0.w = pg8::cvt_pk_bf16(acc[6], acc[7]);
        o1.x = pg8::cvt_pk_bf16(acc[8], acc[9]); o1.y = pg8::cvt_pk_bf16(acc[10], acc[11]); o1.z = pg8::cvt_pk_bf16(acc[12], acc[13]); o1.w = pg8::cvt_pk_bf16(acc[14], acc[15]);
        u32x4* dst = (u32x4*)(KT + (size_t)(tau + 1) * 256 + c * 16); dst[0] = o0; dst[1] = o1;
    }
    if (part == 2 && tid < 32) ((u32x4*)KT)[tid] = (u32x4){0u, 0u, 0u, 0u};
}

__device__ __forceinline__ void unit(const Params& P, LAS unsigned char* lds, const int l, const int b, const int g) {
    const int tid = otid(), wid = __builtin_amdgcn_readfirstlane(tid >> 6), lane = tid & 63, n32 = lane & 31, hi = lane >> 5;
    const bf16* KT = (const bf16*)(P.ws + WS_S5K) + (size_t)(l * 64 + g) * KT_ELEMS;
    const bf16x8* P1 = (const bf16x8*)((const bf16*)(P.ws + WS_S5P1) + (size_t)(l * 64 + g) * PF_ELEMS);
    const bf16x8* P2 = (const bf16x8*)((const bf16*)(P.ws + WS_S5P2) + (size_t)(l * 64 + g) * PF_ELEMS);
    const f32x2* AL = (const f32x2*)(P.ws + WS_S5AL) + (l * 64 + g) * 64;
    const bf16* ub = (const bf16*)(P.out + SUG_OFF) + (size_t)(b * 64 + g) * SEQ * 16;
    bf16* yb = (bf16*)(P.ws + WS_Y5) + (size_t)b * SEQ * 1024 + g * 16;
    const float* dsk = P.in[22] + l * 1024 + g * 16;
    LAS float* Sl = (LAS float*)(lds + L_S);
    LAS float* car = (LAS float*)(lds + L_CARRY);
    __syncthreads();
    { u32x4 kt[5];
#pragma unroll
      for (int it = 0; it < 5; ++it) { const int i = tid + 512 * it; if (i < KT_BYTES / 16) kt[it] = ((const u32x4*)KT)[i]; }
      __builtin_amdgcn_sched_barrier(0);
#pragma unroll
      for (int it = 0; it < 5; ++it) { const int i = tid + 512 * it; if (i < KT_BYTES / 16) ((LAS u32x4*)(lds + L_KT))[i] = kt[it]; } }
    const f32x4 dvA = *(const f32x4*)(dsk + 4 * hi), dvB = *(const f32x4*)(dsk + 8 + 4 * hi);
    if (tid < 128) car[tid] = 0.f;
    u32x4 ua0[4], ua1[4];
#define S5_LOADU(hh_) do { _Pragma("unroll") for (int it = 0; it < 4; ++it) { const int rr = tid + 512 * it, n = rr >> 6, s = rr & 63; \
        const u32x4* src = (const u32x4*)(ub + (size_t)((32 * (hh_) + n) * 64 + s) * 16); ua0[it] = src[0]; ua1[it] = src[1]; } } while (0)
    S5_LOADU(0);
    for (int hh = 0; hh < 2; ++hh) {
        __builtin_amdgcn_sched_barrier(0);
#pragma unroll
        for (int it = 0; it < 4; ++it) { const int rr = tid + 512 * it, n = rr >> 6, s = rr & 63;
            *(LAS u32x4*)(lds + L_U + n * UCOL + s * 32) = ua0[it]; *(LAS u32x4*)(lds + L_U + n * UCOL + s * 32 + 16) = ua1[it]; }
        __syncthreads();
        {
            const int mb = wid & 3, kh = wid >> 2;
            f32x16 acc0 = f32x16{}, acc1 = f32x16{};
            const bf16x8* pa = P1 + (size_t)(mb * 64 + kh * 32) * 64 + lane;
            LAS const unsigned char* ua = lds + L_U + n32 * UCOL + hi * 16 + kh * 32 * 32;
#pragma unroll 1
            for (int kb = 0; kb < 4; ++kb) {
                const bf16x8* qa = pa + 4 * 64;
                bf16x8 fa[8];
#pragma unroll
                for (int i = 0; i < 4; ++i) { fa[i] = pa[i * 64]; fa[4 + i] = qa[i * 64]; }
                __builtin_amdgcn_sched_barrier(0);
#pragma unroll
                for (int i = 0; i < 8; i += 2) {
                    acc0 = __builtin_amdgcn_mfma_f32_32x32x16_bf16(fa[i], *(LAS const bf16x8*)(ua + i * 32), acc0, 0, 0, 0);
                    acc1 = __builtin_amdgcn_mfma_f32_32x32x16_bf16(fa[i + 1], *(LAS const bf16x8*)(ua + (i + 1) * 32), acc1, 0, 0, 0); }
                __builtin_amdgcn_sched_barrier(0);
                pa += 8 * 64; ua += 8 * 32;
            }
            acc0 += acc1;
            if (kh == 1) {
#pragma unroll
                for (int r = 0; r < 16; ++r) Sl[n32 * SROW + 32 * mb + (r & 3) + 8 * (r >> 2) + 4 * hi] = acc0[r];
            }
            __syncthreads();
            if (kh == 0) {
#pragma unroll
                for (int r = 0; r < 16; ++r) Sl[n32 * SROW + 32 * mb + (r & 3) + 8 * (r >> 2) + 4 * hi] += acc0[r];
            }
        }
        __syncthreads();
        if (tid < 64) {
            const int p = tid; const f32x2 al = AL[p];
            float xr = car[p], xi = car[64 + p];
            float sre[32], sim[32];
#pragma unroll
            for (int n = 0; n < 32; ++n) { sre[n] = Sl[n * SROW + p]; sim[n] = Sl[n * SROW + 64 + p]; }
#pragma unroll
            for (int n = 0; n < 32; ++n) {
                *(LAS bf16*)(lds + L_XB + n * XCOL + p * 2) = (bf16)f2bf(xr); *(LAS bf16*)(lds + L_XB + n * XCOL + (64 + p) * 2) = (bf16)f2bf(xi);
                const float nx = al.x * xr - al.y * xi + sre[n], ni = al.x * xi + al.y * xr + sim[n]; xr = nx; xi = ni; }
            car[p] = xr; car[64 + p] = xi;
        }
        __syncthreads();
        if (hh == 0) { S5_LOADU(1); __builtin_amdgcn_sched_barrier(0); }
        for (int q4 = 0; q4 < 4; ++q4) {
            const int rb = (q4 == 0) ? wid : (q4 == 1) ? 15 - wid : (q4 == 2) ? 16 + wid : 31 - wid;
            const int t0 = 2 * rb;
            f32x16 acc = f32x16{};
            bf16x8 pf[8];
            { const bf16x8* p2 = P2 + (size_t)(rb * 8) * 64 + lane;
#pragma unroll
              for (int ks = 0; ks < 8; ++ks) pf[ks] = p2[ks * 64]; }
            LAS const unsigned char* ka = lds + L_KT + (t0 + 1) * 512 + n32 * 32 + hi * 16;
            LAS const unsigned char* ua = lds + L_U + n32 * UCOL + hi * 16;
            f32x16 acc2 = f32x16{};
#pragma unroll 4
            for (int s0 = 0; s0 <= t0 + 1; s0 += 2) {
                acc = __builtin_amdgcn_mfma_f32_32x32x16_bf16(*(LAS const bf16x8*)(ka - s0 * 512), *(LAS const bf16x8*)(ua + s0 * 32), acc, 0, 0, 0);
                acc2 = __builtin_amdgcn_mfma_f32_32x32x16_bf16(*(LAS const bf16x8*)(ka - (s0 + 1) * 512), *(LAS const bf16x8*)(ua + (s0 + 1) * 32), acc2, 0, 0, 0); }
            LAS const unsigned char* xa = lds + L_XB + n32 * XCOL + hi * 16;
#pragma unroll
            for (int ks = 0; ks < 8; ks += 2) {
                acc = __builtin_amdgcn_mfma_f32_32x32x16_bf16(pf[ks], *(LAS const bf16x8*)(xa + ks * 32), acc, 0, 0, 0);
                acc2 = __builtin_amdgcn_mfma_f32_32x32x16_bf16(pf[ks + 1], *(LAS const bf16x8*)(xa + (ks + 1) * 32), acc2, 0, 0, 0); }
            acc += acc2;
#pragma unroll
            for (int r4 = 0; r4 < 4; ++r4) {
                const int t = t0 + (r4 >> 1), c0 = 8 * (r4 & 1) + 4 * hi;
                const u32x2 uw = *(LAS const u32x2*)(lds + L_U + n32 * UCOL + t * 32 + c0 * 2);
                const f32x4 dv = (r4 & 1) ? dvB : dvA;
                const float u0 = __uint_as_float(uw.x << 16), u1 = __uint_as_float(uw.x & 0xffff0000u), u2 = __uint_as_float(uw.y << 16), u3 = __uint_as_float(uw.y & 0xffff0000u);
                const float y0 = geluf_(acc[4 * r4 + 0] + dv[0] * u0), y1 = geluf_(acc[4 * r4 + 1] + dv[1] * u1);
                const float y2 = geluf_(acc[4 * r4 + 2] + dv[2] * u2), y3 = geluf_(acc[4 * r4 + 3] + dv[3] * u3);
                u32x2 w; w.x = pk2(y0, y1); w.y = pk2(y2, y3);
                *(u32x2*)(yb + (size_t)((32 * hh + n32) * 64 + t) * 1024 + c0) = w;
            }
        }
        __syncthreads();
    }
#undef S5_LOADU
}
}

namespace a1 {
typedef float f32x16 __attribute__((ext_vector_type(16)));
__device__ __forceinline__ void norm_task(const Params& P, LAS unsigned char* lds, const int l, const int blk, const int vec) {
    const int tid = otid(), wid = __builtin_amdgcn_readfirstlane(tid >> 6), lane = tid & 63;
    int off; const float* nw;
    if (vec < 4) { off = O_MQ + vec * 128; nw = P.in[4]; }
    else if (vec < 8) { off = O_MK + (vec - 4) * 128; nw = P.in[5]; }
    else if (vec < 12) { off = O_NQ + (vec - 8) * 128; nw = P.in[6]; }
    else if (vec == 12) { off = O_KS; nw = P.in[8]; }
    else { off = O_KW; nw = P.in[9]; }
    nw += l * 128;
    const float2* cs = (const float2*)(P.ws + WS_ROPE);
    bf16* base = (bf16*)(P.ws + WS_PROJ) + (size_t)(blk * 256 + wid * 32) * NP + off;
    const int pos0 = (blk * 256 + wid * 32) % SEQ;
    const float wa = nw[lane], wb = nw[lane + 64];
    float sa = 0.f, sb = 0.f;
#pragma unroll 4
    for (int i = 0; i < 32; ++i) {
        bf16* v = base + (size_t)i * NP;
        float a = bf2f(v[lane]), b = bf2f(v[lane + 64]);
        const float ss = wave_sum(a * a + b * b);
        const float r = 1.0f / sqrtf(ss * (1.0f / 128.0f) + EPSN);
        a = a * r * wa; b = b * r * wb;
        const float other = __shfl_xor(a, 16);
        if (lane < 32) { const float2 c = cs[(pos0 + i) * 16 + (lane & 15)]; a = (lane < 16) ? (a * c.x - other * c.y) : (a * c.x + other * c.y); }
        v[lane] = (bf16)f2bf(a); v[lane + 64] = (bf16)f2bf(b);
        sa += a; sb += b;
    }
    if (vec >= 4 && vec < 8) {
        LAS float* red = (LAS float*)lds;
        red[wid * 128 + lane] = sa; red[wid * 128 + lane + 64] = sb;
        __syncthreads();
        if (tid < 128) { float s = 0.f;
#pragma unroll
            for (int w = 0; w < 8; ++w) s += red[w * 128 + tid];
            const int b = blk >> 4, n = blk & 15, h = vec - 4;
            ((float*)(P.ws + WS_KMEAN))[((size_t)(b * 4 + h) * 16 + n) * 128 + tid] = s * (1.0f / 256.0f); }
    }
}
__device__ __forceinline__ void gates_task(const Params& P, LAS unsigned char* lds, const int l, const int task) {
    const int tid = otid(), wid = __builtin_amdgcn_readfirstlane(tid >> 6), lane = tid & 63, r32 = lane & 31, hi = lane >> 5;
    const bf16* xb = (const bf16*)(P.ws + WS_XB) + (size_t)(task * 64 + r32) * DM + wid * 256 + 8 * hi;
    const bf16x8* wf = (const bf16x8*)(P.ws + WS_WGF) + ((size_t)l * 128 + wid * 16) * 64 + lane;
    f32x16 acc0 = f32x16{}, acc1 = f32x16{};
#pragma unroll 1
    for (int kb = 0; kb < 2; ++kb) {
        bf16x8 a0[8], a1[8], bw[8];
        const bf16* xq = xb + (size_t)32 * DM;
#pragma unroll
        for (int k = 0; k < 8; ++k) { a0[k] = *(const bf16x8*)(xb + 16 * k); a1[k] = *(const bf16x8*)(xq + 16 * k); bw[k] = wf[k * 64]; }
        __builtin_amdgcn_sched_barrier(0);
#pragma unroll
        for (int k = 0; k < 8; ++k) { acc0 = __builtin_amdgcn_mfma_f32_32x32x16_bf16(a0[k], bw[k], acc0, 0, 0, 0); acc1 = __builtin_amdgcn_mfma_f32_32x32x16_bf16(a1[k], bw[k], acc1, 0, 0, 0); }
        __builtin_amdgcn_sched_barrier(0);
        xb += 128; wf += 8 * 64;
    }
    LAS float* red = (LAS float*)lds;
    LAS float* rsl = red + 8 * 64 * 12;
    if (r32 < 12) {
#pragma unroll
        for (int r = 0; r < 16; ++r) { const int rw = (r & 3) + 8 * (r >> 2) + 4 * hi;
            red[(wid * 64 + rw) * 12 + r32] = acc0[r]; red[(wid * 64 + 32 + rw) * 12 + r32] = acc1[r]; }
    }
    if (tid < 64) rsl[tid] = ((const float*)(P.ws + WS_RS))[task * 64 + tid];
    __syncthreads();
    for (int i = tid; i < 64 * 12; i += 512) { float s = 0.f;
#pragma unroll
        for (int w = 0; w < 8; ++w) s += red[w * 768 + i];
        ((float*)(P.ws + WS_GATES))[(size_t)task * 768 + i] = sigmoidf_(s * rsl[i / 12]); }
}
__device__ __forceinline__ void cmp_task(const Params& P, LAS unsigned char* lds, const int l, const int which, const int b, const int nb) {
    const int tid = otid(), wid = __builtin_amdgcn_readfirstlane(tid >> 6), lane = tid & 63, r32 = lane & 31, hi = lane >> 5;
    const int n0 = 32 * nb, cb = wid & 3, kh = wid >> 2;
    LAS float* red = (LAS float*)lds;
    LAS bf16* hid = (LAS bf16*)(lds + 4 * 32 * 33 * 4);
    LAS float* ot = (LAS float*)(lds + 4 * 32 * 33 * 4 + 32 * 136 * 2);
    {
        const int n = min(n0 + r32, NCMP - 1);
        const bf16* tokbase = (const bf16*)(P.ws + WS_PROJ) + (size_t)(b * SEQ + 16 * n) * NP + (which ? O_VC : O_KC) + 8 * hi;
        const bf16x8* wf = (const bf16x8*)(P.ws + WS_W1F) + ((size_t)((l * 2 + which) * 4 + cb) * 256 + kh * 128) * 64 + lane;
        const bf16* tok = tokbase + (size_t)(kh * 16) * NP;
        f32x16 acc = f32x16{}, acc2 = f32x16{};
#pragma unroll 1
        for (int t = 0; t < 16; ++t) {
            bf16x8 A[8], Bf[8];
            const bf16x8* wq = wf + 4 * 64;
#pragma unroll
            for (int k = 0; k < 4; ++k) { A[k] = *(const bf16x8*)(tok + k * 16); A[4 + k] = *(const bf16x8*)(tok + (4 + k) * 16); Bf[k] = wf[k * 64]; Bf[4 + k] = wq[k * 64]; }
            __builtin_amdgcn_sched_barrier(0);
#pragma unroll
            for (int k = 0; k < 8; k += 2) { acc = __builtin_amdgcn_mfma_f32_32x32x16_bf16(A[k], Bf[k], acc, 0, 0, 0); acc2 = __builtin_amdgcn_mfma_f32_32x32x16_bf16(A[k + 1], Bf[k + 1], acc2, 0, 0, 0); }
            __builtin_amdgcn_sched_barrier(0);
            tok += NP; wf += 8 * 64;
        }
        acc += acc2;
        if (kh == 1) {
#pragma unroll
            for (int r = 0; r < 16; ++r) red[(cb * 32 + (r & 3) + 8 * (r >> 2) + 4 * hi) * 33 + r32] = acc[r];
        }
        __syncthreads();
        if (kh == 0) { float cst = 0.f;
            { const float* cp = (const float*)(P.ws + WS_CST) + (size_t)((l * 2 + which) * 64) * 128 + cb * 32 + r32;
#pragma unroll 8
              for (int sl = 0; sl < 64; ++sl) cst += cp[sl * 128]; }
#pragma unroll
            for (int r = 0; r < 16; ++r) { const int rw = (r & 3) + 8 * (r >> 2) + 4 * hi;
                hid[rw * 136 + cb * 32 + r32] = (bf16)f2bf(geluf_(acc[r] + red[(cb * 32 + rw) * 33 + r32] + cst)); } }
        __syncthreads();
    }
    if (wid < 4) {
        const bf16x8* w2f = (const bf16x8*)(P.ws + WS_W2F) + ((size_t)((l * 2 + which) * 4 + wid) * 8) * 64 + lane;
        f32x16 acc = f32x16{};
#pragma unroll
        for (int ks = 0; ks < 8; ++ks) acc = __builtin_amdgcn_mfma_f32_32x32x16_bf16(*(const LAS bf16x8*)(hid + r32 * 136 + 16 * ks + 8 * hi), w2f[ks * 64], acc, 0, 0, 0);
#pragma unroll
        for (int r = 0; r < 16; ++r) ot[((r & 3) + 8 * (r >> 2) + 4 * hi) * 132 + wid * 32 + r32] = acc[r];
    }
    __syncthreads();
    {
        const int r = tid >> 4, jg = tid & 15, j2 = jg * 8;
        float o[8];
        { const f32x4 oa = *(const LAS f32x4*)(ot + r * 132 + j2), ob = *(const LAS f32x4*)(ot + r * 132 + j2 + 4);
#pragma unroll
          for (int e = 0; e < 4; ++e) { o[e] = oa[e]; o[4 + e] = ob[e]; } }
        const int n = n0 + r;
        if (which == 0) {
            float ss = 0.f;
#pragma unroll
            for (int e = 0; e < 8; ++e) ss += o[e] * o[e];
            ss += __shfl_xor(ss, 1); ss += __shfl_xor(ss, 2); ss += __shfl_xor(ss, 4); ss += __shfl_xor(ss, 8);
            const float rs = 1.0f / sqrtf(ss * (1.0f / 128.0f) + EPSN);
            const float* kcn = P.in[7] + l * 128 + j2;
            const float2* cs = (const float2*)(P.ws + WS_ROPE) + (size_t)min(16 * n + 31, SEQ - 1) * 16 + (jg & 1) * 8;
#pragma unroll
            for (int e = 0; e < 8; ++e) { o[e] = o[e] * rs * kcn[e];
                const float other = __shfl_xor(o[e], 2);
                if (jg < 4) { const float2 c = cs[e]; o[e] = (jg < 2) ? (o[e] * c.x - other * c.y) : (o[e] * c.x + other * c.y); } }
        }
        u32x4 w; w.x = pk2(o[0], o[1]); w.y = pk2(o[2], o[3]); w.z = pk2(o[4], o[5]); w.w = pk2(o[6], o[7]);
        if (n >= NCMP) w = (u32x4){0u, 0u, 0u, 0u};
        *(u32x4*)((bf16*)(P.ws + WS_CMPB) + ((size_t)(which * NB + b) * 256 + n) * 128 + j2) = w;
    }
}
__device__ __forceinline__ void prep_w1(const Params& P, LAS unsigned char* lds) {
    const int tid = otid();
    const int gt = blockIdx.x * 512 + tid, GT = gridDim.x * 512;
    for (int fl = gt; fl < NL * 2 * 65536; fl += GT) {
        const int lw = fl >> 16, rem = fl & 65535, lane = rem & 63, ks = (rem >> 6) & 255, cb = rem >> 14;
        const float* w1 = P.in[(lw & 1) ? 14 : 12] + (size_t)(lw >> 1) * 4096 * 128;
        const float* src = w1 + (size_t)(16 * ks + 8 * (lane >> 5)) * 128 + 32 * cb + (lane & 31);
        u32x4 o; o.x = pk2(src[0], src[128]); o.y = pk2(src[256], src[384]); o.z = pk2(src[512], src[640]); o.w = pk2(src[768], src[896]);
        *(u32x4*)((bf16*)(P.ws + WS_W1F) + (size_t)fl * 8) = o;
    }
    for (int fl = gt; fl < NL * 2 * 4 * 8 * 64; fl += GT) {
        const int lw = fl >> 11, cb = (fl >> 9) & 3, ks = (fl >> 6) & 7, lane = fl & 63;
        const float* w2 = P.in[(lw & 1) ? 15 : 13] + (size_t)(lw >> 1) * 16384 + (size_t)(16 * ks + 8 * (lane >> 5)) * 128 + 32 * cb + (lane & 31);
        u32x4 o; o.x = pk2(w2[0], w2[128]); o.y = pk2(w2[256], w2[384]); o.z = pk2(w2[512], w2[640]); o.w = pk2(w2[768], w2[896]);
        *(u32x4*)((bf16*)(P.ws + WS_W2F) + (size_t)fl * 8) = o;
    }
    for (int fl = gt; fl < NL * 128 * 64; fl += GT) {
        const int l = fl >> 13, ks = (fl >> 6) & 127, lane = fl & 63, n = lane & 31, k0 = 16 * ks + 8 * (lane >> 5);
        float v[8];
#pragma unroll
        for (int e = 0; e < 8; ++e) v[e] = (n < 12) ? P.in[1][l * DM + k0 + e] * P.in[2][(size_t)l * DM * INW + (size_t)(k0 + e) * INW + SRC_NG + n] : 0.f;
        u32x4 o; o.x = pk2(v[0], v[1]); o.y = pk2(v[2], v[3]); o.z = pk2(v[4], v[5]); o.w = pk2(v[6], v[7]);
        *(u32x4*)((bf16*)(P.ws + WS_WGF) + (size_t)fl * 8) = o;
    }
    for (int t = blockIdx.x; t < NL * 2 * 64; t += gridDim.x) {
        const int lw = t >> 6, sl = t & 63;
        const float* w1 = P.in[(lw & 1) ? 14 : 12] + (size_t)(lw >> 1) * 4096 * 128;
        const float* pe = P.in[(lw & 1) ? 11 : 10] + (size_t)(lw >> 1) * 4096;
        const int j = tid & 127, kq = tid >> 7;
        float s = 0.f;
#pragma unroll
        for (int i = 0; i < 16; ++i) { const int k = sl * 64 + kq * 16 + i; s += pe[k] * w1[(size_t)k * 128 + j]; }
        LAS float* red = (LAS float*)lds;
        __syncthreads();
        red[tid] = s;
        __syncthreads();
        if (tid < 128) ((float*)(P.ws + WS_CST))[(size_t)t * 128 + tid] = (red[tid] + red[128 + tid]) + (red[256 + tid] + red[384 + tid]);
    }
}
}

__device__ __forceinline__ void unit_done(unsigned* cnt) {
    asm volatile("s_waitcnt vmcnt(0)" ::: "memory");
    __syncthreads();
    if (otid() == 0) { __builtin_amdgcn_fence(__ATOMIC_RELEASE, "agent"); asm volatile("s_waitcnt vmcnt(0)" ::: "memory");
        __hip_atomic_fetch_add(cnt, 1u, __ATOMIC_RELAXED, __HIP_MEMORY_SCOPE_AGENT); }
}
__device__ __forceinline__ void unit_wait(unsigned* cnt, unsigned target) {
    if (otid() == 0) { unsigned sp = 0u;
        while (__hip_atomic_load(cnt, __ATOMIC_RELAXED, __HIP_MEMORY_SCOPE_AGENT) < target) { __builtin_amdgcn_s_sleep(4); if (++sp > (1u << 22)) break; }
        __builtin_amdgcn_fence(__ATOMIC_ACQUIRE, "agent"); asm volatile("s_waitcnt vmcnt(0)" ::: "memory"); }
    __syncthreads();
}
struct OneUnit { int pm, pn; __device__ __forceinline__ bool next(int i, pg8::Unit& u) const { if (i != 0) return false; u.pm = pm; u.pn = pn; return true; } };

__device__ __forceinline__ void phase_mid(const Params& P, LAS unsigned char* lds, int l) {
    unsigned* ctl = (unsigned*)(P.ws + WS_CTL) + 64 * 8 * l;
    const int* order = (const int*)(P.ws + WS_ORDER);
    LAS int* slot = (LAS int*)(lds + LDS_BYTES - 64);
    bool small_ok = false; unsigned s5_ok = 0u;
    for (;;) {
        __syncthreads();
        if (otid() == 0) slot[0] = (int)__hip_atomic_fetch_add(ctl, 1u, __ATOMIC_RELAXED, __HIP_MEMORY_SCOPE_AGENT);
        __syncthreads();
        const int u = slot[0];
        if (u >= 1344) break;
        if (u < 64) { a1::cmp_task(P, lds, l, u >> 5, (u >> 3) & 3, u & 7); unit_done(ctl + 64); }
        else if (u < 320) { a1::gates_task(P, lds, l, u - 64); unit_done(ctl + 64); }
        else if (u < 576) { const int v = u - 320; s5::unit(P, lds, l, v >> 6, v & 63); unit_done(ctl + 128 + 64 * (v >> 6)); }
        else if (u < 1088) { const int id = order[u - 576];
            if (id < 256) { if (!small_ok) { unit_wait(ctl + 64, 320u); small_ok = true; } att::nsa_unit(P, lds, id >> 6, id & 63); }
            else { const int v = id - 256; att::moba_unit(P, lds, v >> 6, (v >> 4) & 3, v & 15); } }
        else { const int t = u - 1088, pm = t >> 2, b = pm >> 4;
            if (!((s5_ok >> b) & 1u)) { unit_wait(ctl + 128 + 64 * b, 64u); s5_ok |= 1u << b; }
            pg8::Gemm g{(const bf16*)(P.ws + WS_Y5), (const bf16*)(P.ws + WS_GLU + l * GLU_BYTES), NT, 1024, 1024, 1024};
            OneUnit S{pm, t & 3};
            EpiGlu E{(bf16*)(P.ws + WS_MIXED), (const bf16*)(P.ws + WS_Y5), (const bf16*)(P.ws + WS_PROJ)};
            pg8::gemm_phase<EpiGlu, OneUnit>(lds, g, S, E); }
    }
}

#define XB_TMO      128
#define XB_XCNT(j)  (256  + 64 * (j))
#define XB_XSUB(j)  (1280 + 64 * (j))
#define XB_XGEN(j)  (2304 + 64 * (j))
#define XB_TOP      3328
#define XB_TOPGEN   3392
#define XCD_BAR_WORDS 3456
#define XB_SPIN_CAP (1u << 18)
__device__ __forceinline__ unsigned xb_ld(unsigned* p)              { return __hip_atomic_load(p, __ATOMIC_RELAXED, __HIP_MEMORY_SCOPE_AGENT); }
__device__ __forceinline__ unsigned xb_add(unsigned* p, unsigned v) { return __hip_atomic_fetch_add(p, v, __ATOMIC_RELAXED, __HIP_MEMORY_SCOPE_AGENT); }
__device__ __forceinline__ unsigned xb_xcc_id() { return (unsigned)__builtin_amdgcn_s_getreg((3 << 11) | 20) & 0xFu; }
#define XB_SPIN(cond, bar) do { unsigned _sp = 0; while (cond) { __builtin_amdgcn_s_sleep(1); \
    if ((++_sp & 255u) == 0u) { if (xb_ld(&(bar)[XB_TMO])) break; if (_sp > XB_SPIN_CAP) { atomicAdd(&(bar)[XB_TMO], 1u); break; } } } } while (0)
struct XcdBarrier { unsigned* bar; unsigned x; volatile LAS unsigned* st; };
__device__ __forceinline__ XcdBarrier xcd_barrier_post(unsigned* bar, volatile LAS unsigned* st) {
    XcdBarrier b; b.bar = bar; b.x = xb_xcc_id(); b.st = st;
    if (threadIdx.x == 0) (void)xb_add(&bar[XB_XCNT(b.x)], 1u);
    return b;
}
__device__ __forceinline__ void xcd_barrier_complete(unsigned* bar, unsigned x, unsigned& nloc, unsigned& nx) {
    const unsigned G = gridDim.x * gridDim.y * gridDim.z;
    unsigned sum, cnt, mine, sp = 0u;
    for (;;) {
        sum = 0u; cnt = 0u; mine = 0u;
#pragma unroll
        for (unsigned j = 0; j < 16; ++j) { const unsigned c = xb_ld(&bar[XB_XCNT(j)]); sum += c; cnt += (c > 0u) ? 1u : 0u; mine = (j == x) ? c : mine; }
        if (sum == G) break;
        __builtin_amdgcn_s_sleep(1);
        if ((++sp & 255u) == 0u) { if (xb_ld(&bar[XB_TMO])) break; if (sp > XB_SPIN_CAP) { atomicAdd(&bar[XB_TMO], 1u); break; } }
    }
    nloc = mine > 0u ? mine : 1u; nx = cnt > 0u ? cnt : 1u;
}
__device__ __forceinline__ void xcd_barrier(const XcdBarrier& b) {
    asm volatile("s_waitcnt vmcnt(0)" ::: "memory");
    __syncthreads();
    if (threadIdx.x == 0) {
        unsigned* bar = b.bar;
        __builtin_amdgcn_s_waitcnt(0);
        unsigned nloc = b.st[0], nx = b.st[1];
        if (nloc == 0u) { xcd_barrier_complete(bar, b.x, nloc, nx); b.st[0] = nloc; b.st[1] = nx; }
        const unsigned old = xb_add(&bar[XB_XSUB(b.x)], 1u);
        const unsigned gen = old / nloc;
        if (old + 1u == (gen + 1u) * nloc) {
            __builtin_amdgcn_fence(__ATOMIC_RELEASE, "agent");
            asm volatile("s_waitcnt vmcnt(0)" ::: "memory");
            const unsigned og = xb_add(&bar[XB_TOP], 1u);
            const unsigned tg = og / nx;
            if (og + 1u == (tg + 1u) * nx) xb_add(&bar[XB_TOPGEN], 1u);
            else XB_SPIN(xb_ld(&bar[XB_TOPGEN]) == tg, bar);
            __builtin_amdgcn_fence(__ATOMIC_ACQUIRE, "agent");
            xb_add(&bar[XB_XGEN(b.x)], 1u);
            asm volatile("s_waitcnt vmcnt(0)" ::: "memory");
        } else {
            XB_SPIN(xb_ld(&bar[XB_XGEN(b.x)]) == gen, bar);
            __builtin_amdgcn_fence(__ATOMIC_ACQUIRE, "agent");
            asm volatile("s_waitcnt vmcnt(0)" ::: "memory");
        }
    }
    __syncthreads();
}

__global__ void __launch_bounds__(512, 2) k_mega(Params P) {
    extern __shared__ __attribute__((aligned(16))) unsigned char lds_raw[];
    LAS unsigned char* lds = (LAS unsigned char*)lds_raw;
    const int lo = P.ph_lo, hi = P.ph_hi;
#define IN(k) (lo <= (k) && (k) < hi)
    volatile LAS unsigned* bst = (volatile LAS unsigned*)(lds + LDS_BYTES - 32);
    if (threadIdx.x < 2) bst[threadIdx.x] = 0u;
    __syncthreads();
    const XcdBarrier bar = xcd_barrier_post((unsigned*)(P.ws + WS_CTL) + 4096, bst);
#define SEAM(k) do { if (IN(k) && IN((k) + 1)) xcd_barrier(bar); } while (0)
    if (IN(0)) phase_prep(P, lds);
    SEAM(0);
    for (int l = 0; l < NL; ++l) {
        if (IN(1 + 3 * l)) phase_gemm1(P, lds, l);
        SEAM(1 + 3 * l);
        if (IN(2 + 3 * l)) phase_mid(P, lds, l);
        SEAM(2 + 3 * l);
        if (IN(3 + 3 * l)) phase_out(P, lds, l);
        SEAM(3 + 3 * l);
    }
#undef SEAM
#undef IN
}

extern "C" void kernel_launch(void* const* d_in, const int* in_sizes, int n_in, void* d_out, int out_size, void* d_ws, size_t ws_size, hipStream_t stream) {
    static int grid = 0;
    if (grid == 0) {
        if (ws_size < WS_END) { fprintf(stderr, "kernel_launch: workspace too small (%zu < %zu)\n", ws_size, (size_t)WS_END); grid = -1; return; }
        int dev = 0, cus = 0;
        hipGetDevice(&dev); hipDeviceGetAttribute(&cus, hipDeviceAttributeMultiprocessorCount, dev);
        hipFuncSetAttribute((const void*)k_mega, hipFuncAttributeMaxDynamicSharedMemorySize, LDS_BYTES);
        int per_cu = 0;
        hipOccupancyMaxActiveBlocksPerMultiprocessor(&per_cu, (const void*)k_mega, 512, LDS_BYTES);
        if (per_cu < 1) { fprintf(stderr, "kernel_launch: occupancy query says %d blocks per CU\n", per_cu); per_cu = 1; }
        grid = (cus > 0 ? cus : 256) * 1;
    }
    if (grid < 0) return;
    unsigned char* ws = (unsigned char*)d_ws;
    Params P{};
    for (int i = 0; i < 25; ++i) P.in[i] = (const float*)d_in[i];
    P.out = (float*)d_out; P.ws = ws;
    hipMemsetAsync(ws + WS_CTL, 0, 32768, stream);
    P.ph_lo = 0; P.ph_hi = 7;
    void* args[] = {&P};
    hipError_t e = hipLaunchCooperativeKernel((const void*)k_mega, dim3(grid), dim3(512), args, LDS_BYTES, stream);
    if (e != hipSuccess) fprintf(stderr, "kernel_launch: cooperative launch failed: %s (grid %d)\n", hipGetErrorString(e), grid);
}
```

```cpp
#include <hip/hip_runtime.h>
#include <stdint.h>
#include <cstdio>

typedef unsigned short bf16;
typedef short bf16x8 __attribute__((ext_vector_type(8)));
typedef float f32x4 __attribute__((ext_vector_type(4)));
typedef unsigned u32x4 __attribute__((ext_vector_type(4)));
typedef unsigned u32x2 __attribute__((ext_vector_type(2)));
#define LAS __attribute__((address_space(3)))
__device__ __forceinline__ int otid() { int t = threadIdx.x; asm volatile("" : "+v"(t)); return t; }

constexpr int NB = 4, SEQ = 4096, DM = 2048, NT = NB * SEQ, NL = 2;
constexpr int INW = 5900;
constexpr int NP = 5888;
constexpr int O_MQ = 0, O_MK = 512, O_MV = 1024, O_MZ = 1536, O_NQ = 2048, O_KC = 2560, O_VC = 2688, O_KS = 2816, O_VS = 2944,
              O_KW = 3072, O_VW = 3200, O_NZ = 3328, O_SU = 3840, O_SZ = 4864;
constexpr int SRC_NG = 3328;
constexpr int NCMP = 255;
constexpr float EPSN = 1e-6f;
constexpr float SCALE = 0.08838834764831845f;

constexpr size_t MiB = 1u << 20;
constexpr size_t WS_CTL = 0;
constexpr size_t WS_WIN = 1 * MiB;
constexpr size_t WIN_BYTES = (size_t)NP * DM * 2;
constexpr size_t WS_WOUT = WS_WIN + 2 * WIN_BYTES;
constexpr size_t WOUT_BYTES = (size_t)DM * DM * 2;
constexpr size_t WS_GLU = WS_WOUT + 2 * WOUT_BYTES;
constexpr size_t GLU_BYTES = (size_t)1024 * 1024 * 2;
constexpr size_t WS_XB = WS_GLU + 2 * GLU_BYTES;
constexpr size_t WS_PROJ = WS_XB + (size_t)NT * DM * 2;
constexpr size_t WS_MIXED = WS_PROJ + (size_t)NT * NP * 2;
constexpr size_t WS_Y5 = WS_MIXED + (size_t)NT * DM * 2;
constexpr size_t WS_SSQP = WS_Y5 + (size_t)NT * 1024 * 2;
constexpr size_t WS_GATES = WS_SSQP + (size_t)NT * 32 * 4;
constexpr size_t WS_ROPE = WS_GATES + 1 * MiB;
constexpr size_t WS_RS = WS_ROPE + 512 * 1024;
constexpr size_t WS_KMEAN = WS_ROPE + 1 * MiB;
constexpr size_t WS_CMP = WS_KMEAN + 1 * MiB;
constexpr size_t WS_HID = WS_CMP + 1 * MiB;
constexpr size_t WS_CMPB = WS_HID + 1 * MiB;
constexpr size_t WS_ORDER = WS_CMPB + 1 * MiB;
constexpr size_t WS_S5K = WS_ORDER + 1 * MiB;
constexpr size_t WS_S5P1 = WS_S5K + 5 * MiB;
constexpr size_t WS_S5P2 = WS_S5P1 + 32 * MiB;
constexpr size_t WS_S5AL = WS_S5P2 + 32 * MiB;
constexpr size_t WS_W1F = WS_S5AL + 1 * MiB;
constexpr size_t WS_CST = WS_W1F + 4 * MiB;
constexpr size_t WS_WGF = WS_CST + 1 * MiB;
constexpr size_t WS_W2F = WS_WGF + 1 * MiB;
constexpr size_t WS_END = WS_W2F + 1 * MiB;
static_assert(WS_END <= 536870912ull, "workspace map exceeds 512 MiB");
constexpr size_t SUG_OFF = (size_t)256 * 256 * 128;

__device__ const double INVF[16] = {1.0, 0.44036660267178046, 0.19392274474868576, 0.08539710028576561, 0.03760603093086393,
    0.016560440080994446, 0.007292664737217109, 0.003211445994752591, 0.001414213562373095, 0.000622772421914596,
    0.0002742481756762073, 0.00012076973741146504, 5.318295896944988e-05, 2.341999896140934e-05, 1.031338537721246e-05,
    4.5416704806078695e-06};

__device__ __forceinline__ void dsincos(double a, double& s, double& c) {
    const double k = rint(a * 0.63661977236758134308);
    double r = fma(-k, 1.57079632679489655800e+00, a);
    r = fma(-k, 6.12323399573676603587e-17, r);
    const double r2 = r * r;
    double sp = 1.0 / 6227020800.0;
    sp = fma(sp, r2, -1.0 / 39916800.0); sp = fma(sp, r2, 1.0 / 362880.0); sp = fma(sp, r2, -1.0 / 5040.0);
    sp = fma(sp, r2, 1.0 / 120.0); sp = fma(sp, r2, -1.0 / 6.0); sp = fma(sp, r2, 1.0);
    const double sn = sp * r;
    double cp = -1.0 / 87178291200.0;
    cp = fma(cp, r2, 1.0 / 479001600.0); cp = fma(cp, r2, -1.0 / 3628800.0); cp = fma(cp, r2, 1.0 / 40320.0);
    cp = fma(cp, r2, -1.0 / 720.0); cp = fma(cp, r2, 1.0 / 24.0); cp = fma(cp, r2, -0.5); cp = fma(cp, r2, 1.0);
    const long long q = (long long)k & 3;
    if (q == 0) { s = sn; c = cp; } else if (q == 1) { s = cp; c = -sn; } else if (q == 2) { s = -sn; c = -cp; } else { s = -cp; c = sn; }
}
__device__ __forceinline__ float wave_sum(float v) {
#pragma unroll
    for (int o = 1; o < 64; o <<= 1) v += __shfl_xor(v, o);
    return v;
}
__device__ __forceinline__ float wave_max(float v) {
#pragma unroll
    for (int o = 1; o < 64; o <<= 1) v = fmaxf(v, __shfl_xor(v, o));
    return v;
}
__device__ __forceinline__ float sigmoidf_(float x) { return __builtin_amdgcn_rcpf(1.0f + __builtin_amdgcn_exp2f(-1.4426950408889634f * x)); }
__device__ __forceinline__ float siluf_(float x) { return x * sigmoidf_(x); }
__device__ __forceinline__ float geluf_(float x) { return x * sigmoidf_(1.5957691216057308f * (x + 0.044715f * x * x * x)); }
__device__ __forceinline__ float bf2f(bf16 b) { return __uint_as_float((unsigned)b << 16); }
__device__ __forceinline__ unsigned f2bf(float f) { const unsigned u = __float_as_uint(f); return (u + 0x7fffu + ((u >> 16) & 1u)) >> 16; }
__device__ __forceinline__ unsigned pk2(float lo, float hi) { return f2bf(lo) | (f2bf(hi) << 16); }
__device__ __forceinline__ float2 ld2(const bf16* p, int lane) { const unsigned w = ((const unsigned*)p)[lane]; return make_float2(__uint_as_float(w << 16), __uint_as_float(w & 0xffff0000u)); }

namespace pg8 {
constexpr int BM = 256, BK = 64, HALF = 128, HTB = HALF * BK * 2, STAGE_BYTES = 8 * HTB, NXCD = 8, WGM = 8;
__host__ __device__ __forceinline__ int lds_byte(int r, int c) { const int st = (r >> 4) * 2 + (c >> 5), rr = r & 15, cc = c & 31, ob = rr * 64 + cc * 2; return st * 1024 + (ob ^ (((ob >> 9) & 1) << 5)); }
__host__ __device__ __forceinline__ void stage_rc(int b, int& R, int& C) { const int st = b / 1024, sb = b % 1024, swz = sb ^ (((sb >> 9) & 1) << 5); R = (st >> 1) * 16 + swz / 64; C = (st & 1) * 32 + (swz % 64) / 2; }
__host__ __device__ __forceinline__ int perm32(int rho) { const int n = rho >> 4, i = rho & 15; return 8 * (i >> 2) + 4 * n + (i & 3); }
struct Unit { int pm, pn; };
struct Gemm { const bf16* A; const bf16* Bt; int M, N, K, lda; };
struct StaticOrder {
    int nM, nN, nwg, G, c, permN;
    __host__ __device__ void init(int M, int N, int G_, int c_, int permN_ = 0) { nM = M / BM; nN = N / BM; nwg = nM * nN; G = G_; c = c_; permN = permN_; }
    __host__ __device__ bool next(int i, Unit& u) const {
        const long L = (long)i * G + c; if (L >= nwg) return false;
        int wgid = (int)L; { const int q = nwg / NXCD, r = nwg % NXCD, xcd = wgid % NXCD, off = wgid / NXCD; wgid = (xcd < r ? xcd * (q + 1) : r * (q + 1) + (xcd - r) * q) + off; }
        const int nig = WGM * nN, gid = wgid / nig, fm = gid * WGM, gsz = (nM - fm) < WGM ? (nM - fm) : WGM;
        u.pm = fm + ((wgid % nig) % gsz); u.pn = (wgid % nig) / gsz;
        if (permN) u.pn = (int)((u.pn < 12 ? (0x14dc50c9a403169ull >> (5 * u.pn)) : (0x5a2a456071d1e6ull >> (5 * (u.pn - 12)))) & 31ull);
        return true;
    }
};
__device__ __forceinline__ unsigned cvt_pk_bf16(float lo, float hi) { unsigned r; asm volatile("v_cvt_pk_bf16_f32 %0, %1, %2" : "=v"(r) : "v"(lo), "v"(hi)); return r; }

template <class Epi, class Sched>
__device__ __forceinline__ void gemm_phase(LAS unsigned char* lds, const Gemm g, const Sched& S, const Epi& E) {
    constexpr bool ALIGN_EPI = true;
    const int tid = otid(), wid = __builtin_amdgcn_readfirstlane(tid >> 6), lane = tid & 63, wr = wid >> 2, wc = wid & 3, fr = lane & 15, fq = lane >> 4;
    const int K = g.K, nt = K / BK;
    unsigned voffA[2], voffB[2];
#pragma unroll
    for (int i = 0; i < 2; ++i) { int R, C; stage_rc(tid * 16 + i * 8192, R, C); const int Rb = Epi::PERM ? ((R & ~31) + perm32(R & 31)) : R;
        voffA[i] = (unsigned)(R * g.lda + C) * 2u; voffB[i] = (unsigned)(Rb * K + C) * 2u; }
    const size_t kstep = (size_t)(BK * 2);
    const size_t hstepA = (size_t)HALF * g.lda * 2, hstepB = (size_t)HALF * K * 2;
    const size_t tstepA = 2 * hstepA, tstepB = 2 * hstepB;
    const unsigned ldsw = (unsigned)wid * 1024u;
    const int aoff = lds_byte(wr * 64 + fr, fq * 8), boff = lds_byte(wc * 32 + fr, fq * 8);
#define PG8_SA(b, h) (((b) * 2 + (h)) * HTB)
#define PG8_SB(b, h) ((4 + (b) * 2 + (h)) * HTB)
#define PG8_STAGE(bufoff, gbase, voff) do { _Pragma("unroll") for (int _i = 0; _i < 2; ++_i) \
        __builtin_amdgcn_global_load_lds((const unsigned*)((const char*)(gbase) + (voff)[_i]), (LAS unsigned*)(lds + (bufoff) + ldsw + _i * 8192), 16, 0, 0); } while (0)
#define PG8_LDA(dst, b, h) do { _Pragma("unroll") for (int m = 0; m < 4; ++m) _Pragma("unroll") for (int k = 0; k < 2; ++k) dst[m][k] = *(const LAS bf16x8*)(lds + PG8_SA(b, h) + aoff + m * 2048 + k * 1024); } while (0)
#define PG8_LDB(dst, b, h) do { _Pragma("unroll") for (int n = 0; n < 2; ++n) _Pragma("unroll") for (int k = 0; k < 2; ++k) dst[n][k] = *(const LAS bf16x8*)(lds + PG8_SB(b, h) + boff + n * 2048 + k * 1024); } while (0)
#define PG8_MMA(ai, bj, At, Bt) do { __builtin_amdgcn_s_setprio(1); _Pragma("unroll") for (int m = 0; m < 4; ++m) _Pragma("unroll") for (int n = 0; n < 2; ++n) _Pragma("unroll") for (int k = 0; k < 2; ++k) \
        acc[ai][bj][m][n] = __builtin_amdgcn_mfma_f32_16x16x32_bf16(Bt[n][k], At[m][k], acc[ai][bj][m][n], 0, 0, 0); __builtin_amdgcn_s_setprio(0); } while (0)
#define PG8_WAIT_V(n) asm volatile("s_waitcnt vmcnt(" #n ")" ::: "memory")
#define PG8_WAIT_L(n) asm volatile("s_waitcnt lgkmcnt(" #n ")" ::: "memory")
#define PG8_BAR __builtin_amdgcn_s_barrier()
#define PG8_SCHED __builtin_amdgcn_sched_barrier(0)
    Unit cur, nxt; int ui = 0;
    if (!S.next(0, cur)) return;
    typename Epi::Pre pre = E.pre(cur, wr), pren = pre;
    f32x4 acc[2][2][4][2];
#pragma unroll
    for (int a = 0; a < 2; ++a)
#pragma unroll
        for (int b = 0; b < 2; ++b)
#pragma unroll
            for (int m = 0; m < 4; ++m)
#pragma unroll
                for (int n = 0; n < 2; ++n) acc[a][b][m][n] = (f32x4){0.f, 0.f, 0.f, 0.f};
    bf16x8 At[4][2], B0[2][2], B1[2][2];
    const char* cA = (const char*)g.A + (size_t)cur.pm * tstepA; const char* cB = (const char*)g.Bt + (size_t)cur.pn * tstepB;
    PG8_STAGE(PG8_SB(0, 0), cB, voffB); PG8_STAGE(PG8_SB(0, 1), cB + hstepB, voffB); PG8_STAGE(PG8_SA(0, 0), cA, voffA); PG8_STAGE(PG8_SA(0, 1), cA + hstepA, voffA);
    if (wr == 1) PG8_BAR;
    PG8_WAIT_V(2); PG8_BAR;
    PG8_STAGE(PG8_SB(1, 0), cB + kstep, voffB); PG8_STAGE(PG8_SA(1, 0), cA + kstep, voffA); PG8_STAGE(PG8_SB(1, 1), cB + hstepB + kstep, voffB);
    PG8_WAIT_V(6); PG8_BAR;
    for (;;) {
        const bool has_next = S.next(ui + 1, nxt);
        const char* nA = has_next ? (const char*)g.A + (size_t)nxt.pm * tstepA : cA; const char* nB = has_next ? (const char*)g.Bt + (size_t)nxt.pn * tstepB : cB;
        for (int t = 0; t < nt; t += 2) {
            const bool last = (t == nt - 2);
            const char* a1 = cA + (size_t)(t + 1) * kstep;
            const char* a2 = last ? nA : cA + (size_t)(t + 2) * kstep; const char* b2 = last ? nB : cB + (size_t)(t + 2) * kstep;
            const char* a3 = a2 + kstep; const char* b3 = b2 + kstep;
            PG8_LDB(B0, 0, 0); PG8_LDB(B1, 0, 1); PG8_SCHED; PG8_LDA(At, 0, 0); PG8_STAGE(PG8_SA(1, 1), a1 + hstepA, voffA);
            PG8_WAIT_V(8); PG8_WAIT_L(0); PG8_BAR; PG8_MMA(0, 0, At, B0); PG8_MMA(0, 1, At, B1); PG8_BAR; PG8_SCHED;
            PG8_LDA(At, 0, 1); PG8_STAGE(PG8_SB(0, 0), b2, voffB); PG8_STAGE(PG8_SB(0, 1), b2 + hstepB, voffB); PG8_STAGE(PG8_SA(0, 0), a2, voffA);
            PG8_WAIT_V(8); PG8_WAIT_L(0); PG8_BAR; PG8_MMA(1, 0, At, B0); PG8_MMA(1, 1, At, B1); PG8_BAR; PG8_SCHED;
            PG8_LDB(B0, 1, 0); PG8_LDB(B1, 1, 1); PG8_SCHED; PG8_LDA(At, 1, 0); PG8_STAGE(PG8_SA(0, 1), a2 + hstepA, voffA);
            PG8_WAIT_V(8); PG8_WAIT_L(0); PG8_BAR; PG8_MMA(0, 0, At, B0); PG8_MMA(0, 1, At, B1); PG8_BAR; PG8_SCHED;
            PG8_LDA(At, 1, 1); PG8_STAGE(PG8_SB(1, 0), b3, voffB); PG8_STAGE(PG8_SB(1, 1), b3 + hstepB, voffB); PG8_STAGE(PG8_SA(1, 0), a3, voffA);
            PG8_WAIT_V(8); PG8_WAIT_L(0); PG8_BAR; PG8_MMA(1, 0, At, B0); PG8_MMA(1, 1, At, B1); PG8_BAR; PG8_SCHED;
        }
        if constexpr (ALIGN_EPI) { if (wr == 0) PG8_BAR; }
        if (has_next) pren = E.pre(nxt, wr);
        E(acc, cur, wr, wc, fr, fq, pre);
        if (!has_next) break;
        pre = pren;
#pragma unroll
        for (int a = 0; a < 2; ++a)
#pragma unroll
            for (int b = 0; b < 2; ++b)
#pragma unroll
                for (int m = 0; m < 4; ++m)
#pragma unroll
                    for (int n = 0; n < 2; ++n) acc[a][b][m][n] = (f32x4){0.f, 0.f, 0.f, 0.f};
        cur = nxt; cA = nA; cB = nB; ++ui;
        if constexpr (ALIGN_EPI) { if (wr == 1) PG8_BAR; }
    }
    PG8_WAIT_V(0);
    if constexpr (!ALIGN_EPI) { if (wr == 0) PG8_BAR; }
    PG8_BAR;
#undef PG8_SA
#undef PG8_SB
#undef PG8_STAGE
#undef PG8_LDA
#undef PG8_LDB
#undef PG8_MMA
#undef PG8_WAIT_V
#undef PG8_WAIT_L
#undef PG8_BAR
#undef PG8_SCHED
}
}

struct EpiProj {
    static constexpr bool PERM = true;
    bf16* O; bf16* ug; const float* rs; const float *nw0, *nw1, *nw2, *nw3, *nw4; const float2* cs; float* kmean; LAS unsigned char* xl;
    struct Pre { float r0, r1; };
    __device__ __forceinline__ Pre pre(const pg8::Unit& u, int wr) const { const float* p = rs + u.pm * 256 + 64 * wr + (otid() & 63); Pre q; q.r0 = p[0]; q.r1 = p[128]; return q; }
    __device__ __forceinline__ static int nid(int h) { return h < 4 ? 0 : h < 8 ? 1 : (h >= 16 && h < 20) ? 2 : h == 22 ? 3 : h == 24 ? 4 : -1; }
    __device__ __forceinline__ void operator()(const f32x4 (&acc)[2][2][4][2], const pg8::Unit& u, int wr, int wc, int fr, int fq, const Pre& pr) const {
        const float rsv[2] = {pr.r0, pr.r1};
        const int row0 = u.pm * 256 + wr * 64 + fr, col0 = u.pn * 256 + wc * 32 + 8 * fq;
        const int n0 = nid(2 * u.pn), n1 = nid(2 * u.pn + 1);
        if (n0 < 0 && n1 < 0) {
            const bool su = (u.pn >= O_SU / 256) && (u.pn < O_SZ / 256);
            const int cs0 = col0 - O_SU;
#pragma unroll
            for (int ai = 0; ai < 2; ++ai)
#pragma unroll
                for (int m = 0; m < 4; ++m) {
                    const float r = __shfl(rsv[ai], m * 16 + fr);
                    const int row = row0 + ai * 128 + m * 16;
                    bf16* rowp = su ? ug + (((size_t)((row >> 12) * 64 + (cs0 >> 4)) * SEQ + (row & (SEQ - 1))) * 16 + (cs0 & 8)) : O + (size_t)row * NP + col0;
                    const size_t bjs = su ? (size_t)8 * SEQ * 16 : (size_t)128;
#pragma unroll
                    for (int bj = 0; bj < 2; ++bj) { const f32x4 v0 = acc[ai][bj][m][0] * r, v1 = acc[ai][bj][m][1] * r;
                        u32x4 w; w.x = pg8::cvt_pk_bf16(v0[0], v0[1]); w.y = pg8::cvt_pk_bf16(v0[2], v0[3]); w.z = pg8::cvt_pk_bf16(v1[0], v1[1]); w.w = pg8::cvt_pk_bf16(v1[2], v1[3]);
                        *(u32x4*)(rowp + bj * bjs) = w; }
                }
            return;
        }
        LAS float* part = (LAS float*)xl;
        LAS float* ksum = (LAS float*)(xl + 8192);
#pragma unroll
        for (int ai = 0; ai < 2; ++ai)
#pragma unroll
            for (int m = 0; m < 4; ++m) {
                const float r = __shfl(rsv[ai], m * 16 + fr);
#pragma unroll
                for (int bj = 0; bj < 2; ++bj) { const f32x4 v0 = acc[ai][bj][m][0] * r, v1 = acc[ai][bj][m][1] * r;
                    float ss = (v0[0] * v0[0] + v0[1] * v0[1]) + (v0[2] * v0[2] + v0[3] * v0[3]) + (v1[0] * v1[0] + v1[1] * v1[1]) + (v1[2] * v1[2] + v1[3] * v1[3]);
                    ss += __shfl_xor(ss, 16); ss += __shfl_xor(ss, 32);
                    if (fq == 0) part[((ai * 128 + wr * 64 + m * 16 + fr) * 2 + bj) * 4 + wc] = ss; }
            }
        asm volatile("s_waitcnt lgkmcnt(0)" ::: "memory"); __builtin_amdgcn_s_barrier(); asm volatile("" ::: "memory");
        float csum[2][8];
#pragma unroll
        for (int bj = 0; bj < 2; ++bj)
#pragma unroll
            for (int e = 0; e < 8; ++e) csum[bj][e] = 0.f;
        f32x4 wq[2][2];
#pragma unroll
        for (int bj = 0; bj < 2; ++bj) { const int ni = bj ? n1 : n0;
            const float* wp = (ni <= 0 ? nw0 : ni == 1 ? nw1 : ni == 2 ? nw2 : ni == 3 ? nw3 : nw4) + wc * 32 + 8 * fq;
            wq[bj][0] = *(const f32x4*)wp; wq[bj][1] = *(const f32x4*)(wp + 4); }
        f32x4 cnx[4];
        const int ol = otid() & 63, ofr = ol & 15, ofq1 = (ol >> 4) & 1;
        { const f32x4* c4 = (const f32x4*)(cs + (size_t)((u.pm * 256 + wr * 64 + ofr) & (SEQ - 1)) * 16 + 8 * ofq1);
#pragma unroll
          for (int q = 0; q < 4; ++q) cnx[q] = c4[q]; }
#pragma unroll
        for (int ai = 0; ai < 2; ++ai)
#pragma unroll
            for (int m = 0; m < 4; ++m) {
                const float r = __shfl(rsv[ai], m * 16 + fr);
                const int rl = ai * 128 + wr * 64 + m * 16 + fr;
                bf16* rowp = O + (size_t)(u.pm * 256 + rl) * NP + col0;
                f32x4 ccur[4];
#pragma unroll
                for (int q = 0; q < 4; ++q) ccur[q] = cnx[q];
                if (ai * 4 + m < 7) { const int rn_ = (ai * 4 + m + 1 >= 4 ? 128 : 0) + wr * 64 + ((ai * 4 + m + 1) & 3) * 16 + ofr;
                    const f32x4* c4 = (const f32x4*)(cs + (size_t)((u.pm * 256 + rn_) & (SEQ - 1)) * 16 + 8 * ofq1);
#pragma unroll
                    for (int q = 0; q < 4; ++q) cnx[q] = c4[q]; }
#pragma unroll
                for (int bj = 0; bj < 2; ++bj) {
                    const int ni = bj ? n1 : n0;
                    float v[8];
#pragma unroll
                    for (int e = 0; e < 8; ++e) v[e] = ((e < 4) ? acc[ai][bj][m][0][e & 3] : acc[ai][bj][m][1][e & 3]) * r;
                    if (ni >= 0) {
                        const f32x4 p4 = *(const LAS f32x4*)(part + (rl * 2 + bj) * 4);
                        const float rn = 1.0f / sqrtf(((p4[0] + p4[1]) + (p4[2] + p4[3])) * (1.0f / 128.0f) + EPSN);
#pragma unroll
                        for (int e = 0; e < 8; ++e) v[e] *= rn * ((e < 4) ? wq[bj][0][e & 3] : wq[bj][1][e & 3]);
                        if (wc == 0) {
#pragma unroll
                            for (int e = 0; e < 8; ++e) { const float other = __shfl_xor(v[e], 32); const float cx = ccur[e >> 1][2 * (e & 1)], cy = ccur[e >> 1][2 * (e & 1) + 1];
                                v[e] = (fq < 2) ? (v[e] * cx - other * cy) : (v[e] * cx + other * cy); }
                        }
                        if (ni == 1) {
#pragma unroll
                            for (int e = 0; e < 8; ++e) csum[bj][e] += v[e];
                        }
                    }
                    u32x4 w; w.x = pg8::cvt_pk_bf16(v[0], v[1]); w.y = pg8::cvt_pk_bf16(v[2], v[3]); w.z = pg8::cvt_pk_bf16(v[4], v[5]); w.w = pg8::cvt_pk_bf16(v[6], v[7]);
                    *(u32x4*)(rowp + bj * 128) = w;
                }
                asm volatile("" ::: "memory");
            }
        if (n0 == 1) {
#pragma unroll
            for (int bj = 0; bj < 2; ++bj)
#pragma unroll
                for (int e = 0; e < 8; ++e) { float s = csum[bj][e]; s += __shfl_xor(s, 1); s += __shfl_xor(s, 2); s += __shfl_xor(s, 4); s += __shfl_xor(s, 8);
                    if (fr == 0) ksum[wr * 256 + bj * 128 + wc * 32 + 8 * fq + e] = s; }
            asm volatile("s_waitcnt lgkmcnt(0)" ::: "memory"); __builtin_amdgcn_s_barrier(); asm volatile("" ::: "memory");
            const int tid = otid();
            if (tid < 256) { const int h = 2 * u.pn + (tid >> 7) - 4, b = u.pm >> 4, n = u.pm & 15;
                kmean[((size_t)(b * 4 + h) * 16 + n) * 128 + (tid & 127)] = (ksum[tid] + ksum[256 + tid]) * (1.0f / 256.0f); }
        }
    }
};
struct EpiGlu {
    static constexpr bool PERM = true;
    bf16* mixed; const bf16* y5; const bf16* proj;
    struct Pre {};
    __device__ __forceinline__ Pre pre(const pg8::Unit&, int) const { return Pre{}; }
    __device__ __forceinline__ void operator()(const f32x4 (&acc)[2][2][4][2], const pg8::Unit& u, int wr, int wc, int fr, int fq, const Pre&) const {
        const int row0 = u.pm * 256 + wr * 64 + fr, col0 = u.pn * 256 + wc * 32 + 8 * fq;
#pragma unroll
        for (int ai = 0; ai < 2; ++ai) {
            u32x4 yv[4][2], zv[4][2];
#pragma unroll
            for (int m = 0; m < 4; ++m)
#pragma unroll
                for (int bj = 0; bj < 2; ++bj) { const size_t row = (size_t)(row0 + ai * 128 + m * 16); const int col = col0 + bj * 128;
                    yv[m][bj] = *(const u32x4*)(y5 + row * 1024 + col); zv[m][bj] = *(const u32x4*)(proj + row * NP + O_SZ + col); }
            asm volatile("" ::: "memory");
#pragma unroll
            for (int m = 0; m < 4; ++m) {
                const size_t row = (size_t)(row0 + ai * 128 + m * 16);
#pragma unroll
                for (int bj = 0; bj < 2; ++bj) {
                    const int col = col0 + bj * 128;
                    float o[8];
#pragma unroll
                    for (int e = 0; e < 8; ++e) {
                        const float a = (e < 4) ? acc[ai][bj][m][0][e & 3] : acc[ai][bj][m][1][e & 3];
                        const unsigned yw = yv[m][bj][e >> 1], zw = zv[m][bj][e >> 1];
                        const float y = (e & 1) ? __uint_as_float(yw & 0xffff0000u) : __uint_as_float(yw << 16);
                        const float z = (e & 1) ? __uint_as_float(zw & 0xffff0000u) : __uint_as_float(zw << 16);
                        o[e] = y * sigmoidf_(a) * siluf_(z);
                    }
                    u32x4 w; w.x = pg8::cvt_pk_bf16(o[0], o[1]); w.y = pg8::cvt_pk_bf16(o[2], o[3]); w.z = pg8::cvt_pk_bf16(o[4], o[5]); w.w = pg8::cvt_pk_bf16(o[6], o[7]);
                    *(u32x4*)(mixed + row * DM + 1024 + col) = w;
                }
            }
        }
    }
};
struct EpiOut {
    static constexpr bool PERM = true;
    float* out; bf16* xb; float* ssqp; int last; float* rs; unsigned* cnt; LAS unsigned* fl;
    struct Pre {};
    __device__ __forceinline__ Pre pre(const pg8::Unit&, int) const { return Pre{}; }
    __device__ __forceinline__ void operator()(const f32x4 (&acc)[2][2][4][2], const pg8::Unit& u, int wr, int wc, int fr, int fq, const Pre&) const {
        const int row0 = u.pm * 256 + wr * 64 + fr, col0 = u.pn * 256 + wc * 32 + 8 * fq;
#pragma unroll
        for (int ai = 0; ai < 2; ++ai) {
            u32x4 xv[4][2];
#pragma unroll
            for (int m = 0; m < 4; ++m)
#pragma unroll
                for (int bj = 0; bj < 2; ++bj) xv[m][bj] = *(const u32x4*)(xb + (size_t)(row0 + ai * 128 + m * 16) * DM + col0 + bj * 128);
            asm volatile("" ::: "memory");
#pragma unroll
            for (int m = 0; m < 4; ++m) {
                const size_t row = (size_t)(row0 + ai * 128 + m * 16);
                float ss = 0.f;
#pragma unroll
                for (int bj = 0; bj < 2; ++bj) {
                    const size_t off = row * DM + col0 + bj * 128;
                    const u32x4 xw = xv[m][bj];
                    f32x4 a, b;
                    a[0] = __uint_as_float(xw.x << 16) + acc[ai][bj][m][0][0]; a[1] = __uint_as_float(xw.x & 0xffff0000u) + acc[ai][bj][m][0][1];
                    a[2] = __uint_as_float(xw.y << 16) + acc[ai][bj][m][0][2]; a[3] = __uint_as_float(xw.y & 0xffff0000u) + acc[ai][bj][m][0][3];
                    b[0] = __uint_as_float(xw.z << 16) + acc[ai][bj][m][1][0]; b[1] = __uint_as_float(xw.z & 0xffff0000u) + acc[ai][bj][m][1][1];
                    b[2] = __uint_as_float(xw.w << 16) + acc[ai][bj][m][1][2]; b[3] = __uint_as_float(xw.w & 0xffff0000u) + acc[ai][bj][m][1][3];
                    if (last) { *(f32x4*)(out + off) = a; *(f32x4*)(out + off + 4) = b; }
                    else {
                        ss += ((a[0] * a[0] + a[1] * a[1]) + (a[2] * a[2] + a[3] * a[3])) + ((b[0] * b[0] + b[1] * b[1]) + (b[2] * b[2] + b[3] * b[3]));
                        u32x4 w; w.x = pg8::cvt_pk_bf16(a[0], a[1]); w.y = pg8::cvt_pk_bf16(a[2], a[3]); w.z = pg8::cvt_pk_bf16(b[0], b[1]); w.w = pg8::cvt_pk_bf16(b[2], b[3]);
                        *(u32x4*)(xb + off) = w;
                    }
                }
                if (!last) {
                    ss += __shfl_xor(ss, 16); ss += __shfl_xor(ss, 32);
                    if (fq == 0) ssqp[row * 32 + u.pn * 4 + wc] = ss;
                }
            }
        }
        if (!last) {
            const int tid = otid();
            asm volatile("s_waitcnt vmcnt(0)" ::: "memory"); __builtin_amdgcn_s_barrier();
            if (tid == 0) { __builtin_amdgcn_fence(__ATOMIC_RELEASE, "agent"); asm volatile("s_waitcnt vmcnt(0)" ::: "memory");
                const unsigned old = __hip_atomic_fetch_add(cnt + u.pm, 1u, __ATOMIC_RELAXED, __HIP_MEMORY_SCOPE_AGENT);
                if (old == 7u) { __builtin_amdgcn_fence(__ATOMIC_ACQUIRE, "agent"); asm volatile("s_waitcnt vmcnt(0)" ::: "memory"); }
                fl[0] = old; }
            asm volatile("s_waitcnt lgkmcnt(0)" ::: "memory"); __builtin_amdgcn_s_barrier(); asm volatile("" ::: "memory");
            if (fl[0] == 7u) { asm volatile("; last arriver" ::: "memory");
                if (tid < 256) { const f32x4* sp = (const f32x4*)(ssqp + (size_t)(u.pm * 256 + tid) * 32); float s = 0.f;
#pragma unroll
                    for (int i = 0; i < 8; ++i) { const f32x4 v = sp[i]; s += (v[0] + v[1]) + (v[2] + v[3]); }
                    rs[u.pm * 256 + tid] = 1.0f / sqrtf(s * (1.0f / DM) + EPSN); }
            }
        }
    }
};

struct Params {
    const float* in[25];
    float* out;
    unsigned char* ws;
    int ph_lo, ph_hi;
};
constexpr int LDS_BYTES = 147456;
constexpr int NWAVES = 8;

namespace a1 { __device__ __forceinline__ void prep_w1(const Params& P, LAS unsigned char* lds); }
namespace s5 { __device__ __forceinline__ void tables_task(const Params& P, LAS unsigned char* lds, const int l, const int g, const int part); }
__device__ __forceinline__ void p0_transpose_item(const float* W, int ldsrc, int srccol0, int K, const float* kscale, bf16* WT, int n0, int k0, LAS float* scr, int lane) {
    float tv[32];
#pragma unroll
    for (int i = 0; i < 32; ++i) tv[i] = W[(size_t)(k0 + 2 * i + (lane >> 5)) * ldsrc + srccol0 + (lane & 31)];
#pragma unroll
    for (int i = 0; i < 32; ++i) { const int kk = 2 * i + (lane >> 5); float v = tv[i]; if (kscale) v *= kscale[k0 + kk]; scr[kk * 33 + (lane & 31)] = v; }
    asm volatile("s_waitcnt lgkmcnt(0)" ::: "memory");
    const int c = lane & 7;
#pragma unroll
    for (int j = 0; j < 4; ++j) { const int n = (lane >> 3) + 8 * j; const LAS float* s = scr + (8 * c) * 33 + n;
        u32x4 o; o.x = pk2(s[0 * 33], s[1 * 33]); o.y = pk2(s[2 * 33], s[3 * 33]); o.z = pk2(s[4 * 33], s[5 * 33]); o.w = pk2(s[6 * 33], s[7 * 33]);
        *(u32x4*)(WT + (size_t)(n0 + n) * K + k0 + 8 * c) = o; }
    asm volatile("s_waitcnt lgkmcnt(0)" ::: "memory");
}
__device__ __forceinline__ void phase_prep(const Params& P, LAS unsigned char* lds) {
    const int tid = otid(), lane = tid & 63, wave = tid >> 6;
    LAS float* scr = (LAS float*)(lds + wave * 16384);
    const int gw = blockIdx.x * NWAVES + wave, NGW = gridDim.x * NWAVES;
    constexpr int I_IN = (DM / 64) * (NP / 32), I_OUT = (DM / 64) * (DM / 32), I_GLU = (1024 / 64) * (1024 / 32);
    constexpr int PER_L = I_IN + I_OUT + I_GLU;
    for (int pass = 0; pass < 2; ++pass) {
    if ((pass == 0) == ((blockIdx.x & 1) == 0)) {
    for (int it = gw; it < NL * PER_L; it += NGW) {
        const int l = it / PER_L; int r = it % PER_L;
        if (r < I_IN) { const int nb = r % (NP / 32), kb = r / (NP / 32), n0 = nb * 32, src = n0 + (n0 >= SRC_NG ? 12 : 0);
            p0_transpose_item(P.in[2] + (size_t)l * DM * INW, INW, src, DM, P.in[1] + l * DM, (bf16*)(P.ws + WS_WIN + l * WIN_BYTES), n0, kb * 64, scr, lane); continue; }
        r -= I_IN;
        if (r < I_OUT) { const int nb = r % (DM / 32), kb = r / (DM / 32);
            p0_transpose_item(P.in[3] + (size_t)l * DM * DM, DM, nb * 32, DM, nullptr, (bf16*)(P.ws + WS_WOUT + l * WOUT_BYTES), nb * 32, kb * 64, scr, lane); continue; }
        r -= I_OUT;
        { const int nb = r % 32, kb = r / 32;
            p0_transpose_item(P.in[24] + (size_t)l * 1024 * 1024, 1024, nb * 32, 1024, nullptr, (bf16*)(P.ws + WS_GLU + l * GLU_BYTES), nb * 32, kb * 64, scr, lane); }
    }
    const float* x = P.in[0]; bf16* xb = (bf16*)(P.ws + WS_XB); float* rs = (float*)(P.ws + WS_RS);
    for (int m = gw; m < NT; m += NGW) {
        const f32x4* xr = (const f32x4*)(x + (size_t)m * DM) + lane;
        u32x2* o8 = (u32x2*)(xb + (size_t)m * DM) + lane;
        float s = 0.f;
        f32x4 xv[8];
#pragma unroll
        for (int j = 0; j < 8; ++j) xv[j] = xr[64 * j];
        __builtin_amdgcn_sched_barrier(0);
#pragma unroll
        for (int j = 0; j < 8; ++j) { const f32x4 v = xv[j]; s += (v[0] * v[0] + v[1] * v[1]) + (v[2] * v[2] + v[3] * v[3]); u32x2 w; w.x = pk2(v[0], v[1]); w.y = pk2(v[2], v[3]); o8[64 * j] = w; }
        __builtin_amdgcn_sched_barrier(0);
        s = wave_sum(s);
        if (lane == 0) rs[m] = 1.0f / sqrtf(s * (1.0f / DM) + EPSN);
    }
    float2* cs = (float2*)(P.ws + WS_ROPE);
    for (int i = blockIdx.x * blockDim.x + tid; i < SEQ * 16; i += gridDim.x * blockDim.x) {
        double s, c; dsincos((double)(i >> 4) * INVF[i & 15], s, c); cs[i] = make_float2((float)c, (float)s);
    }
    } else {
        for (int t = blockIdx.x; t < NL * 64 * 4; t += gridDim.x) s5::tables_task(P, lds, t >> 8, (t >> 2) & 63, t & 3);
    }
    __syncthreads();
    }
    a1::prep_w1(P, lds);
    if (blockIdx.x == 0) {
        int* order = (int*)(P.ws + WS_ORDER);
        const int u = tid; const int cu = (u < 256) ? (2 * (u & 63) + 46) : (8 * ((u - 256) & 15) + 9);
        int rank = 0;
        for (int v = 0; v < 512; ++v) { const int cv = (v < 256) ? (2 * (v & 63) + 46) : (8 * ((v - 256) & 15) + 9); rank += (cv > cu || (cv == cu && v < u)) ? 1 : 0; }
        order[rank] = u;
    }
}

__device__ __forceinline__ void phase_gemm1(const Params& P, LAS unsigned char* lds, int l) {
    pg8::Gemm g{(const bf16*)(P.ws + WS_XB), (const bf16*)(P.ws + WS_WIN + l * WIN_BYTES), NT, NP, DM, DM};
    pg8::StaticOrder S; S.init(NT, NP, gridDim.x, blockIdx.x, 1);
    EpiProj E{(bf16*)(P.ws + WS_PROJ), (bf16*)(P.out + SUG_OFF), (const float*)(P.ws + WS_RS), P.in[4] + l * 128, P.in[5] + l * 128, P.in[6] + l * 128, P.in[8] + l * 128, P.in[9] + l * 128,
              (const float2*)(P.ws + WS_ROPE), (float*)(P.ws + WS_KMEAN), lds + 131072};
    pg8::gemm_phase<EpiProj, pg8::StaticOrder>(lds, g, S, E);
}
__device__ __forceinline__ void phase_out(const Params& P, LAS unsigned char* lds, int l) {
    pg8::Gemm g{(const bf16*)(P.ws + WS_MIXED), (const bf16*)(P.ws + WS_WOUT + l * WOUT_BYTES), NT, DM, DM, DM};
    pg8::StaticOrder S; S.init(NT, DM, gridDim.x, blockIdx.x);
    EpiOut E{P.out, (bf16*)(P.ws + WS_XB), (float*)(P.ws + WS_SSQP), l == NL - 1 ? 1 : 0, (float*)(P.ws + WS_RS), (unsigned*)(P.ws + WS_CTL) + 2048 + 64 * l, (LAS unsigned*)(lds + 131072 + 12288)};
    pg8::gemm_phase<EpiOut, pg8::StaticOrder>(lds, g, S, E);
}

namespace att {
typedef short s16x4 __attribute__((ext_vector_type(4)));
typedef float f32x16 __attribute__((ext_vector_type(16)));
constexpr int SHM_K = 16384, SHM_V = 16384;
constexpr int OFF_V = 0, OFF_K = 2 * SHM_V, OFF_WS = 2 * SHM_V + 2 * SHM_K;
constexpr int OFF_X = OFF_WS + 8 * 256;
constexpr unsigned WINF = 0x7fffffffu;
constexpr float THR = 8.f;
#define KSWZ(row, colB) ((row) * 256 + ((colB) ^ (((row) & 7) << 4)))
#define SBAR() __builtin_amdgcn_sched_barrier(0)
__device__ __forceinline__ int v_st(int k, int c) { const int kk = (k & ~0xC) | ((k & 4) << 1) | ((k & 8) >> 1); return ((kk >> 3) * 4 + (c >> 5)) * 512 + ((kk & 7) * 32 + (c & 31)) * 2; }
__device__ __forceinline__ int v_rd_base(int lane) { return ((lane & 3) << 3) | (((lane >> 2) & 3) << 6) | (((lane >> 4) & 1) << 5) | (((lane >> 5) & 1) << 8); }
constexpr int v_rd_off(int d0, int ks, int half) { return d0 * 512 + ks * 4096 + half * 2048; }
__device__ __forceinline__ int crow(int r, int hi) { return (r & 3) + 8 * (r >> 2) + 4 * hi; }
__device__ __forceinline__ unsigned cvtpk(float lo, float hi) { unsigned r; asm volatile("v_cvt_pk_bf16_f32 %0, %1, %2" : "=v"(r) : "v"(lo), "v"(hi)); return r; }

__device__ __forceinline__ void mask_tile(f32x16& p0, f32x16& p1, int dq, unsigned W) {
    const float NEG = -__builtin_inff();
#pragma unroll
    for (int r = 0; r < 16; ++r) {
        const int c = (r & 3) + 8 * (r >> 2);
        if ((unsigned)(dq - c) >= W) p0[r] = NEG;
        if ((unsigned)(dq - c - 32) >= W) p1[r] = NEG;
    }
}
__device__ __forceinline__ void qkt(f32x16& p0, f32x16& p1, LAS const unsigned char* Kb, int r32, int hi, const bf16x8* qr) {
    p0 = f32x16{}; p1 = f32x16{};
    const int ka0 = (int)(uintptr_t)(Kb + KSWZ(r32, (0 * 16 + hi * 8) * 2)), ka1 = (int)(uintptr_t)(Kb + KSWZ(r32, (1 * 16 + hi * 8) * 2));
    const int ka2 = (int)(uintptr_t)(Kb + KSWZ(r32, (2 * 16 + hi * 8) * 2)), ka3 = (int)(uintptr_t)(Kb + KSWZ(r32, (3 * 16 + hi * 8) * 2));
#define Q_KR(dst, addr, off) asm volatile("ds_read_b128 %0, %1 offset:%2" : "=&v"(dst) : "v"(addr), "i"(off) : "memory")
#define Q_KRD(F, kaa, kab, hoff) do { Q_KR(F[0], kaa, hoff); Q_KR(F[1], kaa, hoff + 8192); Q_KR(F[2], kab, hoff); Q_KR(F[3], kab, hoff + 8192); } while (0)
#define Q_WAIT() do { asm volatile("s_waitcnt lgkmcnt(0)" ::: "memory"); SBAR(); } while (0)
#define Q_QK(F, q0) do { \
        p0 = __builtin_amdgcn_mfma_f32_32x32x16_bf16(F[0], qr[q0], p0, 0, 0, 0); p1 = __builtin_amdgcn_mfma_f32_32x32x16_bf16(F[1], qr[q0], p1, 0, 0, 0); \
        p0 = __builtin_amdgcn_mfma_f32_32x32x16_bf16(F[2], qr[q0 + 1], p0, 0, 0, 0); p1 = __builtin_amdgcn_mfma_f32_32x32x16_bf16(F[3], qr[q0 + 1], p1, 0, 0, 0); } while (0)
    bf16x8 FA[4], FB[4];
    Q_KRD(FA, ka0, ka1, 0); Q_WAIT();
    Q_KRD(FB, ka2, ka3, 0); Q_QK(FA, 0); Q_WAIT();
    Q_KRD(FA, ka0, ka1, 128); Q_QK(FB, 2); Q_WAIT();
    Q_KRD(FB, ka2, ka3, 128); Q_QK(FA, 4); Q_WAIT();
    Q_QK(FB, 6);
#undef Q_KR
#undef Q_KRD
#undef Q_WAIT
#undef Q_QK
}
__device__ __forceinline__ void pv_tile(f32x16* o, int vb, bf16x8 pa0, bf16x8 pa1, bf16x8 pa2, bf16x8 pa3) {
#define TRRD(dst, off) asm volatile("ds_read_b64_tr_b16 %0, %1 offset:%2" : "=&v"(dst) : "v"(vb), "i"(off) : "memory")
#define PV_D0(d0) do { s16x4 l0, l1, l2, l3, h0, h1, h2, h3; constexpr int b_ = v_rd_off(d0, 0, 0); \
        TRRD(l0, b_); TRRD(h0, b_ + 2048); TRRD(l1, b_ + 4096); TRRD(h1, b_ + 6144); TRRD(l2, b_ + 8192); TRRD(h2, b_ + 10240); TRRD(l3, b_ + 12288); TRRD(h3, b_ + 14336); \
        asm volatile("s_waitcnt lgkmcnt(0)" ::: "memory"); SBAR(); \
        o[d0] = __builtin_amdgcn_mfma_f32_32x32x16_bf16(pa0, (bf16x8){l0[0], l0[1], l0[2], l0[3], h0[0], h0[1], h0[2], h0[3]}, o[d0], 0, 0, 0); \
        o[d0] = __builtin_amdgcn_mfma_f32_32x32x16_bf16(pa1, (bf16x8){l1[0], l1[1], l1[2], l1[3], h1[0], h1[1], h1[2], h1[3]}, o[d0], 0, 0, 0); \
        o[d0] = __builtin_amdgcn_mfma_f32_32x32x16_bf16(pa2, (bf16x8){l2[0], l2[1], l2[2], l2[3], h2[0], h2[1], h2[2], h2[3]}, o[d0], 0, 0, 0); \
        o[d0] = __builtin_amdgcn_mfma_f32_32x32x16_bf16(pa3, (bf16x8){l3[0], l3[1], l3[2], l3[3], h3[0], h3[1], h3[2], h3[3]}, o[d0], 0, 0, 0); } while (0)
    PV_D0(0); PV_D0(1); PV_D0(2); PV_D0(3);
#undef PV_D0
#undef TRRD
}

template <bool IMP>
__device__ __forceinline__ void attn_tiles(LAS unsigned char* lds, const bf16x8 (&qr)[8], const bf16* Kp, const bf16* Vp, const int kvs,
                                           unsigned long long tilemask, const int pos, const int wlo, const int whi, const unsigned W,
                                           const unsigned long long rowmask, const int shift,
                                           f32x16 (&o)[4], float& m_reg, float& l_reg, float (&imp)[32]) {
    const int tid = otid(), wid = __builtin_amdgcn_readfirstlane(tid >> 6), lane = tid & 63, r32 = lane & 31, hi = lane >> 5;
    LAS unsigned char* V_lds = lds + OFF_V; LAS unsigned char* K_lds = lds + OFF_K;
    LAS float* al_l = (LAS float*)(lds + OFF_WS) + wid * 64 + 32;
    const int sr = tid >> 4, sc = (tid & 15) * 8;
    const int vst0 = v_st(sr, sc), vst1 = v_st(32 + sr, sc), kws = KSWZ(sr, sc * 2);
    const int vb0 = (int)(uintptr_t)V_lds + v_rd_base(lane);
    const int qm = pos - 4 * hi;
    constexpr float C2 = 1.4426950408889634f * SCALE;
    bf16x8 st_k0, st_k1, st_v0, st_v1;
#define A_LOAD(j_) do { const size_t r0_ = (size_t)((j_) * 64 + sr) * kvs + sc, r1_ = r0_ + (size_t)32 * kvs; \
        st_v0 = *(const bf16x8*)(Vp + r0_); st_v1 = *(const bf16x8*)(Vp + r1_); st_k0 = *(const bf16x8*)(Kp + r0_); st_k1 = *(const bf16x8*)(Kp + r1_); } while (0)
#define A_WRITE(bf_) do { *(LAS bf16x8*)(K_lds + (bf_) * SHM_K + kws) = st_k0; *(LAS bf16x8*)(K_lds + (bf_) * SHM_K + kws + 32 * 256) = st_k1; \
        *(LAS bf16x8*)(V_lds + (bf_) * SHM_V + vst0) = st_v0; *(LAS bf16x8*)(V_lds + (bf_) * SHM_V + vst1) = st_v1; } while (0)
    if (tilemask == 0ull) return;
    int j = __ffsll((long long)tilemask) - 1; tilemask &= tilemask - 1;
    A_LOAD(j); A_WRITE(0);
    __syncthreads();
    int jn = -1;
    if (tilemask) { jn = __ffsll((long long)tilemask) - 1; tilemask &= tilemask - 1; A_LOAD(jn); }
    int buf = 0; float carry = 0.f;
    for (;;) {
        const int kb = j * 64;
        const bool act = (kb <= whi) && ((long long)kb + 63 + (long long)W > (long long)wlo);
        if (act) {
            f32x16 p0, p1;
            SBAR(); qkt(p0, p1, K_lds + buf * SHM_K, r32, hi, qr); SBAR();
            const bool needm = (kb + 63 > wlo) || ((long long)kb + (long long)W <= (long long)whi);
            if (needm) { asm volatile("; boundary tile" ::: "memory"); mask_tile(p0, p1, qm - kb, W); }
            const bool rowsel = ((rowmask >> (kb >> shift)) & 1ull) != 0ull;
            if (!__all(rowsel)) { asm volatile("; row-select mask" ::: "memory"); const float NEG = -__builtin_inff();
#pragma unroll
                for (int r = 0; r < 16; ++r) { p0[r] = rowsel ? p0[r] : NEG; p1[r] = rowsel ? p1[r] : NEG; } }
            float pmax;
            { float m0 = fmaxf(fmaxf(p0[0], p0[1]), p0[2]), m1 = fmaxf(fmaxf(p0[3], p0[4]), p0[5]), m2 = fmaxf(fmaxf(p0[6], p0[7]), p0[8]), m3 = fmaxf(fmaxf(p0[9], p0[10]), p0[11]);
              float m4 = fmaxf(fmaxf(p0[12], p0[13]), p0[14]), m5 = fmaxf(fmaxf(p0[15], p1[0]), p1[1]), m6 = fmaxf(fmaxf(p1[2], p1[3]), p1[4]), m7 = fmaxf(fmaxf(p1[5], p1[6]), p1[7]);
              float m8 = fmaxf(fmaxf(p1[8], p1[9]), p1[10]), m9 = fmaxf(fmaxf(p1[11], p1[12]), p1[13]), ma = fmaxf(p1[14], p1[15]);
              m0 = fmaxf(fmaxf(m0, m1), m2); m3 = fmaxf(fmaxf(m3, m4), m5); m6 = fmaxf(fmaxf(m6, m7), m8); m9 = fmaxf(m9, ma);
              pmax = fmaxf(fmaxf(m0, m3), fmaxf(m6, m9)); }
            { auto rr = __builtin_amdgcn_permlane32_swap(__float_as_uint(pmax), __float_as_uint(pmax), false, false);
              pmax = fmaxf(__uint_as_float(rr[0]), __uint_as_float(rr[1])); }
            float mn, alpha;
            if (__all((pmax - m_reg) * SCALE <= THR)) { mn = m_reg; alpha = 1.f; }
            else { mn = fmaxf(m_reg, pmax); alpha = __builtin_amdgcn_exp2f((m_reg - mn) * C2); m_reg = mn; }
            const float mnL = -mn * C2;
#pragma unroll
            for (int r = 0; r < 16; ++r) { p0[r] = __builtin_amdgcn_exp2f(fmaf(p0[r], C2, mnL)); p1[r] = __builtin_amdgcn_exp2f(fmaf(p1[r], C2, mnL)); }
            float ps;
            { float s0 = (p0[0] + p0[1]) + (p0[2] + p0[3]), s1 = (p0[4] + p0[5]) + (p0[6] + p0[7]), s2 = (p0[8] + p0[9]) + (p0[10] + p0[11]), s3 = (p0[12] + p0[13]) + (p0[14] + p0[15]);
              float s4 = (p1[0] + p1[1]) + (p1[2] + p1[3]), s5_ = (p1[4] + p1[5]) + (p1[6] + p1[7]), s6 = (p1[8] + p1[9]) + (p1[10] + p1[11]), s7 = (p1[12] + p1[13]) + (p1[14] + p1[15]);
              ps = ((s0 + s1) + (s2 + s3)) + ((s4 + s5_) + (s6 + s7)); }
            { auto rr = __builtin_amdgcn_permlane32_swap(__float_as_uint(ps), __float_as_uint(ps), false, false);
              ps = __uint_as_float(rr[0]) + __uint_as_float(rr[1]); }
            l_reg = l_reg * alpha + ps;
            if (__any(alpha < 1.f)) {
                asm volatile("; rescale" ::: "memory");
                if (hi == 0) al_l[r32] = alpha;
                asm volatile("s_waitcnt lgkmcnt(0)" ::: "memory");
#pragma unroll
                for (int r = 0; r < 16; ++r) { const float a = al_l[crow(r, hi)];
#pragma unroll
                    for (int d_ = 0; d_ < 4; ++d_) o[d_][r] *= a; }
            }
            if constexpr (IMP) {
                float e3[4], f3[4], s0[4], s1[4];
#pragma unroll
                for (int q = 0; q < 4; ++q) { e3[q] = __shfl_xor(p0[4 * q + 3], 32); f3[q] = __shfl_xor(p1[4 * q + 3], 32);
                    s0[q] = (p0[4 * q] + p0[4 * q + 1]) + (p0[4 * q + 2] + p0[4 * q + 3]); s1[q] = (p1[4 * q] + p1[4 * q + 1]) + (p1[4 * q + 2] + p1[4 * q + 3]); }
                carry *= alpha;
#pragma unroll
                for (int q = 0; q < 4; ++q) {
                    s0[q] += hi ? e3[q] : (q > 0 ? e3[q > 0 ? q - 1 : 0] : carry);
                    s1[q] += hi ? f3[q] : (q > 0 ? f3[q > 0 ? q - 1 : 0] : e3[3]);
                }
                carry = f3[3];
#pragma unroll
                for (int i = 0; i < 32; ++i) imp[i] *= alpha;
#pragma unroll
                for (int tt = 0; tt < 4; ++tt) if (j == tt) {
#pragma unroll
                    for (int q = 0; q < 4; ++q) { imp[(tt * 2 + 0) * 4 + q] += s0[q]; imp[(tt * 2 + 1) * 4 + q] += s1[q]; } }
            }
            bf16x8 pa0, pa1, pa2, pa3;
#define PK4(P_, B_, OUT) do { const unsigned a0 = cvtpk(P_[B_ + 0], P_[B_ + 1]), a1 = cvtpk(P_[B_ + 2], P_[B_ + 3]); \
        const unsigned b0 = cvtpk(P_[B_ + 4], P_[B_ + 5]), b1 = cvtpk(P_[B_ + 6], P_[B_ + 7]); \
        auto r0 = __builtin_amdgcn_permlane32_swap(a0, b0, false, false); auto r1 = __builtin_amdgcn_permlane32_swap(a1, b1, false, false); \
        u32x4 w = {r0[0], r1[0], r0[1], r1[1]}; OUT = *reinterpret_cast<bf16x8*>(&w); } while (0)
            PK4(p0, 0, pa0); PK4(p0, 8, pa1); PK4(p1, 0, pa2); PK4(p1, 8, pa3);
#undef PK4
            SBAR();
            pv_tile(o, vb0 + buf * SHM_V, pa0, pa1, pa2, pa3);
        } else if (IMP) carry = 0.f;
        if (jn < 0) break;
        A_WRITE(buf ^ 1);
        __syncthreads();
        j = jn; buf ^= 1;
        if (tilemask) { jn = __ffsll((long long)tilemask) - 1; tilemask &= tilemask - 1; A_LOAD(jn); } else jn = -1;
    }
    __syncthreads();
#undef A_LOAD
#undef A_WRITE
}

template <int BR>
__device__ __forceinline__ void nsa_epi(const f32x16 (&o)[4], const float il, LAS float* li_l, float* accb, const float* gt, int r32, int hi, bf16* mixed, const bf16* zb) {
    asm volatile("" : "+v"(r32), "+v"(hi));
    if (hi == 0) li_l[r32] = il;
    asm volatile("s_waitcnt lgkmcnt(0)" ::: "memory");
#pragma unroll
    for (int rh = 0; rh < 2; ++rh) {
        float sv[8], av[8][4], zv[8][4];
#pragma unroll
        for (int q = 0; q < 8; ++q) { const int r = rh * 8 + q, rw = crow(r, hi);
            sv[q] = li_l[rw] * gt[rw * 12 + BR];
#pragma unroll
            for (int d0 = 0; d0 < 4; ++d0) { const int col = d0 * 32 + r32;
                if (BR >= 1) av[q][d0] = accb[rw * 128 + col];
                if (BR == 2) zv[q][d0] = bf2f(zb[(size_t)rw * NP + col]); } }
#pragma unroll
        for (int q = 0; q < 8; ++q) { const int r = rh * 8 + q, rw = crow(r, hi);
#pragma unroll
            for (int d0 = 0; d0 < 4; ++d0) { const int col = d0 * 32 + r32;
                if (BR == 0) accb[rw * 128 + col] = o[d0][r] * sv[q];
                else if (BR == 1) accb[rw * 128 + col] = av[q][d0] + o[d0][r] * sv[q];
                else { const float v = (av[q][d0] + o[d0][r] * sv[q]) * siluf_(zv[q][d0]);
                    const float vn = __shfl_xor(v, 1);
                    if ((r32 & 1) == 0) *(unsigned*)(mixed + (size_t)rw * DM + col) = cvtpk(v, vn); } } }
        asm volatile("" ::: "memory");
    }
}

__device__ __forceinline__ void nsa_unit(const Params& P, LAS unsigned char* lds, const int b, const int c) {
    const int tid = otid(), wid = __builtin_amdgcn_readfirstlane(tid >> 6), lane = tid & 63, r32 = lane & 31, hi = lane >> 5;
    const int head = wid >> 1, half = wid & 1;
    const int t_base = c * 64, trow = t_base + half * 32, pos = trow + r32;
    const bf16* proj = (const bf16*)(P.ws + WS_PROJ);
    const bf16* pb = proj + (size_t)b * SEQ * NP;
    const bf16* prow = pb + (size_t)pos * NP;
    bf16x8 qr[8];
#pragma unroll
    for (int d0 = 0; d0 < 8; ++d0) qr[d0] = *(const bf16x8*)(prow + O_NQ + head * 128 + d0 * 16 + hi * 8);
    LAS float* li_l = (LAS float*)(lds + OFF_WS) + wid * 64;
    float* accb = P.out + ((size_t)blockIdx.x * 256 + wid * 32) * 128;
    const float* gt = (const float*)(P.ws + WS_GATES) + (size_t)(b * SEQ + trow) * 12 + head * 3;
    const bf16* cmpk = (const bf16*)(P.ws + WS_CMPB) + (size_t)(0 * NB + b) * 256 * 128;
    const bf16* cmpv = (const bf16*)(P.ws + WS_CMPB) + (size_t)(1 * NB + b) * 256 * 128;
    f32x16 o[4]; float m_reg, l_reg;
    float dummy[32];
    {
        float imp[32];
#pragma unroll
        for (int i = 0; i < 32; ++i) imp[i] = 0.f;
#pragma unroll
        for (int d = 0; d < 4; ++d) o[d] = f32x16{};
        m_reg = -1e30f; l_reg = 0.f;
        const int posc = (pos - 31) >> 4, wloc = (trow - 31) >> 4, whic = trow >> 4;
        const int maxc = (t_base + 32) >> 4;
        const int ntile = (maxc >> 6) + 1;
        attn_tiles<true>(lds, qr, cmpk, cmpv, 128, (1ull << ntile) - 1ull, posc, wloc, whic, WINF, ~0ull, 12, o, m_reg, l_reg, imp);
        const float il = l_reg > 0.f ? 1.f / l_reg : 0.f;
        nsa_epi<0>(o, il, li_l, accb, gt, r32, hi, nullptr, nullptr);
        LAS float* impH = (LAS float*)lds;
        LAS float* ih = impH + ((head * 64 + half * 32 + r32) * 64);
#pragma unroll
        for (int tt = 0; tt < 4; ++tt)
#pragma unroll
            for (int hh = 0; hh < 2; ++hh)
#pragma unroll
                for (int q = 0; q < 4; ++q) ih[tt * 16 + hh * 8 + 2 * q + hi] = imp[(tt * 2 + hh) * 4 + q] * il;
    }
    __syncthreads();
    LAS float* score = (LAS float*)(lds + OFF_X);
    LAS unsigned char* selb = lds + OFF_X + 64 * 65 * 4;
    LAS unsigned* un = (LAS unsigned*)(lds + OFF_X + 64 * 65 * 4 + 512);
    {
        const int row = tid >> 3, part = tid & 7;
        const LAS float* impH = (const LAS float*)lds;
#pragma unroll
        for (int e = 0; e < 8; ++e) { const int jj = part * 8 + e;
            float s = (impH[(0 * 64 + row) * 64 + jj] + impH[(1 * 64 + row) * 64 + jj]) + (impH[(2 * 64 + row) * 64 + jj] + impH[(3 * 64 + row) * 64 + jj]);
            if (jj > c) s = -__builtin_inff();
            if (jj == 0 || jj == c || jj == c - 1) s = __builtin_inff();
            score[row * 65 + jj] = s; }
        if (tid < 2) un[tid] = 0u;
        __syncthreads();
        float sv[64];
#pragma unroll
        for (int j2 = 0; j2 < 64; ++j2) sv[j2] = score[row * 65 + j2];
        unsigned byte = 0u;
#pragma unroll
        for (int e = 0; e < 8; ++e) { const int jj = part * 8 + e; const float sj = score[row * 65 + jj]; int rank = 0;
#pragma unroll
            for (int j2 = 0; j2 < 64; ++j2) rank += (sv[j2] > sj || (sv[j2] == sj && j2 < jj)) ? 1 : 0;
            if (rank < 16 && jj <= c) byte |= 1u << e; }
        selb[row * 8 + part] = (unsigned char)byte;
        __hip_atomic_fetch_or(&un[part >> 2], byte << (8 * (part & 3)), __ATOMIC_RELAXED, __HIP_MEMORY_SCOPE_WORKGROUP);
    }
    __syncthreads();
    const unsigned long long rowmask = *(const LAS unsigned long long*)(selb + (half * 32 + r32) * 8);
    const unsigned long long selt = (unsigned long long)un[0] | ((unsigned long long)un[1] << 32);
    {
#pragma unroll
        for (int d = 0; d < 4; ++d) o[d] = f32x16{};
        m_reg = -1e30f; l_reg = 0.f;
        attn_tiles<false>(lds, qr, pb + O_KS, pb + O_VS, NP, selt, pos, trow, trow + 31, WINF, rowmask, 6, o, m_reg, l_reg, dummy);
        nsa_epi<1>(o, 1.f / l_reg, li_l, accb, gt, r32, hi, nullptr, nullptr);
    }
    {
#pragma unroll
        for (int d = 0; d < 4; ++d) o[d] = f32x16{};
        m_reg = -1e30f; l_reg = 0.f;
        const int lo = c > 8 ? c - 8 : 0;
        const unsigned long long upto = (c == 63) ? ~0ull : ((1ull << (c + 1)) - 1ull);
        const unsigned long long wt = upto & ~((1ull << lo) - 1ull);
        attn_tiles<false>(lds, qr, pb + O_KW, pb + O_VW, NP, wt, pos, trow, trow + 31, 512u, ~0ull, 12, o, m_reg, l_reg, dummy);
        bf16* mixed = (bf16*)(P.ws + WS_MIXED) + (size_t)(b * SEQ + trow) * DM + 512 + head * 128;
        const bf16* zb = pb + (size_t)trow * NP + O_NZ + head * 128;
        nsa_epi<2>(o, 1.f / l_reg, li_l, accb, gt, r32, hi, mixed, zb);
    }
}

__device__ __forceinline__ void moba_unit(const Params& P, LAS unsigned char* lds, const int b, const int h, const int own) {
    const int tid = otid(), wid = __builtin_amdgcn_readfirstlane(tid >> 6), lane = tid & 63, r32 = lane & 31, hi = lane >> 5;
    const int trow = own * 256 + wid * 32, pos = trow + r32;
    const bf16* proj = (const bf16*)(P.ws + WS_PROJ);
    const bf16* pb = proj + (size_t)b * SEQ * NP;
    const bf16* prow = pb + (size_t)pos * NP;
    bf16x8 qr[8];
#pragma unroll
    for (int d0 = 0; d0 < 8; ++d0) qr[d0] = *(const bf16x8*)(prow + O_MQ + h * 128 + d0 * 16 + hi * 8);
    LAS float* li_l = (LAS float*)(lds + OFF_WS) + wid * 64;
    LAS float* kml = (LAS float*)(lds + OFF_X);
    LAS unsigned* un = (LAS unsigned*)(lds + OFF_X + 8192);
    {
        const f32x4* src = (const f32x4*)((const float*)(P.ws + WS_KMEAN) + (size_t)(b * 4 + h) * 16 * 128);
        ((LAS f32x4*)kml)[tid] = src[tid];
        if (tid == 0) un[0] = 0u;
    }
    __syncthreads();
    float g[15];
#pragma unroll
    for (int n = 0; n < 15; ++n) g[n] = 0.f;
#pragma unroll
    for (int d0 = 0; d0 < 8; ++d0) {
        float qf[8];
#pragma unroll
        for (int e = 0; e < 8; ++e) qf[e] = bf2f((bf16)qr[d0][e]);
#pragma unroll
        for (int n = 0; n < 15; ++n) if (n < own) {
            const f32x4 k0 = *(const LAS f32x4*)(kml + n * 128 + d0 * 16 + hi * 8), k1 = *(const LAS f32x4*)(kml + n * 128 + d0 * 16 + hi * 8 + 4);
            g[n] += (qf[0] * k0[0] + qf[1] * k0[1]) + (qf[2] * k0[2] + qf[3] * k0[3]) + (qf[4] * k1[0] + qf[5] * k1[1]) + (qf[6] * k1[2] + qf[7] * k1[3]);
        }
    }
#pragma unroll
    for (int n = 0; n < 15; ++n) { g[n] += __shfl_xor(g[n], 32); if (n >= own) g[n] = -__builtin_inff(); }
    unsigned sel = 1u << own;
#pragma unroll
    for (int n = 0; n < 15; ++n) { int rank = 0;
#pragma unroll
        for (int n2 = 0; n2 < 15; ++n2) rank += (g[n2] > g[n] || (g[n2] == g[n] && n2 < n)) ? 1 : 0;
        if (n < own && rank < 3) sel |= 1u << n; }
    __hip_atomic_fetch_or(&un[0], sel, __ATOMIC_RELAXED, __HIP_MEMORY_SCOPE_WORKGROUP);
    __syncthreads();
    const unsigned blocks = un[0];
    unsigned long long tmask = 0ull;
#pragma unroll
    for (int n = 0; n < 16; ++n) if ((blocks >> n) & 1u) tmask |= 0xFull << (4 * n);
    f32x16 o[4]; float m_reg = -1e30f, l_reg = 0.f; float dummy[32];
#pragma unroll
    for (int d = 0; d < 4; ++d) o[d] = f32x16{};
    attn_tiles<false>(lds, qr, pb + O_MK + h * 128, pb + O_MV + h * 128, NP, tmask, pos, trow, trow + 31, WINF, (unsigned long long)sel, 8, o, m_reg, l_reg, dummy);
    const float il = 1.f / l_reg;
    if (hi == 0) li_l[r32] = il;
    asm volatile("s_waitcnt lgkmcnt(0)" ::: "memory");
    bf16* mixed = (bf16*)(P.ws + WS_MIXED) + (size_t)(b * SEQ + trow) * DM + h * 128;
    const bf16* zb = pb + (size_t)trow * NP + O_MZ + h * 128;
#pragma unroll
    for (int rh = 0; rh < 2; ++rh) {
        float zv[8][4];
#pragma unroll
        for (int q = 0; q < 8; ++q) { const int rw = crow(rh * 8 + q, hi);
#pragma unroll
            for (int d0 = 0; d0 < 4; ++d0) zv[q][d0] = bf2f(zb[(size_t)rw * NP + d0 * 32 + r32]); }
#pragma unroll
        for (int q = 0; q < 8; ++q) { const int r = rh * 8 + q, rw = crow(r, hi); const float s = li_l[rw];
#pragma unroll
            for (int d0 = 0; d0 < 4; ++d0) { const int col = d0 * 32 + r32;
                const float v = o[d0][r] * s * siluf_(zv[q][d0]);
                const float vn = __shfl_xor(v, 1);
                if ((r32 & 1) == 0) *(unsigned*)(mixed + (size_t)rw * DM + col) = cvtpk(v, vn); } }
        asm volatile("" ::: "memory");
    }
}
#undef KSWZ
#undef SBAR
}

namespace s5 {
typedef float f32x16 __attribute__((ext_vector_type(16)));
typedef float f32x2 __attribute__((ext_vector_type(2)));
constexpr int KT_ELEMS = 65 * 256, KT_BYTES = KT_ELEMS * 2, PF_ELEMS = 131072;
constexpr int UCOL = 2064, XCOL = 272, SROW = 129;
constexpr int L_U = 0, L_KT = 32 * UCOL, L_S = L_KT + KT_BYTES, L_XB = L_S + 32 * SROW * 4, L_CARRY = L_XB + 32 * XCOL, L_END = L_CARRY + 512;
static_assert(L_END <= 147456 && (L_KT % 16) == 0 && (L_S % 16) == 0 && (L_XB % 16) == 0, "s5 lds map");

__device__ __forceinline__ void tables_task(const Params& P, LAS unsigned char* lds, const int l, const int g, const int part) {
    const int tid = otid();
    LAS f32x2* pw = (LAS f32x2*)lds;
    LAS f32x2* fz = (LAS f32x2*)(lds + 65 * 64 * 8);
    __syncthreads();
    if (tid < 64) {
        const int p = tid;
        const double dt = exp((double)P.in[23][l * 64 + g]);
        const double ar = P.in[16][l * 4096 + g * 64 + p], ai = P.in[17][l * 4096 + g * 64 + p];
        const double mag = exp(dt * ar);
        double sn, cs; dsincos(dt * ai, sn, cs);
        const double abr = mag * cs, abi = mag * sn;
        const double nr = abr - 1.0, ni = abi, den = ar * ar + ai * ai;
        fz[p] = (f32x2){(float)((nr * ar + ni * ai) / den), (float)((ni * ar - nr * ai) / den)};
        double pr = 1.0, pi = 0.0;
        for (int n = 0; n <= 64; ++n) { pw[n * 64 + p] = (f32x2){(float)pr, (float)pi}; const double t = pr * abr - pi * abi; pi = pr * abi + pi * abr; pr = t; }
        if (part == 0) ((f32x2*)(P.ws + WS_S5AL))[(l * 64 + g) * 64 + p] = pw[64 * 64 + p];
    }
    __syncthreads();
    LAS float* bre = (LAS float*)(lds + 65 * 64 * 8 + 512);
    LAS float* bim = bre + 1024;
    LAS float* cre = bim + 1024;
    LAS float* cim = cre + 1024;
    { const float* gb = P.in[18] + (size_t)l * 65536 + g * 1024; const float* gbi = P.in[19] + (size_t)l * 65536 + g * 1024;
      const float* gc = P.in[20] + (size_t)l * 65536 + g * 1024; const float* gci = P.in[21] + (size_t)l * 65536 + g * 1024;
      for (int i = tid; i < 1024; i += 512) { bre[i] = gb[i]; bim[i] = gbi[i]; cre[i] = gc[i]; cim[i] = gci[i]; } }
    __syncthreads();
    bf16* P1 = (bf16*)(P.ws + WS_S5P1) + (size_t)(l * 64 + g) * PF_ELEMS;
    bf16* P2 = (bf16*)(P.ws + WS_S5P2) + (size_t)(l * 64 + g) * PF_ELEMS;
    bf16* KT = (bf16*)(P.ws + WS_S5K) + (size_t)(l * 64 + g) * KT_ELEMS;
    if (part == 0) for (int fl = tid; fl < 16384; fl += 512) {
        const int lane = fl & 63, ks = (fl >> 6) & 63, mb = fl >> 12;
        const int row = 32 * mb + (lane & 31), p = row & 63, isim = row >> 6, c0 = 8 * (lane >> 5);
        const f32x2 w = pw[(63 - ks) * 64 + p], f = fz[p];
        const float zr = w.x * f.x - w.y * f.y, zi = w.x * f.y + w.y * f.x;
        float v[8];
#pragma unroll
        for (int j = 0; j < 8; ++j) { const float br = bre[p * 16 + c0 + j], bi = bim[p * 16 + c0 + j]; v[j] = isim ? (zr * bi + zi * br) : (zr * br - zi * bi); }
        u32x4 o; o.x = pg8::cvt_pk_bf16(v[0], v[1]); o.y = pg8::cvt_pk_bf16(v[2], v[3]); o.z = pg8::cvt_pk_bf16(v[4], v[5]); o.w = pg8::cvt_pk_bf16(v[6], v[7]);
        *(u32x4*)(P1 + (size_t)fl * 8) = o;
    }
    if (part == 1) for (int fl = tid; fl < 16384; fl += 512) {
        const int lane = fl & 63, ks = (fl >> 6) & 7, rb = fl >> 9;
        const int r = lane & 31, t = 2 * rb + (r >> 4), c = r & 15, kk0 = 16 * ks + 8 * (lane >> 5);
        float v[8];
#pragma unroll
        for (int j = 0; j < 8; ++j) { const int kk = kk0 + j, p = kk & 63; const f32x2 w = pw[(t + 1) * 64 + p];
            const float cr = cre[c * 64 + p], ci = cim[c * 64 + p];
            v[j] = (kk >> 6) ? -(cr * w.y + ci * w.x) : (cr * w.x - ci * w.y); }
        u32x4 o; o.x = pg8::cvt_pk_bf16(v[0], v[1]); o.y = pg8::cvt_pk_bf16(v[2], v[3]); o.z = pg8::cvt_pk_bf16(v[4], v[5]); o.w = pg8::cvt_pk_bf16(v[6], v[7]);
        *(u32x4*)(P2 + (size_t)fl * 8) = o;
    }
    if (part >= 2) for (int pr_ = (part - 2) * 512 + tid; pr_ < (part - 1) * 512; pr_ += 512) {
        const int tau = pr_ >> 4, c = pr_ & 15;
        float acc[16];
#pragma unroll
        for (int j = 0; j < 16; ++j) acc[j] = 0.f;
        for (int p = 0; p < 64; ++p) {
            const f32x2 w = pw[tau * 64 + p], f = fz[p];
            const float zr = w.x * f.x - w.y * f.y, zi = w.x * f.y + w.y * f.x;
            const float cr = cre[c * 64 + p], ci = cim[c * 64 + p];
            const float czr = cr * zr - ci * zi, czi = cr * zi + ci * zr;
#pragma unroll
            for (int q = 0; q < 4; ++q) { const f32x4 br4 = *(const LAS f32x4*)(bre + p * 16 + 4 * q), bi4 = *(const LAS f32x4*)(bim + p * 16 + 4 * q);
#pragma unroll
                for (int e = 0; e < 4; ++e) acc[4 * q + e] += czr * br4[e] - czi * bi4[e]; }
        }
        u32x4 o0, o1; o0.x = pg8::cvt_pk_bf16(acc[0], acc[1]); o0.y = pg8::cvt_pk_bf16(acc[2], acc[3]); o0.z = pg8::cvt_pk_bf16(acc[4], acc[5]); o0.w = pg8::cvt_pk_bf16(acc[6], acc[7]);
        o1.x = pg8::cvt_pk_bf16(acc[8], acc[9]); o1.y = pg8::cvt_pk_bf16(acc[10], acc[11]); o1.z = pg8::cvt_pk_bf16(acc[12], acc[13]); o1.w = pg8::cvt_pk_bf16(acc[14], acc[15]);
        u32x4* dst = (u32x4*)(KT + (size_t)(tau + 1) * 256 + c * 16); dst[0] = o0; dst[1] = o1;
    }
    if (part == 2 && tid < 32) ((u32x4*)KT)[tid] = (u32x4){0u, 0u, 0u, 0u};
}

__device__ __forceinline__ void unit(const Params& P, LAS unsigned char* lds, const int l, const int b, const int g) {
    const int tid = otid(), wid = __builtin_amdgcn_readfirstlane(tid >> 6), lane = tid & 63, n32 = lane & 31, hi = lane >> 5;
    const bf16* KT = (const bf16*)(P.ws + WS_S5K) + (size_t)(l * 64 + g) * KT_ELEMS;
    const bf16x8* P1 = (const bf16x8*)((const bf16*)(P.ws + WS_S5P1) + (size_t)(l * 64 + g) * PF_ELEMS);
    const bf16x8* P2 = (const bf16x8*)((const bf16*)(P.ws + WS_S5P2) + (size_t)(l * 64 + g) * PF_ELEMS);
    const f32x2* AL = (const f32x2*)(P.ws + WS_S5AL) + (l * 64 + g) * 64;
    const bf16* ub = (const bf16*)(P.out + SUG_OFF) + (size_t)(b * 64 + g) * SEQ * 16;
    bf16* yb = (bf16*)(P.ws + WS_Y5) + (size_t)b * SEQ * 1024 + g * 16;
    const float* dsk = P.in[22] + l * 1024 + g * 16;
    LAS float* Sl = (LAS float*)(lds + L_S);
    LAS float* car = (LAS float*)(lds + L_CARRY);
    __syncthreads();
    { u32x4 kt[5];
#pragma unroll
      for (int it = 0; it < 5; ++it) { const int i = tid + 512 * it; if (i < KT_BYTES / 16) kt[it] = ((const u32x4*)KT)[i]; }
      __builtin_amdgcn_sched_barrier(0);
#pragma unroll
      for (int it = 0; it < 5; ++it) { const int i = tid + 512 * it; if (i < KT_BYTES / 16) ((LAS u32x4*)(lds + L_KT))[i] = kt[it]; } }
    const f32x4 dvA = *(const f32x4*)(dsk + 4 * hi), dvB = *(const f32x4*)(dsk + 8 + 4 * hi);
    if (tid < 128) car[tid] = 0.f;
    u32x4 ua0[4], ua1[4];
#define S5_LOADU(hh_) do { _Pragma("unroll") for (int it = 0; it < 4; ++it) { const int rr = tid + 512 * it, n = rr >> 6, s = rr & 63; \
        const u32x4* src = (const u32x4*)(ub + (size_t)((32 * (hh_) + n) * 64 + s) * 16); ua0[it] = src[0]; ua1[it] = src[1]; } } while (0)
    S5_LOADU(0);
    for (int hh = 0; hh < 2; ++hh) {
        __builtin_amdgcn_sched_barrier(0);
#pragma unroll
        for (int it = 0; it < 4; ++it) { const int rr = tid + 512 * it, n = rr >> 6, s = rr & 63;
            *(LAS u32x4*)(lds + L_U + n * UCOL + s * 32) = ua0[it]; *(LAS u32x4*)(lds + L_U + n * UCOL + s * 32 + 16) = ua1[it]; }
        __syncthreads();
        {
            const int mb = wid & 3, kh = wid >> 2;
            f32x16 acc0 = f32x16{}, acc1 = f32x16{};
            const bf16x8* pa = P1 + (size_t)(mb * 64 + kh * 32) * 64 + lane;
            LAS const unsigned char* ua = lds + L_U + n32 * UCOL + hi * 16 + kh * 32 * 32;
#pragma unroll 1
            for (int kb = 0; kb < 4; ++kb) {
                const bf16x8* qa = pa + 4 * 64;
                bf16x8 fa[8];
#pragma unroll
                for (int i = 0; i < 4; ++i) { fa[i] = pa[i * 64]; fa[4 + i] = qa[i * 64]; }
                __builtin_amdgcn_sched_barrier(0);
#pragma unroll
                for (int i = 0; i < 8; i += 2) {
                    acc0 = __builtin_amdgcn_mfma_f32_32x32x16_bf16(fa[i], *(LAS const bf16x8*)(ua + i * 32), acc0, 0, 0, 0);
                    acc1 = __builtin_amdgcn_mfma_f32_32x32x16_bf16(fa[i + 1], *(LAS const bf16x8*)(ua + (i + 1) * 32), acc1, 0, 0, 0); }
                __builtin_amdgcn_sched_barrier(0);
                pa += 8 * 64; ua += 8 * 32;
            }
            acc0 += acc1;
            if (kh == 1) {
#pragma unroll
                for (int r = 0; r < 16; ++r) Sl[n32 * SROW + 32 * mb + (r & 3) + 8 * (r >> 2) + 4 * hi] = acc0[r];
            }
            __syncthreads();
            if (kh == 0) {
#pragma unroll
                for (int r = 0; r < 16; ++r) Sl[n32 * SROW + 32 * mb + (r & 3) + 8 * (r >> 2) + 4 * hi] += acc0[r];
            }
        }
        __syncthreads();
        if (tid < 64) {
            const int p = tid; const f32x2 al = AL[p];
            float xr = car[p], xi = car[64 + p];
            float sre[32], sim[32];
#pragma unroll
            for (int n = 0; n < 32; ++n) { sre[n] = Sl[n * SROW + p]; sim[n] = Sl[n * SROW + 64 + p]; }
#pragma unroll
            for (int n = 0; n < 32; ++n) {
                *(LAS bf16*)(lds + L_XB + n * XCOL + p * 2) = (bf16)f2bf(xr); *(LAS bf16*)(lds + L_XB + n * XCOL + (64 + p) * 2) = (bf16)f2bf(xi);
                const float nx = al.x * xr - al.y * xi + sre[n], ni = al.x * xi + al.y * xr + sim[n]; xr = nx; xi = ni; }
            car[p] = xr; car[64 + p] = xi;
        }
        __syncthreads();
        if (hh == 0) { S5_LOADU(1); __builtin_amdgcn_sched_barrier(0); }
        for (int q4 = 0; q4 < 4; ++q4) {
            const int rb = (q4 == 0) ? wid : (q4 == 1) ? 15 - wid : (q4 == 2) ? 16 + wid : 31 - wid;
            const int t0 = 2 * rb;
            f32x16 acc = f32x16{};
            bf16x8 pf[8];
            { const bf16x8* p2 = P2 + (size_t)(rb * 8) * 64 + lane;
#pragma unroll
              for (int ks = 0; ks < 8; ++ks) pf[ks] = p2[ks * 64]; }
            LAS const unsigned char* ka = lds + L_KT + (t0 + 1) * 512 + n32 * 32 + hi * 16;
            LAS const unsigned char* ua = lds + L_U + n32 * UCOL + hi * 16;
            f32x16 acc2 = f32x16{};
#pragma unroll 4
            for (int s0 = 0; s0 <= t0 + 1; s0 += 2) {
                acc = __builtin_amdgcn_mfma_f32_32x32x16_bf16(*(LAS const bf16x8*)(ka - s0 * 512), *(LAS const bf16x8*)(ua + s0 * 32), acc, 0, 0, 0);
                acc2 = __builtin_amdgcn_mfma_f32_32x32x16_bf16(*(LAS const bf16x8*)(ka - (s0 + 1) * 512), *(LAS const bf16x8*)(ua + (s0 + 1) * 32), acc2, 0, 0, 0); }
            LAS const unsigned char* xa = lds + L_XB + n32 * XCOL + hi * 16;
#pragma unroll
            for (int ks = 0; ks < 8; ks += 2) {
                acc = __builtin_amdgcn_mfma_f32_32x32x16_bf16(pf[ks], *(LAS const bf16x8*)(xa + ks * 32), acc, 0, 0, 0);
                acc2 = __builtin_amdgcn_mfma_f32_32x32x16_bf16(pf[ks + 1], *(LAS const bf16x8*)(xa + (ks + 1) * 32), acc2, 0, 0, 0); }
            acc += acc2;
#pragma unroll
            for (int r4 = 0; r4 < 4; ++r4) {
                const int t = t0 + (r4 >> 1), c0 = 8 * (r4 & 1) + 4 * hi;
                const u32x2 uw = *(LAS const u32x2*)(lds + L_U + n32 * UCOL + t * 32 + c0 * 2);
                const f32x4 dv = (r4 & 1) ? dvB : dvA;
                const float u0 = __uint_as_float(uw.x << 16), u1 = __uint_as_float(uw.x & 0xffff0000u), u2 = __uint_as_float(uw.y << 16), u3 = __uint_as_float(uw.y & 0xffff0000u);
                const float y0 = geluf_(acc[4 * r4 + 0] + dv[0] * u0), y1 = geluf_(acc[4 * r4 + 1] + dv[1] * u1);
                const float y2 = geluf_(acc[4 * r4 + 2] + dv[2] * u2), y3 = geluf_(acc[4 * r4 + 3] + dv[3] * u3);
                u32x2 w; w.x = pk2(y0, y1); w.y = pk2(y2, y3);
                *(u32x2*)(yb + (size_t)((32 * hh + n32) * 64 + t) * 1024 + c0) = w;
            }
        }
        __syncthreads();
    }
#undef S5_LOADU
}
}

namespace a1 {
typedef float f32x16 __attribute__((ext_vector_type(16)));
__device__ __forceinline__ void norm_task(const Params& P, LAS unsigned char* lds, const int l, const int blk, const int vec) {
    const int tid = otid(), wid = __builtin_amdgcn_readfirstlane(tid >> 6), lane = tid & 63;
    int off; const float* nw;
    if (vec < 4) { off = O_MQ + vec * 128; nw = P.in[4]; }
    else if (vec < 8) { off = O_MK + (vec - 4) * 128; nw = P.in[5]; }
    else if (vec < 12) { off = O_NQ + (vec - 8) * 128; nw = P.in[6]; }
    else if (vec == 12) { off = O_KS; nw = P.in[8]; }
    else { off = O_KW; nw = P.in[9]; }
    nw += l * 128;
    const float2* cs = (const float2*)(P.ws + WS_ROPE);
    bf16* base = (bf16*)(P.ws + WS_PROJ) + (size_t)(blk * 256 + wid * 32) * NP + off;
    const int pos0 = (blk * 256 + wid * 32) % SEQ;
    const float wa = nw[lane], wb = nw[lane + 64];
    float sa = 0.f, sb = 0.f;
#pragma unroll 4
    for (int i = 0; i < 32; ++i) {
        bf16* v = base + (size_t)i * NP;
        float a = bf2f(v[lane]), b = bf2f(v[lane + 64]);
        const float ss = wave_sum(a * a + b * b);
        const float r = 1.0f / sqrtf(ss * (1.0f / 128.0f) + EPSN);
        a = a * r * wa; b = b * r * wb;
        const float other = __shfl_xor(a, 16);
        if (lane < 32) { const float2 c = cs[(pos0 + i) * 16 + (lane & 15)]; a = (lane < 16) ? (a * c.x - other * c.y) : (a * c.x + other * c.y); }
        v[lane] = (bf16)f2bf(a); v[lane + 64] = (bf16)f2bf(b);
        sa += a; sb += b;
    }
    if (vec >= 4 && vec < 8) {
        LAS float* red = (LAS float*)lds;
        red[wid * 128 + lane] = sa; red[wid * 128 + lane + 64] = sb;
        __syncthreads();
        if (tid < 128) { float s = 0.f;
#pragma unroll
            for (int w = 0; w < 8; ++w) s += red[w * 128 + tid];
            const int b = blk >> 4, n = blk & 15, h = vec - 4;
            ((float*)(P.ws + WS_KMEAN))[((size_t)(b * 4 + h) * 16 + n) * 128 + tid] = s * (1.0f / 256.0f); }
    }
}
__device__ __forceinline__ void gates_task(const Params& P, LAS unsigned char* lds, const int l, const int task) {
    const int tid = otid(), wid = __builtin_amdgcn_readfirstlane(tid >> 6), lane = tid & 63, r32 = lane & 31, hi = lane >> 5;
    const bf16* xb = (const bf16*)(P.ws + WS_XB) + (size_t)(task * 64 + r32) * DM + wid * 256 + 8 * hi;
    const bf16x8* wf = (const bf16x8*)(P.ws + WS_WGF) + ((size_t)l * 128 + wid * 16) * 64 + lane;
    f32x16 acc0 = f32x16{}, acc1 = f32x16{};
#pragma unroll 1
    for (int kb = 0; kb < 2; ++kb) {
        bf16x8 a0[8], a1[8], bw[8];
        const bf16* xq = xb + (size_t)32 * DM;
#pragma unroll
        for (int k = 0; k < 8; ++k) { a0[k] = *(const bf16x8*)(xb + 16 * k); a1[k] = *(const bf16x8*)(xq + 16 * k); bw[k] = wf[k * 64]; }
        __builtin_amdgcn_sched_barrier(0);
#pragma unroll
        for (int k = 0; k < 8; ++k) { acc0 = __builtin_amdgcn_mfma_f32_32x32x16_bf16(a0[k], bw[k], acc0, 0, 0, 0); acc1 = __builtin_amdgcn_mfma_f32_32x32x16_bf16(a1[k], bw[k], acc1, 0, 0, 0); }
        __builtin_amdgcn_sched_barrier(0);
        xb += 128; wf += 8 * 64;
    }
    LAS float* red = (LAS float*)lds;
    LAS float* rsl = red + 8 * 64 * 12;
    if (r32 < 12) {
#pragma unroll
        for (int r = 0; r < 16; ++r) { const int rw = (r & 3) + 8 * (r >> 2) + 4 * hi;
            red[(wid * 64 + rw) * 12 + r32] = acc0[r]; red[(wid * 64 + 32 + rw) * 12 + r32] = acc1[r]; }
    }
    if (tid < 64) rsl[tid] = ((const float*)(P.ws + WS_RS))[task * 64 + tid];
    __syncthreads();
    for (int i = tid; i < 64 * 12; i += 512) { float s = 0.f;
#pragma unroll
        for (int w = 0; w < 8; ++w) s += red[w * 768 + i];
        ((float*)(P.ws + WS_GATES))[(size_t)task * 768 + i] = sigmoidf_(s * rsl[i / 12]); }
}
__device__ __forceinline__ void cmp_task(const Params& P, LAS unsigned char* lds, const int l, const int which, const int b, const int nb) {
    const int tid = otid(), wid = __builtin_amdgcn_readfirstlane(tid >> 6), lane = tid & 63, r32 = lane & 31, hi = lane >> 5;
    const int n0 = 32 * nb, cb = wid & 3, kh = wid >> 2;
    LAS float* red = (LAS float*)lds;
    LAS bf16* hid = (LAS bf16*)(lds + 4 * 32 * 33 * 4);
    LAS float* ot = (LAS float*)(lds + 4 * 32 * 33 * 4 + 32 * 136 * 2);
    {
        const int n = min(n0 + r32, NCMP - 1);
        const bf16* tokbase = (const bf16*)(P.ws + WS_PROJ) + (size_t)(b * SEQ + 16 * n) * NP + (which ? O_VC : O_KC) + 8 * hi;
        const bf16x8* wf = (const bf16x8*)(P.ws + WS_W1F) + ((size_t)((l * 2 + which) * 4 + cb) * 256 + kh * 128) * 64 + lane;
        const bf16* tok = tokbase + (size_t)(kh * 16) * NP;
        f32x16 acc = f32x16{}, acc2 = f32x16{};
#pragma unroll 1
        for (int t = 0; t < 16; ++t) {
            bf16x8 A[8], Bf[8];
            const bf16x8* wq = wf + 4 * 64;
#pragma unroll
            for (int k = 0; k < 4; ++k) { A[k] = *(const bf16x8*)(tok + k * 16); A[4 + k] = *(const bf16x8*)(tok + (4 + k) * 16); Bf[k] = wf[k * 64]; Bf[4 + k] = wq[k * 64]; }
            __builtin_amdgcn_sched_barrier(0);
#pragma unroll
            for (int k = 0; k < 8; k += 2) { acc = __builtin_amdgcn_mfma_f32_32x32x16_bf16(A[k], Bf[k], acc, 0, 0, 0); acc2 = __builtin_amdgcn_mfma_f32_32x32x16_bf16(A[k + 1], Bf[k + 1], acc2, 0, 0, 0); }
            __builtin_amdgcn_sched_barrier(0);
            tok += NP; wf += 8 * 64;
        }
        acc += acc2;
        if (kh == 1) {
#pragma unroll
            for (int r = 0; r < 16; ++r) red[(cb * 32 + (r & 3) + 8 * (r >> 2) + 4 * hi) * 33 + r32] = acc[r];
        }
        __syncthreads();
        if (kh == 0) { float cst = 0.f;
            { const float* cp = (const float*)(P.ws + WS_CST) + (size_t)((l * 2 + which) * 64) * 128 + cb * 32 + r32;
#pragma unroll 1
              for (int s0 = 0; s0 < 64; s0 += 16) {
                  float cv[16];
#pragma unroll
                  for (int i = 0; i < 16; ++i) cv[i] = cp[i * 128];
                  __builtin_amdgcn_sched_barrier(0);
#pragma unroll
                  for (int i = 0; i < 16; ++i) cst += cv[i];
                  __builtin_amdgcn_sched_barrier(0);
                  cp += 16 * 128; } }
#pragma unroll
            for (int r = 0; r < 16; ++r) { const int rw = (r & 3) + 8 * (r >> 2) + 4 * hi;
                hid[rw * 136 + cb * 32 + r32] = (bf16)f2bf(geluf_(acc[r] + red[(cb * 32 + rw) * 33 + r32] + cst)); } }
        __syncthreads();
    }
    if (wid < 4) {
        const bf16x8* w2f = (const bf16x8*)(P.ws + WS_W2F) + ((size_t)((l * 2 + which) * 4 + wid) * 8) * 64 + lane;
        f32x16 acc = f32x16{};
        bf16x8 wb[8];
#pragma unroll
        for (int ks = 0; ks < 8; ++ks) wb[ks] = w2f[ks * 64];
        __builtin_amdgcn_sched_barrier(0);
#pragma unroll
        for (int ks = 0; ks < 8; ++ks) acc = __builtin_amdgcn_mfma_f32_32x32x16_bf16(*(const LAS bf16x8*)(hid + r32 * 136 + 16 * ks + 8 * hi), wb[ks], acc, 0, 0, 0);
#pragma unroll
        for (int r = 0; r < 16; ++r) ot[((r & 3) + 8 * (r >> 2) + 4 * hi) * 132 + wid * 32 + r32] = acc[r];
    }
    __syncthreads();
    {
        const int r = tid >> 4, jg = tid & 15, j2 = jg * 8;
        float o[8];
        { const f32x4 oa = *(const LAS f32x4*)(ot + r * 132 + j2), ob = *(const LAS f32x4*)(ot + r * 132 + j2 + 4);
#pragma unroll
          for (int e = 0; e < 4; ++e) { o[e] = oa[e]; o[4 + e] = ob[e]; } }
        const int n = n0 + r;
        if (which == 0) {
            float ss = 0.f;
#pragma unroll
            for (int e = 0; e < 8; ++e) ss += o[e] * o[e];
            ss += __shfl_xor(ss, 1); ss += __shfl_xor(ss, 2); ss += __shfl_xor(ss, 4); ss += __shfl_xor(ss, 8);
            const float rs = 1.0f / sqrtf(ss * (1.0f / 128.0f) + EPSN);
            const float* kcn = P.in[7] + l * 128 + j2;
            const float2* cs = (const float2*)(P.ws + WS_ROPE) + (size_t)min(16 * n + 31, SEQ - 1) * 16 + (jg & 1) * 8;
#pragma unroll
            for (int e = 0; e < 8; ++e) { o[e] = o[e] * rs * kcn[e];
                const float other = __shfl_xor(o[e], 2);
                if (jg < 4) { const float2 c = cs[e]; o[e] = (jg < 2) ? (o[e] * c.x - other * c.y) : (o[e] * c.x + other * c.y); } }
        }
        u32x4 w; w.x = pk2(o[0], o[1]); w.y = pk2(o[2], o[3]); w.z = pk2(o[4], o[5]); w.w = pk2(o[6], o[7]);
        if (n >= NCMP) w = (u32x4){0u, 0u, 0u, 0u};
        *(u32x4*)((bf16*)(P.ws + WS_CMPB) + ((size_t)(which * NB + b) * 256 + n) * 128 + j2) = w;
    }
}
__device__ __forceinline__ void prep_w1(const Params& P, LAS unsigned char* lds) {
    const int tid = otid();
    const int gt = blockIdx.x * 512 + tid, GT = gridDim.x * 512;
    for (int fl = gt; fl < NL * 2 * 65536; fl += GT) {
        const int lw = fl >> 16, rem = fl & 65535, lane = rem & 63, ks = (rem >> 6) & 255, cb = rem >> 14;
        const float* w1 = P.in[(lw & 1) ? 14 : 12] + (size_t)(lw >> 1) * 4096 * 128;
        const float* src = w1 + (size_t)(16 * ks + 8 * (lane >> 5)) * 128 + 32 * cb + (lane & 31);
        u32x4 o; o.x = pk2(src[0], src[128]); o.y = pk2(src[256], src[384]); o.z = pk2(src[512], src[640]); o.w = pk2(src[768], src[896]);
        *(u32x4*)((bf16*)(P.ws + WS_W1F) + (size_t)fl * 8) = o;
    }
    for (int fl = gt; fl < NL * 2 * 4 * 8 * 64; fl += GT) {
        const int lw = fl >> 11, cb = (fl >> 9) & 3, ks = (fl >> 6) & 7, lane = fl & 63;
        const float* w2 = P.in[(lw & 1) ? 15 : 13] + (size_t)(lw >> 1) * 16384 + (size_t)(16 * ks + 8 * (lane >> 5)) * 128 + 32 * cb + (lane & 31);
        u32x4 o; o.x = pk2(w2[0], w2[128]); o.y = pk2(w2[256], w2[384]); o.z = pk2(w2[512], w2[640]); o.w = pk2(w2[768], w2[896]);
        *(u32x4*)((bf16*)(P.ws + WS_W2F) + (size_t)fl * 8) = o;
    }
    for (int fl = gt; fl < NL * 128 * 64; fl += GT) {
        const int l = fl >> 13, ks = (fl >> 6) & 127, lane = fl & 63, n = lane & 31, k0 = 16 * ks + 8 * (lane >> 5);
        float v[8];
#pragma unroll
        for (int e = 0; e < 8; ++e) v[e] = (n < 12) ? P.in[1][l * DM + k0 + e] * P.in[2][(size_t)l * DM * INW + (size_t)(k0 + e) * INW + SRC_NG + n] : 0.f;
        u32x4 o; o.x = pk2(v[0], v[1]); o.y = pk2(v[2], v[3]); o.z = pk2(v[4], v[5]); o.w = pk2(v[6], v[7]);
        *(u32x4*)((bf16*)(P.ws + WS_WGF) + (size_t)fl * 8) = o;
    }
    for (int t = blockIdx.x; t < NL * 2 * 64; t += gridDim.x) {
        const int lw = t >> 6, sl = t & 63;
        const float* w1 = P.in[(lw & 1) ? 14 : 12] + (size_t)(lw >> 1) * 4096 * 128;
        const float* pe = P.in[(lw & 1) ? 11 : 10] + (size_t)(lw >> 1) * 4096;
        const int j = tid & 127, kq = tid >> 7;
        float s = 0.f;
#pragma unroll
        for (int i = 0; i < 16; ++i) { const int k = sl * 64 + kq * 16 + i; s += pe[k] * w1[(size_t)k * 128 + j]; }
        LAS float* red = (LAS float*)lds;
        __syncthreads();
        red[tid] = s;
        __syncthreads();
        if (tid < 128) ((float*)(P.ws + WS_CST))[(size_t)t * 128 + tid] = (red[tid] + red[128 + tid]) + (red[256 + tid] + red[384 + tid]);
    }
}
}

__device__ __forceinline__ void unit_done(unsigned* cnt) {
    asm volatile("s_waitcnt vmcnt(0)" ::: "memory");
    __syncthreads();
    if (otid() == 0) { __builtin_amdgcn_fence(__ATOMIC_RELEASE, "agent"); asm volatile("s_waitcnt vmcnt(0)" ::: "memory");
        __hip_atomic_fetch_add(cnt, 1u, __ATOMIC_RELAXED, __HIP_MEMORY_SCOPE_AGENT); }
}
__device__ __forceinline__ void unit_wait(unsigned* cnt, unsigned target) {
    if (otid() == 0) { unsigned sp = 0u;
        while (__hip_atomic_load(cnt, __ATOMIC_RELAXED, __HIP_MEMORY_SCOPE_AGENT) < target) { __builtin_amdgcn_s_sleep(4); if (++sp > (1u << 22)) break; }
        __builtin_amdgcn_fence(__ATOMIC_ACQUIRE, "agent"); asm volatile("s_waitcnt vmcnt(0)" ::: "memory"); }
    __syncthreads();
}
struct OneUnit { int pm, pn; __device__ __forceinline__ bool next(int i, pg8::Unit& u) const { if (i != 0) return false; u.pm = pm; u.pn = pn; return true; } };

__device__ __forceinline__ void phase_mid(const Params& P, LAS unsigned char* lds, int l) {
    unsigned* ctl = (unsigned*)(P.ws + WS_CTL) + 64 * 8 * l;
    const int* order = (const int*)(P.ws + WS_ORDER);
    LAS int* slot = (LAS int*)(lds + LDS_BYTES - 64);
    bool small_ok = false; unsigned s5_ok = 0u;
    for (;;) {
        __syncthreads();
        if (otid() == 0) slot[0] = (int)__hip_atomic_fetch_add(ctl, 1u, __ATOMIC_RELAXED, __HIP_MEMORY_SCOPE_AGENT);
        __syncthreads();
        const int u = slot[0];
        if (u >= 1344) break;
        if (u < 64) { a1::cmp_task(P, lds, l, u >> 5, (u >> 3) & 3, u & 7); unit_done(ctl + 64); }
        else if (u < 320) { a1::gates_task(P, lds, l, u - 64); unit_done(ctl + 64); }
        else if (u < 576) { const int v = u - 320; s5::unit(P, lds, l, v >> 6, v & 63); unit_done(ctl + 128 + 64 * (v >> 6)); }
        else if (u < 1088) { const int id = order[u - 576];
            if (id < 256) { if (!small_ok) { unit_wait(ctl + 64, 320u); small_ok = true; } att::nsa_unit(P, lds, id >> 6, id & 63); }
            else { const int v = id - 256; att::moba_unit(P, lds, v >> 6, (v >> 4) & 3, v & 15); } }
        else { const int t = u - 1088, pm = t >> 2, b = pm >> 4;
            if (!((s5_ok >> b) & 1u)) { unit_wait(ctl + 128 + 64 * b, 64u); s5_ok |= 1u << b; }
            pg8::Gemm g{(const bf16*)(P.ws + WS_Y5), (const bf16*)(P.ws + WS_GLU + l * GLU_BYTES), NT, 1024, 1024, 1024};
            OneUnit S{pm, t & 3};
            EpiGlu E{(bf16*)(P.ws + WS_MIXED), (const bf16*)(P.ws + WS_Y5), (const bf16*)(P.ws + WS_PROJ)};
            pg8::gemm_phase<EpiGlu, OneUnit>(lds, g, S, E); }
    }
}

#define XB_TMO      128
#define XB_XCNT(j)  (256  + 64 * (j))
#define XB_XSUB(j)  (1280 + 64 * (j))
#define XB_XGEN(j)  (2304 + 64 * (j))
#define XB_TOP      3328
#define XB_TOPGEN   3392
#define XCD_BAR_WORDS 3456
#define XB_SPIN_CAP (1u << 18)
__device__ __forceinline__ unsigned xb_ld(unsigned* p)              { return __hip_atomic_load(p, __ATOMIC_RELAXED, __HIP_MEMORY_SCOPE_AGENT); }
__device__ __forceinline__ unsigned xb_add(unsigned* p, unsigned v) { return __hip_atomic_fetch_add(p, v, __ATOMIC_RELAXED, __HIP_MEMORY_SCOPE_AGENT); }
__device__ __forceinline__ unsigned xb_xcc_id() { return (unsigned)__builtin_amdgcn_s_getreg((3 << 11) | 20) & 0xFu; }
#define XB_SPIN(cond, bar) do { unsigned _sp = 0; while (cond) { __builtin_amdgcn_s_sleep(1); \
    if ((++_sp & 255u) == 0u) { if (xb_ld(&(bar)[XB_TMO])) break; if (_sp > XB_SPIN_CAP) { atomicAdd(&(bar)[XB_TMO], 1u); break; } } } } while (0)
struct XcdBarrier { unsigned* bar; unsigned x; volatile LAS unsigned* st; };
__device__ __forceinline__ XcdBarrier xcd_barrier_post(unsigned* bar, volatile LAS unsigned* st) {
    XcdBarrier b; b.bar = bar; b.x = xb_xcc_id(); b.st = st;
    if (threadIdx.x == 0) (void)xb_add(&bar[XB_XCNT(b.x)], 1u);
    return b;
}
__device__ __forceinline__ void xcd_barrier_complete(unsigned* bar, unsigned x, unsigned& nloc, unsigned& nx) {
    const unsigned G = gridDim.x * gridDim.y * gridDim.z;
    const unsigned lane = (unsigned)otid() & 63u;
    unsigned sum, cnt, mine, sp = 0u;
    for (;;) {
        const unsigned c = (lane < 16u) ? xb_ld(&bar[XB_XCNT(lane)]) : 0u;
        sum = c;
#pragma unroll
        for (int o = 1; o < 16; o <<= 1) sum += __shfl_xor(sum, o);
        sum = __shfl(sum, 0);
        cnt = (unsigned)__popcll(__ballot(c > 0u));
        mine = __shfl(c, (int)x);
        if (sum == G) break;
        __builtin_amdgcn_s_sleep(1);
        if ((++sp & 255u) == 0u) { if (xb_ld(&bar[XB_TMO])) break; if (sp > XB_SPIN_CAP) { if (lane == 0u) atomicAdd(&bar[XB_TMO], 1u); break; } }
    }
    nloc = mine > 0u ? mine : 1u; nx = cnt > 0u ? cnt : 1u;
}
__device__ __forceinline__ void xcd_barrier(const XcdBarrier& b) {
    asm volatile("s_waitcnt vmcnt(0)" ::: "memory");
    __syncthreads();
    if (threadIdx.x < 64 && b.st[0] == 0u) {
        unsigned nloc0, nx0; xcd_barrier_complete(b.bar, b.x, nloc0, nx0);
        if (threadIdx.x == 0) { b.st[0] = nloc0; b.st[1] = nx0; }
        asm volatile("s_waitcnt lgkmcnt(0)" ::: "memory");
    }
    if (threadIdx.x == 0) {
        unsigned* bar = b.bar;
        __builtin_amdgcn_s_waitcnt(0);
        unsigned nloc = b.st[0], nx = b.st[1];
        const unsigned old = xb_add(&bar[XB_XSUB(b.x)], 1u);
        const unsigned gen = old / nloc;
        if (old + 1u == (gen + 1u) * nloc) {
            __builtin_amdgcn_fence(__ATOMIC_RELEASE, "agent");
            asm volatile("s_waitcnt vmcnt(0)" ::: "memory");
            const unsigned og = xb_add(&bar[XB_TOP], 1u);
            const unsigned tg = og / nx;
            if (og + 1u == (tg + 1u) * nx) xb_add(&bar[XB_TOPGEN], 1u);
            else XB_SPIN(xb_ld(&bar[XB_TOPGEN]) == tg, bar);
            __builtin_amdgcn_fence(__ATOMIC_ACQUIRE, "agent");
            xb_add(&bar[XB_XGEN(b.x)], 1u);
            asm volatile("s_waitcnt vmcnt(0)" ::: "memory");
        } else {
            XB_SPIN(xb_ld(&bar[XB_XGEN(b.x)]) == gen, bar);
            __builtin_amdgcn_fence(__ATOMIC_ACQUIRE, "agent");
            asm volatile("s_waitcnt vmcnt(0)" ::: "memory");
        }
    }
    __syncthreads();
}

__global__ void __launch_bounds__(512, 2) k_mega(Params P) {
    extern __shared__ __attribute__((aligned(16))) unsigned char lds_raw[];
    LAS unsigned char* lds = (LAS unsigned char*)lds_raw;
    const int lo = P.ph_lo, hi = P.ph_hi;
#define IN(k) (lo <= (k) && (k) < hi)
    volatile LAS unsigned* bst = (volatile LAS unsigned*)(lds + LDS_BYTES - 32);
    if (threadIdx.x < 2) bst[threadIdx.x] = 0u;
    __syncthreads();
    const XcdBarrier bar = xcd_barrier_post((unsigned*)(P.ws + WS_CTL) + 4096, bst);
#define SEAM(k) do { if (IN(k) && IN((k) + 1)) xcd_barrier(bar); } while (0)
    if (IN(0)) phase_prep(P, lds);
    SEAM(0);
    for (int l = 0; l < NL; ++l) {
        if (IN(1 + 3 * l)) phase_gemm1(P, lds, l);
        SEAM(1 + 3 * l);
        if (IN(2 + 3 * l)) phase_mid(P, lds, l);
        SEAM(2 + 3 * l);
        if (IN(3 + 3 * l)) phase_out(P, lds, l);
        SEAM(3 + 3 * l);
    }
#undef SEAM
#undef IN
}

extern "C" void kernel_launch(void* const* d_in, const int* in_sizes, int n_in, void* d_out, int out_size, void* d_ws, size_t ws_size, hipStream_t stream) {
    static int grid = 0;
    if (grid == 0) {
        if (ws_size < WS_END) { fprintf(stderr, "kernel_launch: workspace too small (%zu < %zu)\n", ws_size, (size_t)WS_END); grid = -1; return; }
        int dev = 0, cus = 0;
        hipGetDevice(&dev); hipDeviceGetAttribute(&cus, hipDeviceAttributeMultiprocessorCount, dev);
        hipFuncSetAttribute((const void*)k_mega, hipFuncAttributeMaxDynamicSharedMemorySize, LDS_BYTES);
        int per_cu = 0;
        hipOccupancyMaxActiveBlocksPerMultiprocessor(&per_cu, (const void*)k_mega, 512, LDS_BYTES);
        if (per_cu < 1) { fprintf(stderr, "kernel_launch: occupancy query says %d blocks per CU\n", per_cu); per_cu = 1; }
        grid = (cus > 0 ? cus : 256) * 1;
    }
    if (grid < 0) return;
    unsigned char* ws = (unsigned char*)d_ws;
    Params P{};
    for (int i = 0; i < 25; ++i) P.in[i] = (const float*)d_in[i];
    P.out = (float*)d_out; P.ws = ws;
    hipMemsetAsync(ws + WS_CTL, 0, 32768, stream);
    P.ph_lo = 0; P.ph_hi = 7;
    void* args[] = {&P};
    hipError_t e = hipLaunchCooperativeKernel((const void*)k_mega, dim3(grid), dim3(512), args, LDS_BYTES, stream);
    if (e != hipSuccess) fprintf(stderr, "kernel_launch: cooperative launch failed: %s (grid %d)\n", hipGetErrorString(e), grid);
}
```

```cpp
#include <hip/hip_runtime.h>
#include <stdint.h>
#include <cstdio>

typedef unsigned short bf16;
typedef short bf16x8 __attribute__((ext_vector_type(8)));
typedef float f32x4 __attribute__((ext_vector_type(4)));
typedef unsigned u32x4 __attribute__((ext_vector_type(4)));
typedef unsigned u32x2 __attribute__((ext_vector_type(2)));
#define LAS __attribute__((address_space(3)))
__device__ __forceinline__ int otid() { int t = threadIdx.x; asm volatile("" : "+v"(t)); return t; }

constexpr int NB = 4, SEQ = 4096, DM = 2048, NT = NB * SEQ, NL = 2;
constexpr int INW = 5900;
constexpr int NP = 5888;
constexpr int O_MQ = 0, O_MK = 512, O_MV = 1024, O_MZ = 1536, O_NQ = 2048, O_KC = 2560, O_VC = 2688, O_KS = 2816, O_VS = 2944,
              O_KW = 3072, O_VW = 3200, O_NZ = 3328, O_SU = 3840, O_SZ = 4864;
constexpr int SRC_NG = 3328;
constexpr int NCMP = 255;
constexpr float EPSN = 1e-6f;
constexpr float SCALE = 0.08838834764831845f;

constexpr size_t MiB = 1u << 20;
constexpr size_t WS_CTL = 0;
constexpr size_t WS_WIN = 1 * MiB;
constexpr size_t WIN_BYTES = (size_t)NP * DM * 2;
constexpr size_t WS_WOUT = WS_WIN + 2 * WIN_BYTES;
constexpr size_t WOUT_BYTES = (size_t)DM * DM * 2;
constexpr size_t WS_GLU = WS_WOUT + 2 * WOUT_BYTES;
constexpr size_t GLU_BYTES = (size_t)1024 * 1024 * 2;
constexpr size_t WS_XB = WS_GLU + 2 * GLU_BYTES;
constexpr size_t WS_PROJ = WS_XB + (size_t)NT * DM * 2;
constexpr size_t WS_MIXED = WS_PROJ + (size_t)NT * NP * 2;
constexpr size_t WS_Y5 = WS_MIXED + (size_t)NT * DM * 2;
constexpr size_t WS_SSQP = WS_Y5 + (size_t)NT * 1024 * 2;
constexpr size_t WS_GATES = WS_SSQP + (size_t)NT * 32 * 4;
constexpr size_t WS_ROPE = WS_GATES + 1 * MiB;
constexpr size_t WS_RS = WS_ROPE + 512 * 1024;
constexpr size_t WS_KMEAN = WS_ROPE + 1 * MiB;
constexpr size_t WS_CMP = WS_KMEAN + 1 * MiB;
constexpr size_t WS_HID = WS_CMP + 1 * MiB;
constexpr size_t WS_CMPB = WS_HID + 1 * MiB;
constexpr size_t WS_ORDER = WS_CMPB + 1 * MiB;
constexpr size_t WS_S5K = WS_ORDER + 1 * MiB;
constexpr size_t WS_S5P1 = WS_S5K + 5 * MiB;
constexpr size_t WS_S5P2 = WS_S5P1 + 32 * MiB;
constexpr size_t WS_S5AL = WS_S5P2 + 32 * MiB;
constexpr size_t WS_W1F = WS_S5AL + 1 * MiB;
constexpr size_t WS_CST = WS_W1F + 4 * MiB;
constexpr size_t WS_WGF = WS_CST + 1 * MiB;
constexpr size_t WS_W2F = WS_WGF + 1 * MiB;
constexpr size_t WS_END = WS_W2F + 1 * MiB;
static_assert(WS_END <= 536870912ull, "workspace map exceeds 512 MiB");
constexpr size_t SUG_OFF = (size_t)256 * 256 * 128;

__device__ const double INVF[16] = {1.0, 0.44036660267178046, 0.19392274474868576, 0.08539710028576561, 0.03760603093086393,
    0.016560440080994446, 0.007292664737217109, 0.003211445994752591, 0.001414213562373095, 0.000622772421914596,
    0.0002742481756762073, 0.00012076973741146504, 5.318295896944988e-05, 2.341999896140934e-05, 1.031338537721246e-05,
    4.5416704806078695e-06};

__device__ __forceinline__ void dsincos(double a, double& s, double& c) {
    const double k = rint(a * 0.63661977236758134308);
    double r = fma(-k, 1.57079632679489655800e+00, a);
    r = fma(-k, 6.12323399573676603587e-17, r);
    const double r2 = r * r;
    double sp = 1.0 / 6227020800.0;
    sp = fma(sp, r2, -1.0 / 39916800.0); sp = fma(sp, r2, 1.0 / 362880.0); sp = fma(sp, r2, -1.0 / 5040.0);
    sp = fma(sp, r2, 1.0 / 120.0); sp = fma(sp, r2, -1.0 / 6.0); sp = fma(sp, r2, 1.0);
    const double sn = sp * r;
    double cp = -1.0 / 87178291200.0;
    cp = fma(cp, r2, 1.0 / 479001600.0); cp = fma(cp, r2, -1.0 / 3628800.0); cp = fma(cp, r2, 1.0 / 40320.0);
    cp = fma(cp, r2, -1.0 / 720.0); cp = fma(cp, r2, 1.0 / 24.0); cp = fma(cp, r2, -0.5); cp = fma(cp, r2, 1.0);
    const long long q = (long long)k & 3;
    if (q == 0) { s = sn; c = cp; } else if (q == 1) { s = cp; c = -sn; } else if (q == 2) { s = -sn; c = -cp; } else { s = -cp; c = sn; }
}
__device__ __forceinline__ float wave_sum(float v) {
#pragma unroll
    for (int o = 1; o < 64; o <<= 1) v += __shfl_xor(v, o);
    return v;
}
__device__ __forceinline__ float wave_max(float v) {
#pragma unroll
    for (int o = 1; o < 64; o <<= 1) v = fmaxf(v, __shfl_xor(v, o));
    return v;
}
__device__ __forceinline__ float sigmoidf_(float x) { return __builtin_amdgcn_rcpf(1.0f + __builtin_amdgcn_exp2f(-1.4426950408889634f * x)); }
__device__ __forceinline__ float siluf_(float x) { return x * sigmoidf_(x); }
__device__ __forceinline__ float geluf_(float x) { return x * sigmoidf_(1.5957691216057308f * (x + 0.044715f * x * x * x)); }
__device__ __forceinline__ float bf2f(bf16 b) { return __uint_as_float((unsigned)b << 16); }
__device__ __forceinline__ unsigned f2bf(float f) { const unsigned u = __float_as_uint(f); return (u + 0x7fffu + ((u >> 16) & 1u)) >> 16; }
__device__ __forceinline__ unsigned pk2(float lo, float hi) { return f2bf(lo) | (f2bf(hi) << 16); }
__device__ __forceinline__ float2 ld2(const bf16* p, int lane) { const unsigned w = ((const unsigned*)p)[lane]; return make_float2(__uint_as_float(w << 16), __uint_as_float(w & 0xffff0000u)); }

namespace pg8 {
constexpr int BM = 256, BK = 64, HALF = 128, HTB = HALF * BK * 2, STAGE_BYTES = 8 * HTB, NXCD = 8, WGM = 8;
__host__ __device__ __forceinline__ int lds_byte(int r, int c) { const int st = (r >> 4) * 2 + (c >> 5), rr = r & 15, cc = c & 31, ob = rr * 64 + cc * 2; return st * 1024 + (ob ^ (((ob >> 9) & 1) << 5)); }
__host__ __device__ __forceinline__ void stage_rc(int b, int& R, int& C) { const int st = b / 1024, sb = b % 1024, swz = sb ^ (((sb >> 9) & 1) << 5); R = (st >> 1) * 16 + swz / 64; C = (st & 1) * 32 + (swz % 64) / 2; }
__host__ __device__ __forceinline__ int perm32(int rho) { const int n = rho >> 4, i = rho & 15; return 8 * (i >> 2) + 4 * n + (i & 3); }
struct Unit { int pm, pn; };
struct Gemm { const bf16* A; const bf16* Bt; int M, N, K, lda; };
struct StaticOrder {
    int nM, nN, nwg, G, c, permN;
    __host__ __device__ void init(int M, int N, int G_, int c_, int permN_ = 0) { nM = M / BM; nN = N / BM; nwg = nM * nN; G = G_; c = c_; permN = permN_; }
    __host__ __device__ bool next(int i, Unit& u) const {
        const long L = (long)i * G + c; if (L >= nwg) return false;
        int wgid = (int)L; { const int q = nwg / NXCD, r = nwg % NXCD, xcd = wgid % NXCD, off = wgid / NXCD; wgid = (xcd < r ? xcd * (q + 1) : r * (q + 1) + (xcd - r) * q) + off; }
        const int nig = WGM * nN, gid = wgid / nig, fm = gid * WGM, gsz = (nM - fm) < WGM ? (nM - fm) : WGM;
        u.pm = fm + ((wgid % nig) % gsz); u.pn = (wgid % nig) / gsz;
        if (permN) u.pn = (int)((u.pn < 12 ? (0x14dc50c9a403169ull >> (5 * u.pn)) : (0x5a2a456071d1e6ull >> (5 * (u.pn - 12)))) & 31ull);
        return true;
    }
};
__device__ __forceinline__ unsigned cvt_pk_bf16(float lo, float hi) { unsigned r; asm volatile("v_cvt_pk_bf16_f32 %0, %1, %2" : "=v"(r) : "v"(lo), "v"(hi)); return r; }

template <class Epi, class Sched>
__device__ __forceinline__ void gemm_phase(LAS unsigned char* lds, const Gemm g, const Sched& S, const Epi& E) {
    constexpr bool ALIGN_EPI = true;
    const int tid = otid(), wid = __builtin_amdgcn_readfirstlane(tid >> 6), lane = tid & 63, wr = wid >> 2, wc = wid & 3, fr = lane & 15, fq = lane >> 4;
    const int K = g.K, nt = K / BK;
    unsigned voffA[2], voffB[2];
#pragma unroll
    for (int i = 0; i < 2; ++i) { int R, C; stage_rc(tid * 16 + i * 8192, R, C); const int Rb = Epi::PERM ? ((R & ~31) + perm32(R & 31)) : R;
        voffA[i] = (unsigned)(R * g.lda + C) * 2u; voffB[i] = (unsigned)(Rb * K + C) * 2u; }
    const size_t kstep = (size_t)(BK * 2);
    const size_t hstepA = (size_t)HALF * g.lda * 2, hstepB = (size_t)HALF * K * 2;
    const size_t tstepA = 2 * hstepA, tstepB = 2 * hstepB;
    const unsigned ldsw = (unsigned)wid * 1024u;
    const int aoff = lds_byte(wr * 64 + fr, fq * 8), boff = lds_byte(wc * 32 + fr, fq * 8);
#define PG8_SA(b, h) (((b) * 2 + (h)) * HTB)
#define PG8_SB(b, h) ((4 + (b) * 2 + (h)) * HTB)
#define PG8_STAGE(bufoff, gbase, voff) do { _Pragma("unroll") for (int _i = 0; _i < 2; ++_i) \
        __builtin_amdgcn_global_load_lds((const unsigned*)((const char*)(gbase) + (voff)[_i]), (LAS unsigned*)(lds + (bufoff) + ldsw + _i * 8192), 16, 0, 0); } while (0)
#define PG8_LDA(dst, b, h) do { _Pragma("unroll") for (int m = 0; m < 4; ++m) _Pragma("unroll") for (int k = 0; k < 2; ++k) dst[m][k] = *(const LAS bf16x8*)(lds + PG8_SA(b, h) + aoff + m * 2048 + k * 1024); } while (0)
#define PG8_LDB(dst, b, h) do { _Pragma("unroll") for (int n = 0; n < 2; ++n) _Pragma("unroll") for (int k = 0; k < 2; ++k) dst[n][k] = *(const LAS bf16x8*)(lds + PG8_SB(b, h) + boff + n * 2048 + k * 1024); } while (0)
#define PG8_MMA(ai, bj, At, Bt) do { __builtin_amdgcn_s_setprio(1); _Pragma("unroll") for (int m = 0; m < 4; ++m) _Pragma("unroll") for (int n = 0; n < 2; ++n) _Pragma("unroll") for (int k = 0; k < 2; ++k) \
        acc[ai][bj][m][n] = __builtin_amdgcn_mfma_f32_16x16x32_bf16(Bt[n][k], At[m][k], acc[ai][bj][m][n], 0, 0, 0); __builtin_amdgcn_s_setprio(0); } while (0)
#define PG8_WAIT_V(n) asm volatile("s_waitcnt vmcnt(" #n ")" ::: "memory")
#define PG8_WAIT_L(n) asm volatile("s_waitcnt lgkmcnt(" #n ")" ::: "memory")
#define PG8_BAR __builtin_amdgcn_s_barrier()
#define PG8_SCHED __builtin_amdgcn_sched_barrier(0)
    Unit cur, nxt; int ui = 0;
    if (!S.next(0, cur)) return;
    typename Epi::Pre pre = E.pre(cur, wr), pren = pre;
    f32x4 acc[2][2][4][2];
#pragma unroll
    for (int a = 0; a < 2; ++a)
#pragma unroll
        for (int b = 0; b < 2; ++b)
#pragma unroll
            for (int m = 0; m < 4; ++m)
#pragma unroll
                for (int n = 0; n < 2; ++n) acc[a][b][m][n] = (f32x4){0.f, 0.f, 0.f, 0.f};
    bf16x8 At[4][2], B0[2][2], B1[2][2];
    const char* cA = (const char*)g.A + (size_t)cur.pm * tstepA; const char* cB = (const char*)g.Bt + (size_t)cur.pn * tstepB;
    PG8_STAGE(PG8_SB(0, 0), cB, voffB); PG8_STAGE(PG8_SB(0, 1), cB + hstepB, voffB); PG8_STAGE(PG8_SA(0, 0), cA, voffA); PG8_STAGE(PG8_SA(0, 1), cA + hstepA, voffA);
    if (wr == 1) PG8_BAR;
    PG8_WAIT_V(2); PG8_BAR;
    PG8_STAGE(PG8_SB(1, 0), cB + kstep, voffB); PG8_STAGE(PG8_SA(1, 0), cA + kstep, voffA); PG8_STAGE(PG8_SB(1, 1), cB + hstepB + kstep, voffB);
    PG8_WAIT_V(6); PG8_BAR;
    for (;;) {
        const bool has_next = S.next(ui + 1, nxt);
        const char* nA = has_next ? (const char*)g.A + (size_t)nxt.pm * tstepA : cA; const char* nB = has_next ? (const char*)g.Bt + (size_t)nxt.pn * tstepB : cB;
        for (int t = 0; t < nt; t += 2) {
            const bool last = (t == nt - 2);
            const char* a1 = cA + (size_t)(t + 1) * kstep;
            const char* a2 = last ? nA : cA + (size_t)(t + 2) * kstep; const char* b2 = last ? nB : cB + (size_t)(t + 2) * kstep;
            const char* a3 = a2 + kstep; const char* b3 = b2 + kstep;
            PG8_LDB(B0, 0, 0); PG8_LDB(B1, 0, 1); PG8_SCHED; PG8_LDA(At, 0, 0); PG8_STAGE(PG8_SA(1, 1), a1 + hstepA, voffA);
            PG8_WAIT_V(8); PG8_WAIT_L(0); PG8_BAR; PG8_MMA(0, 0, At, B0); PG8_MMA(0, 1, At, B1); PG8_BAR; PG8_SCHED;
            PG8_LDA(At, 0, 1); PG8_STAGE(PG8_SB(0, 0), b2, voffB); PG8_STAGE(PG8_SB(0, 1), b2 + hstepB, voffB); PG8_STAGE(PG8_SA(0, 0), a2, voffA);
            PG8_WAIT_V(8); PG8_WAIT_L(0); PG8_BAR; PG8_MMA(1, 0, At, B0); PG8_MMA(1, 1, At, B1); PG8_BAR; PG8_SCHED;
            PG8_LDB(B0, 1, 0); PG8_LDB(B1, 1, 1); PG8_SCHED; PG8_LDA(At, 1, 0); PG8_STAGE(PG8_SA(0, 1), a2 + hstepA, voffA);
            PG8_WAIT_V(8); PG8_WAIT_L(0); PG8_BAR; PG8_MMA(0, 0, At, B0); PG8_MMA(0, 1, At, B1); PG8_BAR; PG8_SCHED;
            PG8_LDA(At, 1, 1); PG8_STAGE(PG8_SB(1, 0), b3, voffB); PG8_STAGE(PG8_SB(1, 1), b3 + hstepB, voffB); PG8_STAGE(PG8_SA(1, 0), a3, voffA);
            PG8_WAIT_V(8); PG8_WAIT_L(0); PG8_BAR; PG8_MMA(1, 0, At, B0); PG8_MMA(1, 1, At, B1); PG8_BAR; PG8_SCHED;
        }
        if constexpr (ALIGN_EPI) { if (wr == 0) PG8_BAR; }
        if (has_next) pren = E.pre(nxt, wr);
        E(acc, cur, wr, wc, fr, fq, pre);
        if (!has_next) break;
        pre = pren;
#pragma unroll
        for (int a = 0; a < 2; ++a)
#pragma unroll
            for (int b = 0; b < 2; ++b)
#pragma unroll
                for (int m = 0; m < 4; ++m)
#pragma unroll
                    for (int n = 0; n < 2; ++n) acc[a][b][m][n] = (f32x4){0.f, 0.f, 0.f, 0.f};
        cur = nxt; cA = nA; cB = nB; ++ui;
        if constexpr (ALIGN_EPI) { if (wr == 1) PG8_BAR; }
    }
    PG8_WAIT_V(0);
    if constexpr (!ALIGN_EPI) { if (wr == 0) PG8_BAR; }
    PG8_BAR;
#undef PG8_SA
#undef PG8_SB
#undef PG8_STAGE
#undef PG8_LDA
#undef PG8_LDB
#undef PG8_MMA
#undef PG8_WAIT_V
#undef PG8_WAIT_L
#undef PG8_BAR
#undef PG8_SCHED
}
}

struct EpiProj {
    static constexpr bool PERM = true;
    bf16* O; bf16* ug; const float* rs; const float *nw0, *nw1, *nw2, *nw3, *nw4; const float2* cs; float* kmean; LAS unsigned char* xl;
    struct Pre { float r0, r1; };
    __device__ __forceinline__ Pre pre(const pg8::Unit& u, int wr) const { const float* p = rs + u.pm * 256 + 64 * wr + (otid() & 63); Pre q; q.r0 = p[0]; q.r1 = p[128]; return q; }
    __device__ __forceinline__ static int nid(int h) { return h < 4 ? 0 : h < 8 ? 1 : (h >= 16 && h < 20) ? 2 : h == 22 ? 3 : h == 24 ? 4 : -1; }
    __device__ __forceinline__ void operator()(const f32x4 (&acc)[2][2][4][2], const pg8::Unit& u, int wr, int wc, int fr, int fq, const Pre& pr) const {
        const float rsv[2] = {pr.r0, pr.r1};
        const int row0 = u.pm * 256 + wr * 64 + fr, col0 = u.pn * 256 + wc * 32 + 8 * fq;
        const int n0 = nid(2 * u.pn), n1 = nid(2 * u.pn + 1);
        if (n0 < 0 && n1 < 0) {
            const bool su = (u.pn >= O_SU / 256) && (u.pn < O_SZ / 256);
            const int cs0 = col0 - O_SU;
#pragma unroll
            for (int ai = 0; ai < 2; ++ai)
#pragma unroll
                for (int m = 0; m < 4; ++m) {
                    const float r = __shfl(rsv[ai], m * 16 + fr);
                    const int row = row0 + ai * 128 + m * 16;
                    bf16* rowp = su ? ug + (((size_t)((row >> 12) * 64 + (cs0 >> 4)) * SEQ + (row & (SEQ - 1))) * 16 + (cs0 & 8)) : O + (size_t)row * NP + col0;
                    const size_t bjs = su ? (size_t)8 * SEQ * 16 : (size_t)128;
#pragma unroll
                    for (int bj = 0; bj < 2; ++bj) { const f32x4 v0 = acc[ai][bj][m][0] * r, v1 = acc[ai][bj][m][1] * r;
                        u32x4 w; w.x = pg8::cvt_pk_bf16(v0[0], v0[1]); w.y = pg8::cvt_pk_bf16(v0[2], v0[3]); w.z = pg8::cvt_pk_bf16(v1[0], v1[1]); w.w = pg8::cvt_pk_bf16(v1[2], v1[3]);
                        *(u32x4*)(rowp + bj * bjs) = w; }
                }
            return;
        }
        LAS float* part = (LAS float*)xl;
        LAS float* ksum = (LAS float*)(xl + 8192);
#pragma unroll
        for (int ai = 0; ai < 2; ++ai)
#pragma unroll
            for (int m = 0; m < 4; ++m) {
                const float r = __shfl(rsv[ai], m * 16 + fr);
#pragma unroll
                for (int bj = 0; bj < 2; ++bj) { const f32x4 v0 = acc[ai][bj][m][0] * r, v1 = acc[ai][bj][m][1] * r;
                    float ss = (v0[0] * v0[0] + v0[1] * v0[1]) + (v0[2] * v0[2] + v0[3] * v0[3]) + (v1[0] * v1[0] + v1[1] * v1[1]) + (v1[2] * v1[2] + v1[3] * v1[3]);
                    ss += __shfl_xor(ss, 16); ss += __shfl_xor(ss, 32);
                    if (fq == 0) part[((ai * 128 + wr * 64 + m * 16 + fr) * 2 + bj) * 4 + wc] = ss; }
            }
        asm volatile("s_waitcnt lgkmcnt(0)" ::: "memory"); __builtin_amdgcn_s_barrier(); asm volatile("" ::: "memory");
        float csum[2][8];
#pragma unroll
        for (int bj = 0; bj < 2; ++bj)
#pragma unroll
            for (int e = 0; e < 8; ++e) csum[bj][e] = 0.f;
        f32x4 wq[2][2];
#pragma unroll
        for (int bj = 0; bj < 2; ++bj) { const int ni = bj ? n1 : n0;
            const float* wp = (ni <= 0 ? nw0 : ni == 1 ? nw1 : ni == 2 ? nw2 : ni == 3 ? nw3 : nw4) + wc * 32 + 8 * fq;
            wq[bj][0] = *(const f32x4*)wp; wq[bj][1] = *(const f32x4*)(wp + 4); }
        f32x4 cnx[4];
        const int ol = otid() & 63, ofr = ol & 15, ofq1 = (ol >> 4) & 1;
        { const f32x4* c4 = (const f32x4*)(cs + (size_t)((u.pm * 256 + wr * 64 + ofr) & (SEQ - 1)) * 16 + 8 * ofq1);
#pragma unroll
          for (int q = 0; q < 4; ++q) cnx[q] = c4[q]; }
#pragma unroll
        for (int ai = 0; ai < 2; ++ai)
#pragma unroll
            for (int m = 0; m < 4; ++m) {
                const float r = __shfl(rsv[ai], m * 16 + fr);
                const int rl = ai * 128 + wr * 64 + m * 16 + fr;
                bf16* rowp = O + (size_t)(u.pm * 256 + rl) * NP + col0;
                f32x4 ccur[4];
#pragma unroll
                for (int q = 0; q < 4; ++q) ccur[q] = cnx[q];
                if (ai * 4 + m < 7) { const int rn_ = (ai * 4 + m + 1 >= 4 ? 128 : 0) + wr * 64 + ((ai * 4 + m + 1) & 3) * 16 + ofr;
                    const f32x4* c4 = (const f32x4*)(cs + (size_t)((u.pm * 256 + rn_) & (SEQ - 1)) * 16 + 8 * ofq1);
#pragma unroll
                    for (int q = 0; q < 4; ++q) cnx[q] = c4[q]; }
#pragma unroll
                for (int bj = 0; bj < 2; ++bj) {
                    const int ni = bj ? n1 : n0;
                    float v[8];
#pragma unroll
                    for (int e = 0; e < 8; ++e) v[e] = ((e < 4) ? acc[ai][bj][m][0][e & 3] : acc[ai][bj][m][1][e & 3]) * r;
                    if (ni >= 0) {
                        const f32x4 p4 = *(const LAS f32x4*)(part + (rl * 2 + bj) * 4);
                        const float rn = 1.0f / sqrtf(((p4[0] + p4[1]) + (p4[2] + p4[3])) * (1.0f / 128.0f) + EPSN);
#pragma unroll
                        for (int e = 0; e < 8; ++e) v[e] *= rn * ((e < 4) ? wq[bj][0][e & 3] : wq[bj][1][e & 3]);
                        if (wc == 0) {
#pragma unroll
                            for (int e = 0; e < 8; ++e) { const float other = __shfl_xor(v[e], 32); const float cx = ccur[e >> 1][2 * (e & 1)], cy = ccur[e >> 1][2 * (e & 1) + 1];
                                v[e] = (fq < 2) ? (v[e] * cx - other * cy) : (v[e] * cx + other * cy); }
                        }
                        if (ni == 1) {
#pragma unroll
                            for (int e = 0; e < 8; ++e) csum[bj][e] += v[e];
                        }
                    }
                    u32x4 w; w.x = pg8::cvt_pk_bf16(v[0], v[1]); w.y = pg8::cvt_pk_bf16(v[2], v[3]); w.z = pg8::cvt_pk_bf16(v[4], v[5]); w.w = pg8::cvt_pk_bf16(v[6], v[7]);
                    *(u32x4*)(rowp + bj * 128) = w;
                }
                asm volatile("" ::: "memory");
            }
        if (n0 == 1) {
#pragma unroll
            for (int bj = 0; bj < 2; ++bj)
#pragma unroll
                for (int e = 0; e < 8; ++e) { float s = csum[bj][e]; s += __shfl_xor(s, 1); s += __shfl_xor(s, 2); s += __shfl_xor(s, 4); s += __shfl_xor(s, 8);
                    if (fr == 0) ksum[wr * 256 + bj * 128 + wc * 32 + 8 * fq + e] = s; }
            asm volatile("s_waitcnt lgkmcnt(0)" ::: "memory"); __builtin_amdgcn_s_barrier(); asm volatile("" ::: "memory");
            const int tid = otid();
            if (tid < 256) { const int h = 2 * u.pn + (tid >> 7) - 4, b = u.pm >> 4, n = u.pm & 15;
                kmean[((size_t)(b * 4 + h) * 16 + n) * 128 + (tid & 127)] = (ksum[tid] + ksum[256 + tid]) * (1.0f / 256.0f); }
        }
    }
};
struct EpiGlu {
    static constexpr bool PERM = true;
    bf16* mixed; const bf16* y5; const bf16* proj;
    struct Pre {};
    __device__ __forceinline__ Pre pre(const pg8::Unit&, int) const { return Pre{}; }
    __device__ __forceinline__ void operator()(const f32x4 (&acc)[2][2][4][2], const pg8::Unit& u, int wr, int wc, int fr, int fq, const Pre&) const {
        const int row0 = u.pm * 256 + wr * 64 + fr, col0 = u.pn * 256 + wc * 32 + 8 * fq;
#pragma unroll
        for (int ai = 0; ai < 2; ++ai) {
            u32x4 yv[4][2], zv[4][2];
#pragma unroll
            for (int m = 0; m < 4; ++m)
#pragma unroll
                for (int bj = 0; bj < 2; ++bj) { const size_t row = (size_t)(row0 + ai * 128 + m * 16); const int col = col0 + bj * 128;
                    yv[m][bj] = *(const u32x4*)(y5 + row * 1024 + col); zv[m][bj] = *(const u32x4*)(proj + row * NP + O_SZ + col); }
            asm volatile("" ::: "memory");
#pragma unroll
            for (int m = 0; m < 4; ++m) {
                const size_t row = (size_t)(row0 + ai * 128 + m * 16);
#pragma unroll
                for (int bj = 0; bj < 2; ++bj) {
                    const int col = col0 + bj * 128;
                    float o[8];
#pragma unroll
                    for (int e = 0; e < 8; ++e) {
                        const float a = (e < 4) ? acc[ai][bj][m][0][e & 3] : acc[ai][bj][m][1][e & 3];
                        const unsigned yw = yv[m][bj][e >> 1], zw = zv[m][bj][e >> 1];
                        const float y = (e & 1) ? __uint_as_float(yw & 0xffff0000u) : __uint_as_float(yw << 16);
                        const float z = (e & 1) ? __uint_as_float(zw & 0xffff0000u) : __uint_as_float(zw << 16);
                        o[e] = y * sigmoidf_(a) * siluf_(z);
                    }
                    u32x4 w; w.x = pg8::cvt_pk_bf16(o[0], o[1]); w.y = pg8::cvt_pk_bf16(o[2], o[3]); w.z = pg8::cvt_pk_bf16(o[4], o[5]); w.w = pg8::cvt_pk_bf16(o[6], o[7]);
                    *(u32x4*)(mixed + row * DM + 1024 + col) = w;
                }
            }
        }
    }
};
struct EpiOut {
    static constexpr bool PERM = true;
    float* out; bf16* xb; float* ssqp; int last; float* rs; unsigned* cnt; LAS unsigned* fl;
    struct Pre {};
    __device__ __forceinline__ Pre pre(const pg8::Unit&, int) const { return Pre{}; }
    __device__ __forceinline__ void operator()(const f32x4 (&acc)[2][2][4][2], const pg8::Unit& u, int wr, int wc, int fr, int fq, const Pre&) const {
        const int row0 = u.pm * 256 + wr * 64 + fr, col0 = u.pn * 256 + wc * 32 + 8 * fq;
#pragma unroll
        for (int ai = 0; ai < 2; ++ai) {
            u32x4 xv[4][2];
#pragma unroll
            for (int m = 0; m < 4; ++m)
#pragma unroll
                for (int bj = 0; bj < 2; ++bj) xv[m][bj] = *(const u32x4*)(xb + (size_t)(row0 + ai * 128 + m * 16) * DM + col0 + bj * 128);
            asm volatile("" ::: "memory");
#pragma unroll
            for (int m = 0; m < 4; ++m) {
                const size_t row = (size_t)(row0 + ai * 128 + m * 16);
                float ss = 0.f;
#pragma unroll
                for (int bj = 0; bj < 2; ++bj) {
                    const size_t off = row * DM + col0 + bj * 128;
                    const u32x4 xw = xv[m][bj];
                    f32x4 a, b;
                    a[0] = __uint_as_float(xw.x << 16) + acc[ai][bj][m][0][0]; a[1] = __uint_as_float(xw.x & 0xffff0000u) + acc[ai][bj][m][0][1];
                    a[2] = __uint_as_float(xw.y << 16) + acc[ai][bj][m][0][2]; a[3] = __uint_as_float(xw.y & 0xffff0000u) + acc[ai][bj][m][0][3];
                    b[0] = __uint_as_float(xw.z << 16) + acc[ai][bj][m][1][0]; b[1] = __uint_as_float(xw.z & 0xffff0000u) + acc[ai][bj][m][1][1];
                    b[2] = __uint_as_float(xw.w << 16) + acc[ai][bj][m][1][2]; b[3] = __uint_as_float(xw.w & 0xffff0000u) + acc[ai][bj][m][1][3];
                    if (last) { *(f32x4*)(out + off) = a; *(f32x4*)(out + off + 4) = b; }
                    else {
                        ss += ((a[0] * a[0] + a[1] * a[1]) + (a[2] * a[2] + a[3] * a[3])) + ((b[0] * b[0] + b[1] * b[1]) + (b[2] * b[2] + b[3] * b[3]));
                        u32x4 w; w.x = pg8::cvt_pk_bf16(a[0], a[1]); w.y = pg8::cvt_pk_bf16(a[2], a[3]); w.z = pg8::cvt_pk_bf16(b[0], b[1]); w.w = pg8::cvt_pk_bf16(b[2], b[3]);
                        *(u32x4*)(xb + off) = w;
                    }
                }
                if (!last) {
                    ss += __shfl_xor(ss, 16); ss += __shfl_xor(ss, 32);
                    if (fq == 0) ssqp[row * 32 + u.pn * 4 + wc] = ss;
                }
            }
        }
        if (!last) {
            const int tid = otid();
            asm volatile("s_waitcnt vmcnt(0)" ::: "memory"); __builtin_amdgcn_s_barrier();
            if (tid == 0) { __builtin_amdgcn_fence(__ATOMIC_RELEASE, "agent"); asm volatile("s_waitcnt vmcnt(0)" ::: "memory");
                const unsigned old = __hip_atomic_fetch_add(cnt + u.pm, 1u, __ATOMIC_RELAXED, __HIP_MEMORY_SCOPE_AGENT);
                if (old == 7u) { __builtin_amdgcn_fence(__ATOMIC_ACQUIRE, "agent"); asm volatile("s_waitcnt vmcnt(0)" ::: "memory"); }
                fl[0] = old; }
            asm volatile("s_waitcnt lgkmcnt(0)" ::: "memory"); __builtin_amdgcn_s_barrier(); asm volatile("" ::: "memory");
            if (fl[0] == 7u) { asm volatile("; last arriver" ::: "memory");
                if (tid < 256) { const f32x4* sp = (const f32x4*)(ssqp + (size_t)(u.pm * 256 + tid) * 32); float s = 0.f;
#pragma unroll
                    for (int i = 0; i < 8; ++i) { const f32x4 v = sp[i]; s += (v[0] + v[1]) + (v[2] + v[3]); }
                    rs[u.pm * 256 + tid] = 1.0f / sqrtf(s * (1.0f / DM) + EPSN); }
            }
        }
    }
};

struct Params {
    const float* in[25];
    float* out;
    unsigned char* ws;
    int ph_lo, ph_hi;
};
constexpr int LDS_BYTES = 147456;
constexpr int NWAVES = 8;

namespace a1 { __device__ __forceinline__ void prep_w1(const Params& P, LAS unsigned char* lds); }
namespace s5 { __device__ __forceinline__ void tables_task(const Params& P, LAS unsigned char* lds, const int l, const int g, const int part); }
__device__ __forceinline__ void p0_transpose_item(const float* W, int ldsrc, int srccol0, int K, const float* kscale, bf16* WT, int n0, int k0, LAS float* scr, int lane) {
    float tv[32];
#pragma unroll
    for (int i = 0; i < 32; ++i) tv[i] = W[(size_t)(k0 + 2 * i + (lane >> 5)) * ldsrc + srccol0 + (lane & 31)];
#pragma unroll
    for (int i = 0; i < 32; ++i) { const int kk = 2 * i + (lane >> 5); float v = tv[i]; if (kscale) v *= kscale[k0 + kk]; scr[kk * 33 + (lane & 31)] = v; }
    asm volatile("s_waitcnt lgkmcnt(0)" ::: "memory");
    const int c = lane & 7;
#pragma unroll
    for (int j = 0; j < 4; ++j) { const int n = (lane >> 3) + 8 * j; const LAS float* s = scr + (8 * c) * 33 + n;
        u32x4 o; o.x = pk2(s[0 * 33], s[1 * 33]); o.y = pk2(s[2 * 33], s[3 * 33]); o.z = pk2(s[4 * 33], s[5 * 33]); o.w = pk2(s[6 * 33], s[7 * 33]);
        *(u32x4*)(WT + (size_t)(n0 + n) * K + k0 + 8 * c) = o; }
    asm volatile("s_waitcnt lgkmcnt(0)" ::: "memory");
}
__device__ __forceinline__ void phase_prep(const Params& P, LAS unsigned char* lds) {
    const int tid = otid(), lane = tid & 63, wave = tid >> 6;
    LAS float* scr = (LAS float*)(lds + wave * 16384);
    const int gw = blockIdx.x * NWAVES + wave, NGW = gridDim.x * NWAVES;
    constexpr int I_IN = (DM / 64) * (NP / 32), I_OUT = (DM / 64) * (DM / 32), I_GLU = (1024 / 64) * (1024 / 32);
    constexpr int PER_L = I_IN + I_OUT + I_GLU;
    for (int pass = 0; pass < 2; ++pass) {
    if ((pass == 0) == ((blockIdx.x & 1) == 0)) {
    for (int it = gw; it < NL * PER_L; it += NGW) {
        const int l = it / PER_L; int r = it % PER_L;
        if (r < I_IN) { const int nb = r % (NP / 32), kb = r / (NP / 32), n0 = nb * 32, src = n0 + (n0 >= SRC_NG ? 12 : 0);
            p0_transpose_item(P.in[2] + (size_t)l * DM * INW, INW, src, DM, P.in[1] + l * DM, (bf16*)(P.ws + WS_WIN + l * WIN_BYTES), n0, kb * 64, scr, lane); continue; }
        r -= I_IN;
        if (r < I_OUT) { const int nb = r % (DM / 32), kb = r / (DM / 32);
            p0_transpose_item(P.in[3] + (size_t)l * DM * DM, DM, nb * 32, DM, nullptr, (bf16*)(P.ws + WS_WOUT + l * WOUT_BYTES), nb * 32, kb * 64, scr, lane); continue; }
        r -= I_OUT;
        { const int nb = r % 32, kb = r / 32;
            p0_transpose_item(P.in[24] + (size_t)l * 1024 * 1024, 1024, nb * 32, 1024, nullptr, (bf16*)(P.ws + WS_GLU + l * GLU_BYTES), nb * 32, kb * 64, scr, lane); }
    }
    const float* x = P.in[0]; bf16* xb = (bf16*)(P.ws + WS_XB); float* rs = (float*)(P.ws + WS_RS);
    for (int m = gw; m < NT; m += NGW) {
        const f32x4* xr = (const f32x4*)(x + (size_t)m * DM) + lane;
        u32x2* o8 = (u32x2*)(xb + (size_t)m * DM) + lane;
        float s = 0.f;
        f32x4 xv[8];
#pragma unroll
        for (int j = 0; j < 8; ++j) xv[j] = xr[64 * j];
        __builtin_amdgcn_sched_barrier(0);
#pragma unroll
        for (int j = 0; j < 8; ++j) { const f32x4 v = xv[j]; s += (v[0] * v[0] + v[1] * v[1]) + (v[2] * v[2] + v[3] * v[3]); u32x2 w; w.x = pk2(v[0], v[1]); w.y = pk2(v[2], v[3]); o8[64 * j] = w; }
        __builtin_amdgcn_sched_barrier(0);
        s = wave_sum(s);
        if (lane == 0) rs[m] = 1.0f / sqrtf(s * (1.0f / DM) + EPSN);
    }
    float2* cs = (float2*)(P.ws + WS_ROPE);
    for (int i = blockIdx.x * blockDim.x + tid; i < SEQ * 16; i += gridDim.x * blockDim.x) {
        double s, c; dsincos((double)(i >> 4) * INVF[i & 15], s, c); cs[i] = make_float2((float)c, (float)s);
    }
    } else {
        for (int t = blockIdx.x; t < NL * 64 * 4; t += gridDim.x) s5::tables_task(P, lds, t >> 8, (t >> 2) & 63, t & 3);
    }
    __syncthreads();
    }
    a1::prep_w1(P, lds);
    if (blockIdx.x == 0) {
        int* order = (int*)(P.ws + WS_ORDER);
        const int u = tid; const int cu = (u < 256) ? (2 * (u & 63) + 46) : (8 * ((u - 256) & 15) + 9);
        int rank = 0;
        for (int v = 0; v < 512; ++v) { const int cv = (v < 256) ? (2 * (v & 63) + 46) : (8 * ((v - 256) & 15) + 9); rank += (cv > cu || (cv == cu && v < u)) ? 1 : 0; }
        order[rank] = u;
    }
}

__device__ __forceinline__ void phase_gemm1(const Params& P, LAS unsigned char* lds, int l) {
    pg8::Gemm g{(const bf16*)(P.ws + WS_XB), (const bf16*)(P.ws + WS_WIN + l * WIN_BYTES), NT, NP, DM, DM};
    pg8::StaticOrder S; S.init(NT, NP, gridDim.x, blockIdx.x, 1);
    EpiProj E{(bf16*)(P.ws + WS_PROJ), (bf16*)(P.out + SUG_OFF), (const float*)(P.ws + WS_RS), P.in[4] + l * 128, P.in[5] + l * 128, P.in[6] + l * 128, P.in[8] + l * 128, P.in[9] + l * 128,
              (const float2*)(P.ws + WS_ROPE), (float*)(P.ws + WS_KMEAN), lds + 131072};
    pg8::gemm_phase<EpiProj, pg8::StaticOrder>(lds, g, S, E);
}
__device__ __forceinline__ void phase_out(const Params& P, LAS unsigned char* lds, int l) {
    pg8::Gemm g{(const bf16*)(P.ws + WS_MIXED), (const bf16*)(P.ws + WS_WOUT + l * WOUT_BYTES), NT, DM, DM, DM};
    pg8::StaticOrder S; S.init(NT, DM, gridDim.x, blockIdx.x);
    EpiOut E{P.out, (bf16*)(P.ws + WS_XB), (float*)(P.ws + WS_SSQP), l == NL - 1 ? 1 : 0, (float*)(P.ws + WS_RS), (unsigned*)(P.ws + WS_CTL) + 2048 + 64 * l, (LAS unsigned*)(lds + 131072 + 12288)};
    pg8::gemm_phase<EpiOut, pg8::StaticOrder>(lds, g, S, E);
}

namespace att {
typedef short s16x4 __attribute__((ext_vector_type(4)));
typedef float f32x16 __attribute__((ext_vector_type(16)));
constexpr int SHM_K = 16384, SHM_V = 16384;
constexpr int OFF_V = 0, OFF_K = 2 * SHM_V, OFF_WS = 2 * SHM_V + 2 * SHM_K;
constexpr int OFF_X = OFF_WS + 8 * 256;
constexpr unsigned WINF = 0x7fffffffu;
constexpr float THR = 8.f;
#define KSWZ(row, colB) ((row) * 256 + ((colB) ^ (((row) & 7) << 4)))
#define SBAR() __builtin_amdgcn_sched_barrier(0)
#define LDSBAR() do { asm volatile("s_waitcnt lgkmcnt(0)" ::: "memory"); __builtin_amdgcn_s_barrier(); asm volatile("" ::: "memory"); } while (0)
__device__ __forceinline__ int v_st(int k, int c) { const int kk = (k & ~0xC) | ((k & 4) << 1) | ((k & 8) >> 1); return ((kk >> 3) * 4 + (c >> 5)) * 512 + ((kk & 7) * 32 + (c & 31)) * 2; }
__device__ __forceinline__ int v_rd_base(int lane) { return ((lane & 3) << 3) | (((lane >> 2) & 3) << 6) | (((lane >> 4) & 1) << 5) | (((lane >> 5) & 1) << 8); }
constexpr int v_rd_off(int d0, int ks, int half) { return d0 * 512 + ks * 4096 + half * 2048; }
__device__ __forceinline__ int crow(int r, int hi) { return (r & 3) + 8 * (r >> 2) + 4 * hi; }
__device__ __forceinline__ unsigned cvtpk(float lo, float hi) { unsigned r; asm volatile("v_cvt_pk_bf16_f32 %0, %1, %2" : "=v"(r) : "v"(lo), "v"(hi)); return r; }

__device__ __forceinline__ void mask_tile(f32x16& p0, f32x16& p1, int dq, unsigned W) {
    const float NEG = -__builtin_inff();
#pragma unroll
    for (int r = 0; r < 16; ++r) {
        const int c = (r & 3) + 8 * (r >> 2);
        if ((unsigned)(dq - c) >= W) p0[r] = NEG;
        if ((unsigned)(dq - c - 32) >= W) p1[r] = NEG;
    }
}
__device__ __forceinline__ void qkt(f32x16& p0, f32x16& p1, LAS const unsigned char* Kb, int r32, int hi, const bf16x8* qr) {
    p0 = f32x16{}; p1 = f32x16{};
    const int ka0 = (int)(uintptr_t)(Kb + KSWZ(r32, (0 * 16 + hi * 8) * 2)), ka1 = (int)(uintptr_t)(Kb + KSWZ(r32, (1 * 16 + hi * 8) * 2));
    const int ka2 = (int)(uintptr_t)(Kb + KSWZ(r32, (2 * 16 + hi * 8) * 2)), ka3 = (int)(uintptr_t)(Kb + KSWZ(r32, (3 * 16 + hi * 8) * 2));
#define Q_KR(dst, addr, off) asm volatile("ds_read_b128 %0, %1 offset:%2" : "=&v"(dst) : "v"(addr), "i"(off) : "memory")
#define Q_KRD(F, kaa, kab, hoff) do { Q_KR(F[0], kaa, hoff); Q_KR(F[1], kaa, hoff + 8192); Q_KR(F[2], kab, hoff); Q_KR(F[3], kab, hoff + 8192); } while (0)
#define Q_WAIT() do { asm volatile("s_waitcnt lgkmcnt(0)" ::: "memory"); SBAR(); } while (0)
#define Q_QK(F, q0) do { \
        p0 = __builtin_amdgcn_mfma_f32_32x32x16_bf16(F[0], qr[q0], p0, 0, 0, 0); p1 = __builtin_amdgcn_mfma_f32_32x32x16_bf16(F[1], qr[q0], p1, 0, 0, 0); \
        p0 = __builtin_amdgcn_mfma_f32_32x32x16_bf16(F[2], qr[q0 + 1], p0, 0, 0, 0); p1 = __builtin_amdgcn_mfma_f32_32x32x16_bf16(F[3], qr[q0 + 1], p1, 0, 0, 0); } while (0)
    bf16x8 FA[4], FB[4];
    Q_KRD(FA, ka0, ka1, 0); Q_WAIT();
    Q_KRD(FB, ka2, ka3, 0); Q_QK(FA, 0); Q_WAIT();
    Q_KRD(FA, ka0, ka1, 128); Q_QK(FB, 2); Q_WAIT();
    Q_KRD(FB, ka2, ka3, 128); Q_QK(FA, 4); Q_WAIT();
    Q_QK(FB, 6);
#undef Q_KR
#undef Q_KRD
#undef Q_WAIT
#undef Q_QK
}
__device__ __forceinline__ void pv_tile(f32x16* o, int vb, bf16x8 pa0, bf16x8 pa1, bf16x8 pa2, bf16x8 pa3) {
#define TRRD(dst, off) asm volatile("ds_read_b64_tr_b16 %0, %1 offset:%2" : "=&v"(dst) : "v"(vb), "i"(off) : "memory")
#define PV_D0(d0) do { s16x4 l0, l1, l2, l3, h0, h1, h2, h3; constexpr int b_ = v_rd_off(d0, 0, 0); \
        TRRD(l0, b_); TRRD(h0, b_ + 2048); TRRD(l1, b_ + 4096); TRRD(h1, b_ + 6144); TRRD(l2, b_ + 8192); TRRD(h2, b_ + 10240); TRRD(l3, b_ + 12288); TRRD(h3, b_ + 14336); \
        asm volatile("s_waitcnt lgkmcnt(0)" ::: "memory"); SBAR(); \
        o[d0] = __builtin_amdgcn_mfma_f32_32x32x16_bf16(pa0, (bf16x8){l0[0], l0[1], l0[2], l0[3], h0[0], h0[1], h0[2], h0[3]}, o[d0], 0, 0, 0); \
        o[d0] = __builtin_amdgcn_mfma_f32_32x32x16_bf16(pa1, (bf16x8){l1[0], l1[1], l1[2], l1[3], h1[0], h1[1], h1[2], h1[3]}, o[d0], 0, 0, 0); \
        o[d0] = __builtin_amdgcn_mfma_f32_32x32x16_bf16(pa2, (bf16x8){l2[0], l2[1], l2[2], l2[3], h2[0], h2[1], h2[2], h2[3]}, o[d0], 0, 0, 0); \
        o[d0] = __builtin_amdgcn_mfma_f32_32x32x16_bf16(pa3, (bf16x8){l3[0], l3[1], l3[2], l3[3], h3[0], h3[1], h3[2], h3[3]}, o[d0], 0, 0, 0); } while (0)
    PV_D0(0); PV_D0(1); PV_D0(2); PV_D0(3);
#undef PV_D0
#undef TRRD
}

template <bool IMP>
__device__ __forceinline__ void attn_tiles(LAS unsigned char* lds, const bf16x8 (&qr)[8], const bf16* Kp, const bf16* Vp, const int kvs,
                                           unsigned long long tilemask, const int pos, const int wlo, const int whi, const unsigned W,
                                           const unsigned long long rowmask, const int shift,
                                           f32x16 (&o)[4], float& m_reg, float& l_reg, float (&imp)[32]) {
    const int tid = otid(), wid = __builtin_amdgcn_readfirstlane(tid >> 6), lane = tid & 63, r32 = lane & 31, hi = lane >> 5;
    LAS unsigned char* V_lds = lds + OFF_V; LAS unsigned char* K_lds = lds + OFF_K;
    LAS float* al_l = (LAS float*)(lds + OFF_WS) + wid * 64 + 32;
    const int sr = tid >> 4, sc = (tid & 15) * 8;
    const int vst0 = v_st(sr, sc), vst1 = v_st(32 + sr, sc), kws = KSWZ(sr, sc * 2);
    const int vb0 = (int)(uintptr_t)V_lds + v_rd_base(lane);
    const int qm = pos - 4 * hi;
    constexpr float C2 = 1.4426950408889634f * SCALE;
    bf16x8 st_k0, st_k1, st_v0, st_v1;
#define A_LOAD(j_) do { const size_t r0_ = (size_t)((j_) * 64 + sr) * kvs + sc, r1_ = r0_ + (size_t)32 * kvs; \
        st_v0 = *(const bf16x8*)(Vp + r0_); st_v1 = *(const bf16x8*)(Vp + r1_); st_k0 = *(const bf16x8*)(Kp + r0_); st_k1 = *(const bf16x8*)(Kp + r1_); } while (0)
#define A_WRITE(bf_) do { *(LAS bf16x8*)(K_lds + (bf_) * SHM_K + kws) = st_k0; *(LAS bf16x8*)(K_lds + (bf_) * SHM_K + kws + 32 * 256) = st_k1; \
        *(LAS bf16x8*)(V_lds + (bf_) * SHM_V + vst0) = st_v0; *(LAS bf16x8*)(V_lds + (bf_) * SHM_V + vst1) = st_v1; } while (0)
    if (tilemask == 0ull) return;
    int j = __ffsll((long long)tilemask) - 1; tilemask &= tilemask - 1;
    A_LOAD(j); A_WRITE(0);
    LDSBAR();
    int jn = -1;
    if (tilemask) { jn = __ffsll((long long)tilemask) - 1; tilemask &= tilemask - 1; A_LOAD(jn); }
    int buf = 0; float carry = 0.f;
    for (;;) {
        const int kb = j * 64;
        const bool act = (kb <= whi) && ((long long)kb + 63 + (long long)W > (long long)wlo);
        if (act) {
            f32x16 p0, p1;
            SBAR(); qkt(p0, p1, K_lds + buf * SHM_K, r32, hi, qr); SBAR();
            const bool needm = (kb + 63 > wlo) || ((long long)kb + (long long)W <= (long long)whi);
            if (needm) { asm volatile("; boundary tile" ::: "memory"); mask_tile(p0, p1, qm - kb, W); }
            const bool rowsel = ((rowmask >> (kb >> shift)) & 1ull) != 0ull;
            if (!__all(rowsel)) { asm volatile("; row-select mask" ::: "memory"); const float NEG = -__builtin_inff();
#pragma unroll
                for (int r = 0; r < 16; ++r) { p0[r] = rowsel ? p0[r] : NEG; p1[r] = rowsel ? p1[r] : NEG; } }
            float pmax;
            { float m0 = fmaxf(fmaxf(p0[0], p0[1]), p0[2]), m1 = fmaxf(fmaxf(p0[3], p0[4]), p0[5]), m2 = fmaxf(fmaxf(p0[6], p0[7]), p0[8]), m3 = fmaxf(fmaxf(p0[9], p0[10]), p0[11]);
              float m4 = fmaxf(fmaxf(p0[12], p0[13]), p0[14]), m5 = fmaxf(fmaxf(p0[15], p1[0]), p1[1]), m6 = fmaxf(fmaxf(p1[2], p1[3]), p1[4]), m7 = fmaxf(fmaxf(p1[5], p1[6]), p1[7]);
              float m8 = fmaxf(fmaxf(p1[8], p1[9]), p1[10]), m9 = fmaxf(fmaxf(p1[11], p1[12]), p1[13]), ma = fmaxf(p1[14], p1[15]);
              m0 = fmaxf(fmaxf(m0, m1), m2); m3 = fmaxf(fmaxf(m3, m4), m5); m6 = fmaxf(fmaxf(m6, m7), m8); m9 = fmaxf(m9, ma);
              pmax = fmaxf(fmaxf(m0, m3), fmaxf(m6, m9)); }
            { auto rr = __builtin_amdgcn_permlane32_swap(__float_as_uint(pmax), __float_as_uint(pmax), false, false);
              pmax = fmaxf(__uint_as_float(rr[0]), __uint_as_float(rr[1])); }
            float mn, alpha;
            if (__all((pmax - m_reg) * SCALE <= THR)) { mn = m_reg; alpha = 1.f; }
            else { mn = fmaxf(m_reg, pmax); alpha = __builtin_amdgcn_exp2f((m_reg - mn) * C2); m_reg = mn; }
            const float mnL = -mn * C2;
#pragma unroll
            for (int r = 0; r < 16; ++r) { p0[r] = __builtin_amdgcn_exp2f(fmaf(p0[r], C2, mnL)); p1[r] = __builtin_amdgcn_exp2f(fmaf(p1[r], C2, mnL)); }
            float ps;
            { float s0 = (p0[0] + p0[1]) + (p0[2] + p0[3]), s1 = (p0[4] + p0[5]) + (p0[6] + p0[7]), s2 = (p0[8] + p0[9]) + (p0[10] + p0[11]), s3 = (p0[12] + p0[13]) + (p0[14] + p0[15]);
              float s4 = (p1[0] + p1[1]) + (p1[2] + p1[3]), s5_ = (p1[4] + p1[5]) + (p1[6] + p1[7]), s6 = (p1[8] + p1[9]) + (p1[10] + p1[11]), s7 = (p1[12] + p1[13]) + (p1[14] + p1[15]);
              ps = ((s0 + s1) + (s2 + s3)) + ((s4 + s5_) + (s6 + s7)); }
            { auto rr = __builtin_amdgcn_permlane32_swap(__float_as_uint(ps), __float_as_uint(ps), false, false);
              ps = __uint_as_float(rr[0]) + __uint_as_float(rr[1]); }
            l_reg = l_reg * alpha + ps;
            if (__any(alpha < 1.f)) {
                asm volatile("; rescale" ::: "memory");
                if (hi == 0) al_l[r32] = alpha;
                asm volatile("s_waitcnt lgkmcnt(0)" ::: "memory");
#pragma unroll
                for (int r = 0; r < 16; ++r) { const float a = al_l[crow(r, hi)];
#pragma unroll
                    for (int d_ = 0; d_ < 4; ++d_) o[d_][r] *= a; }
            }
            if constexpr (IMP) {
                float e3[4], f3[4], s0[4], s1[4];
#pragma unroll
                for (int q = 0; q < 4; ++q) { e3[q] = __shfl_xor(p0[4 * q + 3], 32); f3[q] = __shfl_xor(p1[4 * q + 3], 32);
                    s0[q] = (p0[4 * q] + p0[4 * q + 1]) + (p0[4 * q + 2] + p0[4 * q + 3]); s1[q] = (p1[4 * q] + p1[4 * q + 1]) + (p1[4 * q + 2] + p1[4 * q + 3]); }
                carry *= alpha;
#pragma unroll
                for (int q = 0; q < 4; ++q) {
                    s0[q] += hi ? e3[q] : (q > 0 ? e3[q > 0 ? q - 1 : 0] : carry);
                    s1[q] += hi ? f3[q] : (q > 0 ? f3[q > 0 ? q - 1 : 0] : e3[3]);
                }
                carry = f3[3];
#pragma unroll
                for (int i = 0; i < 32; ++i) imp[i] *= alpha;
#pragma unroll
                for (int tt = 0; tt < 4; ++tt) if (j == tt) {
#pragma unroll
                    for (int q = 0; q < 4; ++q) { imp[(tt * 2 + 0) * 4 + q] += s0[q]; imp[(tt * 2 + 1) * 4 + q] += s1[q]; } }
            }
            bf16x8 pa0, pa1, pa2, pa3;
#define PK4(P_, B_, OUT) do { const unsigned a0 = cvtpk(P_[B_ + 0], P_[B_ + 1]), a1 = cvtpk(P_[B_ + 2], P_[B_ + 3]); \
        const unsigned b0 = cvtpk(P_[B_ + 4], P_[B_ + 5]), b1 = cvtpk(P_[B_ + 6], P_[B_ + 7]); \
        auto r0 = __builtin_amdgcn_permlane32_swap(a0, b0, false, false); auto r1 = __builtin_amdgcn_permlane32_swap(a1, b1, false, false); \
        u32x4 w = {r0[0], r1[0], r0[1], r1[1]}; OUT = *reinterpret_cast<bf16x8*>(&w); } while (0)
            PK4(p0, 0, pa0); PK4(p0, 8, pa1); PK4(p1, 0, pa2); PK4(p1, 8, pa3);
#undef PK4
            SBAR();
            pv_tile(o, vb0 + buf * SHM_V, pa0, pa1, pa2, pa3);
        } else if (IMP) carry = 0.f;
        if (jn < 0) break;
        A_WRITE(buf ^ 1);
        LDSBAR();
        j = jn; buf ^= 1;
        if (tilemask) { jn = __ffsll((long long)tilemask) - 1; tilemask &= tilemask - 1; A_LOAD(jn); } else jn = -1;
    }
    LDSBAR();
#undef A_LOAD
#undef A_WRITE
}

template <int BR>
__device__ __forceinline__ void nsa_epi(const f32x16 (&o)[4], const float il, LAS float* li_l, float* accb, const float* gt, int r32, int hi, bf16* mixed, const bf16* zb) {
    asm volatile("" : "+v"(r32), "+v"(hi));
    if (hi == 0) li_l[r32] = il;
    asm volatile("s_waitcnt lgkmcnt(0)" ::: "memory");
#pragma unroll
    for (int rh = 0; rh < 2; ++rh) {
        float sv[8], av[8][4], zv[8][4];
#pragma unroll
        for (int q = 0; q < 8; ++q) { const int r = rh * 8 + q, rw = crow(r, hi);
            sv[q] = li_l[rw] * gt[rw * 12 + BR];
#pragma unroll
            for (int d0 = 0; d0 < 4; ++d0) { const int col = d0 * 32 + r32;
                if (BR >= 1) av[q][d0] = accb[rw * 128 + col];
                if (BR == 2) zv[q][d0] = bf2f(zb[(size_t)rw * NP + col]); } }
#pragma unroll
        for (int q = 0; q < 8; ++q) { const int r = rh * 8 + q, rw = crow(r, hi);
#pragma unroll
            for (int d0 = 0; d0 < 4; ++d0) { const int col = d0 * 32 + r32;
                if (BR == 0) accb[rw * 128 + col] = o[d0][r] * sv[q];
                else if (BR == 1) accb[rw * 128 + col] = av[q][d0] + o[d0][r] * sv[q];
                else { const float v = (av[q][d0] + o[d0][r] * sv[q]) * siluf_(zv[q][d0]);
                    const float vn = __shfl_xor(v, 1);
                    if ((r32 & 1) == 0) *(unsigned*)(mixed + (size_t)rw * DM + col) = cvtpk(v, vn); } } }
        asm volatile("" ::: "memory");
    }
}

__device__ __forceinline__ void nsa_unit(const Params& P, LAS unsigned char* lds, const int b, const int c) {
    const int tid = otid(), wid = __builtin_amdgcn_readfirstlane(tid >> 6), lane = tid & 63, r32 = lane & 31, hi = lane >> 5;
    const int head = wid >> 1, half = wid & 1;
    const int t_base = c * 64, trow = t_base + half * 32, pos = trow + r32;
    const bf16* proj = (const bf16*)(P.ws + WS_PROJ);
    const bf16* pb = proj + (size_t)b * SEQ * NP;
    const bf16* prow = pb + (size_t)pos * NP;
    bf16x8 qr[8];
#pragma unroll
    for (int d0 = 0; d0 < 8; ++d0) qr[d0] = *(const bf16x8*)(prow + O_NQ + head * 128 + d0 * 16 + hi * 8);
    LAS float* li_l = (LAS float*)(lds + OFF_WS) + wid * 64;
    float* accb = P.out + ((size_t)blockIdx.x * 256 + wid * 32) * 128;
    const float* gt = (const float*)(P.ws + WS_GATES) + (size_t)(b * SEQ + trow) * 12 + head * 3;
    const bf16* cmpk = (const bf16*)(P.ws + WS_CMPB) + (size_t)(0 * NB + b) * 256 * 128;
    const bf16* cmpv = (const bf16*)(P.ws + WS_CMPB) + (size_t)(1 * NB + b) * 256 * 128;
    f32x16 o[4]; float m_reg, l_reg;
    float dummy[32];
    {
        float imp[32];
#pragma unroll
        for (int i = 0; i < 32; ++i) imp[i] = 0.f;
#pragma unroll
        for (int d = 0; d < 4; ++d) o[d] = f32x16{};
        m_reg = -1e30f; l_reg = 0.f;
        const int posc = (pos - 31) >> 4, wloc = (trow - 31) >> 4, whic = trow >> 4;
        const int maxc = (t_base + 32) >> 4;
        const int ntile = (maxc >> 6) + 1;
        attn_tiles<true>(lds, qr, cmpk, cmpv, 128, (1ull << ntile) - 1ull, posc, wloc, whic, WINF, ~0ull, 12, o, m_reg, l_reg, imp);
        const float il = l_reg > 0.f ? 1.f / l_reg : 0.f;
        nsa_epi<0>(o, il, li_l, accb, gt, r32, hi, nullptr, nullptr);
        LAS float* impH = (LAS float*)lds;
        LAS float* ih = impH + ((head * 64 + half * 32 + r32) * 64);
#pragma unroll
        for (int tt = 0; tt < 4; ++tt)
#pragma unroll
            for (int hh = 0; hh < 2; ++hh)
#pragma unroll
                for (int q = 0; q < 4; ++q) ih[tt * 16 + hh * 8 + 2 * q + hi] = imp[(tt * 2 + hh) * 4 + q] * il;
    }
    LDSBAR();
    LAS float* score = (LAS float*)(lds + OFF_X);
    LAS unsigned char* selb = lds + OFF_X + 64 * 65 * 4;
    LAS unsigned* un = (LAS unsigned*)(lds + OFF_X + 64 * 65 * 4 + 512);
    {
        const int row = tid >> 3, part = tid & 7;
        const LAS float* impH = (const LAS float*)lds;
#pragma unroll
        for (int e = 0; e < 8; ++e) { const int jj = part * 8 + e;
            float s = (impH[(0 * 64 + row) * 64 + jj] + impH[(1 * 64 + row) * 64 + jj]) + (impH[(2 * 64 + row) * 64 + jj] + impH[(3 * 64 + row) * 64 + jj]);
            if (jj > c) s = -__builtin_inff();
            if (jj == 0 || jj == c || jj == c - 1) s = __builtin_inff();
            score[row * 65 + jj] = s; }
        if (tid < 2) un[tid] = 0u;
        LDSBAR();
        float sv[64];
#pragma unroll
        for (int j2 = 0; j2 < 64; ++j2) sv[j2] = score[row * 65 + j2];
        unsigned byte = 0u;
#pragma unroll
        for (int e = 0; e < 8; ++e) { const int jj = part * 8 + e; const float sj = score[row * 65 + jj]; int rank = 0;
#pragma unroll
            for (int j2 = 0; j2 < 64; ++j2) rank += (sv[j2] > sj || (sv[j2] == sj && j2 < jj)) ? 1 : 0;
            if (rank < 16 && jj <= c) byte |= 1u << e; }
        selb[row * 8 + part] = (unsigned char)byte;
        __hip_atomic_fetch_or(&un[part >> 2], byte << (8 * (part & 3)), __ATOMIC_RELAXED, __HIP_MEMORY_SCOPE_WORKGROUP);
    }
    LDSBAR();
    const unsigned long long rowmask = *(const LAS unsigned long long*)(selb + (half * 32 + r32) * 8);
    const unsigned long long selt = (unsigned long long)un[0] | ((unsigned long long)un[1] << 32);
    {
#pragma unroll
        for (int d = 0; d < 4; ++d) o[d] = f32x16{};
        m_reg = -1e30f; l_reg = 0.f;
        attn_tiles<false>(lds, qr, pb + O_KS, pb + O_VS, NP, selt, pos, trow, trow + 31, WINF, rowmask, 6, o, m_reg, l_reg, dummy);
        nsa_epi<1>(o, 1.f / l_reg, li_l, accb, gt, r32, hi, nullptr, nullptr);
    }
    {
#pragma unroll
        for (int d = 0; d < 4; ++d) o[d] = f32x16{};
        m_reg = -1e30f; l_reg = 0.f;
        const int lo = c > 8 ? c - 8 : 0;
        const unsigned long long upto = (c == 63) ? ~0ull : ((1ull << (c + 1)) - 1ull);
        const unsigned long long wt = upto & ~((1ull << lo) - 1ull);
        attn_tiles<false>(lds, qr, pb + O_KW, pb + O_VW, NP, wt, pos, trow, trow + 31, 512u, ~0ull, 12, o, m_reg, l_reg, dummy);
        bf16* mixed = (bf16*)(P.ws + WS_MIXED) + (size_t)(b * SEQ + trow) * DM + 512 + head * 128;
        const bf16* zb = pb + (size_t)trow * NP + O_NZ + head * 128;
        nsa_epi<2>(o, 1.f / l_reg, li_l, accb, gt, r32, hi, mixed, zb);
    }
}

__device__ __forceinline__ void moba_unit(const Params& P, LAS unsigned char* lds, const int b, const int h, const int own) {
    const int tid = otid(), wid = __builtin_amdgcn_readfirstlane(tid >> 6), lane = tid & 63, r32 = lane & 31, hi = lane >> 5;
    const int trow = own * 256 + wid * 32, pos = trow + r32;
    const bf16* proj = (const bf16*)(P.ws + WS_PROJ);
    const bf16* pb = proj + (size_t)b * SEQ * NP;
    const bf16* prow = pb + (size_t)pos * NP;
    bf16x8 qr[8];
#pragma unroll
    for (int d0 = 0; d0 < 8; ++d0) qr[d0] = *(const bf16x8*)(prow + O_MQ + h * 128 + d0 * 16 + hi * 8);
    LAS float* li_l = (LAS float*)(lds + OFF_WS) + wid * 64;
    LAS float* kml = (LAS float*)(lds + OFF_X);
    LAS unsigned* un = (LAS unsigned*)(lds + OFF_X + 8192);
    {
        const f32x4* src = (const f32x4*)((const float*)(P.ws + WS_KMEAN) + (size_t)(b * 4 + h) * 16 * 128);
        ((LAS f32x4*)kml)[tid] = src[tid];
        if (tid == 0) un[0] = 0u;
    }
    LDSBAR();
    float g[15];
#pragma unroll
    for (int n = 0; n < 15; ++n) g[n] = 0.f;
#pragma unroll
    for (int d0 = 0; d0 < 8; ++d0) {
        float qf[8];
#pragma unroll
        for (int e = 0; e < 8; ++e) qf[e] = bf2f((bf16)qr[d0][e]);
#pragma unroll
        for (int n = 0; n < 15; ++n) if (n < own) {
            const f32x4 k0 = *(const LAS f32x4*)(kml + n * 128 + d0 * 16 + hi * 8), k1 = *(const LAS f32x4*)(kml + n * 128 + d0 * 16 + hi * 8 + 4);
            g[n] += (qf[0] * k0[0] + qf[1] * k0[1]) + (qf[2] * k0[2] + qf[3] * k0[3]) + (qf[4] * k1[0] + qf[5] * k1[1]) + (qf[6] * k1[2] + qf[7] * k1[3]);
        }
    }
#pragma unroll
    for (int n = 0; n < 15; ++n) { g[n] += __shfl_xor(g[n], 32); if (n >= own) g[n] = -__builtin_inff(); }
    unsigned sel = 1u << own;
#pragma unroll
    for (int n = 0; n < 15; ++n) { int rank = 0;
#pragma unroll
        for (int n2 = 0; n2 < 15; ++n2) rank += (g[n2] > g[n] || (g[n2] == g[n] && n2 < n)) ? 1 : 0;
        if (n < own && rank < 3) sel |= 1u << n; }
    __hip_atomic_fetch_or(&un[0], sel, __ATOMIC_RELAXED, __HIP_MEMORY_SCOPE_WORKGROUP);
    LDSBAR();
    const unsigned blocks = un[0];
    unsigned long long tmask = 0ull;
#pragma unroll
    for (int n = 0; n < 16; ++n) if ((blocks >> n) & 1u) tmask |= 0xFull << (4 * n);
    f32x16 o[4]; float m_reg = -1e30f, l_reg = 0.f; float dummy[32];
#pragma unroll
    for (int d = 0; d < 4; ++d) o[d] = f32x16{};
    attn_tiles<false>(lds, qr, pb + O_MK + h * 128, pb + O_MV + h * 128, NP, tmask, pos, trow, trow + 31, WINF, (unsigned long long)sel, 8, o, m_reg, l_reg, dummy);
    const float il = 1.f / l_reg;
    if (hi == 0) li_l[r32] = il;
    asm volatile("s_waitcnt lgkmcnt(0)" ::: "memory");
    bf16* mixed = (bf16*)(P.ws + WS_MIXED) + (size_t)(b * SEQ + trow) * DM + h * 128;
    const bf16* zb = pb + (size_t)trow * NP + O_MZ + h * 128;
#pragma unroll
    for (int rh = 0; rh < 2; ++rh) {
        float zv[8][4];
#pragma unroll
        for (int q = 0; q < 8; ++q) { const int rw = crow(rh * 8 + q, hi);
#pragma unroll
            for (int d0 = 0; d0 < 4; ++d0) zv[q][d0] = bf2f(zb[(size_t)rw * NP + d0 * 32 + r32]); }
#pragma unroll
        for (int q = 0; q < 8; ++q) { const int r = rh * 8 + q, rw = crow(r, hi); const float s = li_l[rw];
#pragma unroll
            for (int d0 = 0; d0 < 4; ++d0) { const int col = d0 * 32 + r32;
                const float v = o[d0][r] * s * siluf_(zv[q][d0]);
                const float vn = __shfl_xor(v, 1);
                if ((r32 & 1) == 0) *(unsigned*)(mixed + (size_t)rw * DM + col) = cvtpk(v, vn); } }
        asm volatile("" ::: "memory");
    }
}
#undef KSWZ
#undef SBAR
#undef LDSBAR
}

namespace s5 {
typedef float f32x16 __attribute__((ext_vector_type(16)));
typedef float f32x2 __attribute__((ext_vector_type(2)));
constexpr int KT_ELEMS = 65 * 256, KT_BYTES = KT_ELEMS * 2, PF_ELEMS = 131072;
constexpr int UCOL = 2064, XCOL = 272, SROW = 129;
constexpr int L_U = 0, L_KT = 32 * UCOL, L_S = L_KT + KT_BYTES, L_XB = L_S + 32 * SROW * 4, L_CARRY = L_XB + 32 * XCOL, L_END = L_CARRY + 512;
static_assert(L_END <= 147456 && (L_KT % 16) == 0 && (L_S % 16) == 0 && (L_XB % 16) == 0, "s5 lds map");

__device__ __forceinline__ void tables_task(const Params& P, LAS unsigned char* lds, const int l, const int g, const int part) {
    const int tid = otid();
    LAS f32x2* pw = (LAS f32x2*)lds;
    LAS f32x2* fz = (LAS f32x2*)(lds + 65 * 64 * 8);
    __syncthreads();
    if (tid < 64) {
        const int p = tid;
        const double dt = exp((double)P.in[23][l * 64 + g]);
        const double ar = P.in[16][l * 4096 + g * 64 + p], ai = P.in[17][l * 4096 + g * 64 + p];
        const double mag = exp(dt * ar);
        double sn, cs; dsincos(dt * ai, sn, cs);
        const double abr = mag * cs, abi = mag * sn;
        const double nr = abr - 1.0, ni = abi, den = ar * ar + ai * ai;
        fz[p] = (f32x2){(float)((nr * ar + ni * ai) / den), (float)((ni * ar - nr * ai) / den)};
        double pr = 1.0, pi = 0.0;
        for (int n = 0; n <= 64; ++n) { pw[n * 64 + p] = (f32x2){(float)pr, (float)pi}; const double t = pr * abr - pi * abi; pi = pr * abi + pi * abr; pr = t; }
        if (part == 0) ((f32x2*)(P.ws + WS_S5AL))[(l * 64 + g) * 64 + p] = pw[64 * 64 + p];
    }
    __syncthreads();
    LAS float* bre = (LAS float*)(lds + 65 * 64 * 8 + 512);
    LAS float* bim = bre + 1024;
    LAS float* cre = bim + 1024;
    LAS float* cim = cre + 1024;
    { const float* gb = P.in[18] + (size_t)l * 65536 + g * 1024; const float* gbi = P.in[19] + (size_t)l * 65536 + g * 1024;
      const float* gc = P.in[20] + (size_t)l * 65536 + g * 1024; const float* gci = P.in[21] + (size_t)l * 65536 + g * 1024;
      for (int i = tid; i < 1024; i += 512) { bre[i] = gb[i]; bim[i] = gbi[i]; cre[i] = gc[i]; cim[i] = gci[i]; } }
    __syncthreads();
    bf16* P1 = (bf16*)(P.ws + WS_S5P1) + (size_t)(l * 64 + g) * PF_ELEMS;
    bf16* P2 = (bf16*)(P.ws + WS_S5P2) + (size_t)(l * 64 + g) * PF_ELEMS;
    bf16* KT = (bf16*)(P.ws + WS_S5K) + (size_t)(l * 64 + g) * KT_ELEMS;
    if (part == 0) for (int fl = tid; fl < 16384; fl += 512) {
        const int lane = fl & 63, ks = (fl >> 6) & 63, mb = fl >> 12;
        const int row = 32 * mb + (lane & 31), p = row & 63, isim = row >> 6, c0 = 8 * (lane >> 5);
        const f32x2 w = pw[(63 - ks) * 64 + p], f = fz[p];
        const float zr = w.x * f.x - w.y * f.y, zi = w.x * f.y + w.y * f.x;
        float v[8];
#pragma unroll
        for (int j = 0; j < 8; ++j) { const float br = bre[p * 16 + c0 + j], bi = bim[p * 16 + c0 + j]; v[j] = isim ? (zr * bi + zi * br) : (zr * br - zi * bi); }
        u32x4 o; o.x = pg8::cvt_pk_bf16(v[0], v[1]); o.y = pg8::cvt_pk_bf16(v[2], v[3]); o.z = pg8::cvt_pk_bf16(v[4], v[5]); o.w = pg8::cvt_pk_bf16(v[6], v[7]);
        *(u32x4*)(P1 + (size_t)fl * 8) = o;
    }
    if (part == 1) for (int fl = tid; fl < 16384; fl += 512) {
        const int lane = fl & 63, ks = (fl >> 6) & 7, rb = fl >> 9;
        const int r = lane & 31, t = 2 * rb + (r >> 4), c = r & 15, kk0 = 16 * ks + 8 * (lane >> 5);
        float v[8];
#pragma unroll
        for (int j = 0; j < 8; ++j) { const int kk = kk0 + j, p = kk & 63; const f32x2 w = pw[(t + 1) * 64 + p];
            const float cr = cre[c * 64 + p], ci = cim[c * 64 + p];
            v[j] = (kk >> 6) ? -(cr * w.y + ci * w.x) : (cr * w.x - ci * w.y); }
        u32x4 o; o.x = pg8::cvt_pk_bf16(v[0], v[1]); o.y = pg8::cvt_pk_bf16(v[2], v[3]); o.z = pg8::cvt_pk_bf16(v[4], v[5]); o.w = pg8::cvt_pk_bf16(v[6], v[7]);
        *(u32x4*)(P2 + (size_t)fl * 8) = o;
    }
    if (part >= 2) for (int pr_ = (part - 2) * 512 + tid; pr_ < (part - 1) * 512; pr_ += 512) {
        const int tau = pr_ >> 4, c = pr_ & 15;
        float acc[16];
#pragma unroll
        for (int j = 0; j < 16; ++j) acc[j] = 0.f;
        for (int p = 0; p < 64; ++p) {
            const f32x2 w = pw[tau * 64 + p], f = fz[p];
            const float zr = w.x * f.x - w.y * f.y, zi = w.x * f.y + w.y * f.x;
            const float cr = cre[c * 64 + p], ci = cim[c * 64 + p];
            const float czr = cr * zr - ci * zi, czi = cr * zi + ci * zr;
#pragma unroll
            for (int q = 0; q < 4; ++q) { const f32x4 br4 = *(const LAS f32x4*)(bre + p * 16 + 4 * q), bi4 = *(const LAS f32x4*)(bim + p * 16 + 4 * q);
#pragma unroll
                for (int e = 0; e < 4; ++e) acc[4 * q + e] += czr * br4[e] - czi * bi4[e]; }
        }
        u32x4 o0, o1; o0.x = pg8::cvt_pk_bf16(acc[0], acc[1]); o0.y = pg8::cvt_pk_bf16(acc[2], acc[3]); o0.z = pg8::cvt_pk_bf16(acc[4], acc[5]); o0.w = pg8::cvt_pk_bf16(acc[6], acc[7]);
        o1.x = pg8::cvt_pk_bf16(acc[8], acc[9]); o1.y = pg8::cvt_pk_bf16(acc[10], acc[11]); o1.z = pg8::cvt_pk_bf16(acc[12], acc[13]); o1.w = pg8::cvt_pk_bf16(acc[14], acc[15]);
        u32x4* dst = (u32x4*)(KT + (size_t)(tau + 1) * 256 + c * 16); dst[0] = o0; dst[1] = o1;
    }
    if (part == 2 && tid < 32) ((u32x4*)KT)[tid] = (u32x4){0u, 0u, 0u, 0u};
}

__device__ __forceinline__ void unit(const Params& P, LAS unsigned char* lds, const int l, const int b, const int g) {
    const int tid = otid(), wid = __builtin_amdgcn_readfirstlane(tid >> 6), lane = tid & 63, n32 = lane & 31, hi = lane >> 5;
    const bf16* KT = (const bf16*)(P.ws + WS_S5K) + (size_t)(l * 64 + g) * KT_ELEMS;
    const bf16x8* P1 = (const bf16x8*)((const bf16*)(P.ws + WS_S5P1) + (size_t)(l * 64 + g) * PF_ELEMS);
    const bf16x8* P2 = (const bf16x8*)((const bf16*)(P.ws + WS_S5P2) + (size_t)(l * 64 + g) * PF_ELEMS);
    const f32x2* AL = (const f32x2*)(P.ws + WS_S5AL) + (l * 64 + g) * 64;
    const bf16* ub = (const bf16*)(P.out + SUG_OFF) + (size_t)(b * 64 + g) * SEQ * 16;
    bf16* yb = (bf16*)(P.ws + WS_Y5) + (size_t)b * SEQ * 1024 + g * 16;
    const float* dsk = P.in[22] + l * 1024 + g * 16;
    LAS float* Sl = (LAS float*)(lds + L_S);
    LAS float* car = (LAS float*)(lds + L_CARRY);
    __syncthreads();
    { u32x4 kt[5];
#pragma unroll
      for (int it = 0; it < 5; ++it) { const int i = tid + 512 * it; if (i < KT_BYTES / 16) kt[it] = ((const u32x4*)KT)[i]; }
      __builtin_amdgcn_sched_barrier(0);
#pragma unroll
      for (int it = 0; it < 5; ++it) { const int i = tid + 512 * it; if (i < KT_BYTES / 16) ((LAS u32x4*)(lds + L_KT))[i] = kt[it]; } }
    const f32x4 dvA = *(const f32x4*)(dsk + 4 * hi), dvB = *(const f32x4*)(dsk + 8 + 4 * hi);
    if (tid < 128) car[tid] = 0.f;
    u32x4 ua0[4], ua1[4];
#define S5_LOADU(hh_) do { _Pragma("unroll") for (int it = 0; it < 4; ++it) { const int rr = tid + 512 * it, n = rr >> 6, s = rr & 63; \
        const u32x4* src = (const u32x4*)(ub + (size_t)((32 * (hh_) + n) * 64 + s) * 16); ua0[it] = src[0]; ua1[it] = src[1]; } } while (0)
    S5_LOADU(0);
    for (int hh = 0; hh < 2; ++hh) {
        __builtin_amdgcn_sched_barrier(0);
#pragma unroll
        for (int it = 0; it < 4; ++it) { const int rr = tid + 512 * it, n = rr >> 6, s = rr & 63;
            *(LAS u32x4*)(lds + L_U + n * UCOL + s * 32) = ua0[it]; *(LAS u32x4*)(lds + L_U + n * UCOL + s * 32 + 16) = ua1[it]; }
        __syncthreads();
        {
            const int mb = wid & 3, kh = wid >> 2;
            f32x16 acc0 = f32x16{}, acc1 = f32x16{};
            const bf16x8* pa = P1 + (size_t)(mb * 64 + kh * 32) * 64 + lane;
            LAS const unsigned char* ua = lds + L_U + n32 * UCOL + hi * 16 + kh * 32 * 32;
#pragma unroll 1
            for (int kb = 0; kb < 4; ++kb) {
                const bf16x8* qa = pa + 4 * 64;
                bf16x8 fa[8];
#pragma unroll
                for (int i = 0; i < 4; ++i) { fa[i] = pa[i * 64]; fa[4 + i] = qa[i * 64]; }
                __builtin_amdgcn_sched_barrier(0);
#pragma unroll
                for (int i = 0; i < 8; i += 2) {
                    acc0 = __builtin_amdgcn_mfma_f32_32x32x16_bf16(fa[i], *(LAS const bf16x8*)(ua + i * 32), acc0, 0, 0, 0);
                    acc1 = __builtin_amdgcn_mfma_f32_32x32x16_bf16(fa[i + 1], *(LAS const bf16x8*)(ua + (i + 1) * 32), acc1, 0, 0, 0); }
                __builtin_amdgcn_sched_barrier(0);
                pa += 8 * 64; ua += 8 * 32;
            }
            acc0 += acc1;
            if (kh == 1) {
#pragma unroll
                for (int r = 0; r < 16; ++r) Sl[n32 * SROW + 32 * mb + (r & 3) + 8 * (r >> 2) + 4 * hi] = acc0[r];
            }
            __syncthreads();
            if (kh == 0) {
#pragma unroll
                for (int r = 0; r < 16; ++r) Sl[n32 * SROW + 32 * mb + (r & 3) + 8 * (r >> 2) + 4 * hi] += acc0[r];
            }
        }
        __syncthreads();
        if (tid < 64) {
            const int p = tid; const f32x2 al = AL[p];
            float xr = car[p], xi = car[64 + p];
            float sre[32], sim[32];
#pragma unroll
            for (int n = 0; n < 32; ++n) { sre[n] = Sl[n * SROW + p]; sim[n] = Sl[n * SROW + 64 + p]; }
#pragma unroll
            for (int n = 0; n < 32; ++n) {
                *(LAS bf16*)(lds + L_XB + n * XCOL + p * 2) = (bf16)f2bf(xr); *(LAS bf16*)(lds + L_XB + n * XCOL + (64 + p) * 2) = (bf16)f2bf(xi);
                const float nx = al.x * xr - al.y * xi + sre[n], ni = al.x * xi + al.y * xr + sim[n]; xr = nx; xi = ni; }
            car[p] = xr; car[64 + p] = xi;
        }
        __syncthreads();
        if (hh == 0) { S5_LOADU(1); __builtin_amdgcn_sched_barrier(0); }
        for (int q4 = 0; q4 < 4; ++q4) {
            const int rb = (q4 == 0) ? wid : (q4 == 1) ? 15 - wid : (q4 == 2) ? 16 + wid : 31 - wid;
            const int t0 = 2 * rb;
            f32x16 acc = f32x16{};
            bf16x8 pf[8];
            { const bf16x8* p2 = P2 + (size_t)(rb * 8) * 64 + lane;
#pragma unroll
              for (int ks = 0; ks < 8; ++ks) pf[ks] = p2[ks * 64]; }
            LAS const unsigned char* ka = lds + L_KT + (t0 + 1) * 512 + n32 * 32 + hi * 16;
            LAS const unsigned char* ua = lds + L_U + n32 * UCOL + hi * 16;
            f32x16 acc2 = f32x16{};
#pragma unroll 4
            for (int s0 = 0; s0 <= t0 + 1; s0 += 2) {
                acc = __builtin_amdgcn_mfma_f32_32x32x16_bf16(*(LAS const bf16x8*)(ka - s0 * 512), *(LAS const bf16x8*)(ua + s0 * 32), acc, 0, 0, 0);
                acc2 = __builtin_amdgcn_mfma_f32_32x32x16_bf16(*(LAS const bf16x8*)(ka - (s0 + 1) * 512), *(LAS const bf16x8*)(ua + (s0 + 1) * 32), acc2, 0, 0, 0); }
            LAS const unsigned char* xa = lds + L_XB + n32 * XCOL + hi * 16;
#pragma unroll
            for (int ks = 0; ks < 8; ks += 2) {
                acc = __builtin_amdgcn_mfma_f32_32x32x16_bf16(pf[ks], *(LAS const bf16x8*)(xa + ks * 32), acc, 0, 0, 0);
                acc2 = __builtin_amdgcn_mfma_f32_32x32x16_bf16(pf[ks + 1], *(LAS const bf16x8*)(xa + (ks + 1) * 32), acc2, 0, 0, 0); }
            acc += acc2;
#pragma unroll
            for (int r4 = 0; r4 < 4; ++r4) {
                const int t = t0 + (r4 >> 1), c0 = 8 * (r4 & 1) + 4 * hi;
                const u32x2 uw = *(LAS const u32x2*)(lds + L_U + n32 * UCOL + t * 32 + c0 * 2);
                const f32x4 dv = (r4 & 1) ? dvB : dvA;
                const float u0 = __uint_as_float(uw.x << 16), u1 = __uint_as_float(uw.x & 0xffff0000u), u2 = __uint_as_float(uw.y << 16), u3 = __uint_as_float(uw.y & 0xffff0000u);
                const float y0 = geluf_(acc[4 * r4 + 0] + dv[0] * u0), y1 = geluf_(acc[4 * r4 + 1] + dv[1] * u1);
                const float y2 = geluf_(acc[4 * r4 + 2] + dv[2] * u2), y3 = geluf_(acc[4 * r4 + 3] + dv[3] * u3);
                u32x2 w; w.x = pk2(y0, y1); w.y = pk2(y2, y3);
                *(u32x2*)(yb + (size_t)((32 * hh + n32) * 64 + t) * 1024 + c0) = w;
            }
        }
        asm volatile("s_waitcnt lgkmcnt(0)" ::: "memory"); __builtin_amdgcn_s_barrier(); asm volatile("" ::: "memory");
    }
#undef S5_LOADU
}
}

namespace a1 {
typedef float f32x16 __attribute__((ext_vector_type(16)));
__device__ __forceinline__ void norm_task(const Params& P, LAS unsigned char* lds, const int l, const int blk, const int vec) {
    const int tid = otid(), wid = __builtin_amdgcn_readfirstlane(tid >> 6), lane = tid & 63;
    int off; const float* nw;
    if (vec < 4) { off = O_MQ + vec * 128; nw = P.in[4]; }
    else if (vec < 8) { off = O_MK + (vec - 4) * 128; nw = P.in[5]; }
    else if (vec < 12) { off = O_NQ + (vec - 8) * 128; nw = P.in[6]; }
    else if (vec == 12) { off = O_KS; nw = P.in[8]; }
    else { off = O_KW; nw = P.in[9]; }
    nw += l * 128;
    const float2* cs = (const float2*)(P.ws + WS_ROPE);
    bf16* base = (bf16*)(P.ws + WS_PROJ) + (size_t)(blk * 256 + wid * 32) * NP + off;
    const int pos0 = (blk * 256 + wid * 32) % SEQ;
    const float wa = nw[lane], wb = nw[lane + 64];
    float sa = 0.f, sb = 0.f;
#pragma unroll 4
    for (int i = 0; i < 32; ++i) {
        bf16* v = base + (size_t)i * NP;
        float a = bf2f(v[lane]), b = bf2f(v[lane + 64]);
        const float ss = wave_sum(a * a + b * b);
        const float r = 1.0f / sqrtf(ss * (1.0f / 128.0f) + EPSN);
        a = a * r * wa; b = b * r * wb;
        const float other = __shfl_xor(a, 16);
        if (lane < 32) { const float2 c = cs[(pos0 + i) * 16 + (lane & 15)]; a = (lane < 16) ? (a * c.x - other * c.y) : (a * c.x + other * c.y); }
        v[lane] = (bf16)f2bf(a); v[lane + 64] = (bf16)f2bf(b);
        sa += a; sb += b;
    }
    if (vec >= 4 && vec < 8) {
        LAS float* red = (LAS float*)lds;
        red[wid * 128 + lane] = sa; red[wid * 128 + lane + 64] = sb;
        __syncthreads();
        if (tid < 128) { float s = 0.f;
#pragma unroll
            for (int w = 0; w < 8; ++w) s += red[w * 128 + tid];
            const int b = blk >> 4, n = blk & 15, h = vec - 4;
            ((float*)(P.ws + WS_KMEAN))[((size_t)(b * 4 + h) * 16 + n) * 128 + tid] = s * (1.0f / 256.0f); }
    }
}
__device__ __forceinline__ void gates_task(const Params& P, LAS unsigned char* lds, const int l, const int task) {
    const int tid = otid(), wid = __builtin_amdgcn_readfirstlane(tid >> 6), lane = tid & 63, r32 = lane & 31, hi = lane >> 5;
    const bf16* xb = (const bf16*)(P.ws + WS_XB) + (size_t)(task * 64 + r32) * DM + wid * 256 + 8 * hi;
    const bf16x8* wf = (const bf16x8*)(P.ws + WS_WGF) + ((size_t)l * 128 + wid * 16) * 64 + lane;
    f32x16 acc0 = f32x16{}, acc1 = f32x16{};
#pragma unroll 1
    for (int kb = 0; kb < 2; ++kb) {
        bf16x8 a0[8], a1[8], bw[8];
        const bf16* xq = xb + (size_t)32 * DM;
#pragma unroll
        for (int k = 0; k < 8; ++k) { a0[k] = *(const bf16x8*)(xb + 16 * k); a1[k] = *(const bf16x8*)(xq + 16 * k); bw[k] = wf[k * 64]; }
        __builtin_amdgcn_sched_barrier(0);
#pragma unroll
        for (int k = 0; k < 8; ++k) { acc0 = __builtin_amdgcn_mfma_f32_32x32x16_bf16(a0[k], bw[k], acc0, 0, 0, 0); acc1 = __builtin_amdgcn_mfma_f32_32x32x16_bf16(a1[k], bw[k], acc1, 0, 0, 0); }
        __builtin_amdgcn_sched_barrier(0);
        xb += 128; wf += 8 * 64;
    }
    LAS float* red = (LAS float*)lds;
    LAS float* rsl = red + 8 * 64 * 12;
    if (r32 < 12) {
#pragma unroll
        for (int r = 0; r < 16; ++r) { const int rw = (r & 3) + 8 * (r >> 2) + 4 * hi;
            red[(wid * 64 + rw) * 12 + r32] = acc0[r]; red[(wid * 64 + 32 + rw) * 12 + r32] = acc1[r]; }
    }
    if (tid < 64) rsl[tid] = ((const float*)(P.ws + WS_RS))[task * 64 + tid];
    __syncthreads();
    for (int i = tid; i < 64 * 12; i += 512) { float s = 0.f;
#pragma unroll
        for (int w = 0; w < 8; ++w) s += red[w * 768 + i];
        ((float*)(P.ws + WS_GATES))[(size_t)task * 768 + i] = sigmoidf_(s * rsl[i / 12]); }
}
__device__ __forceinline__ void cmp_task(const Params& P, LAS unsigned char* lds, const int l, const int which, const int b, const int nb) {
    const int tid = otid(), wid = __builtin_amdgcn_readfirstlane(tid >> 6), lane = tid & 63, r32 = lane & 31, hi = lane >> 5;
    const int n0 = 32 * nb, cb = wid & 3, kh = wid >> 2;
    LAS float* red = (LAS float*)lds;
    LAS bf16* hid = (LAS bf16*)(lds + 4 * 32 * 33 * 4);
    LAS float* ot = (LAS float*)(lds + 4 * 32 * 33 * 4 + 32 * 136 * 2);
    {
        const int n = min(n0 + r32, NCMP - 1);
        const bf16* tokbase = (const bf16*)(P.ws + WS_PROJ) + (size_t)(b * SEQ + 16 * n) * NP + (which ? O_VC : O_KC) + 8 * hi;
        const bf16x8* wf = (const bf16x8*)(P.ws + WS_W1F) + ((size_t)((l * 2 + which) * 4 + cb) * 256 + kh * 128) * 64 + lane;
        const bf16* tok = tokbase + (size_t)(kh * 16) * NP;
        f32x16 acc = f32x16{}, acc2 = f32x16{};
#pragma unroll 1
        for (int t = 0; t < 16; ++t) {
            bf16x8 A[8], Bf[8];
            const bf16x8* wq = wf + 4 * 64;
#pragma unroll
            for (int k = 0; k < 4; ++k) { A[k] = *(const bf16x8*)(tok + k * 16); A[4 + k] = *(const bf16x8*)(tok + (4 + k) * 16); Bf[k] = wf[k * 64]; Bf[4 + k] = wq[k * 64]; }
            __builtin_amdgcn_sched_barrier(0);
#pragma unroll
            for (int k = 0; k < 8; k += 2) { acc = __builtin_amdgcn_mfma_f32_32x32x16_bf16(A[k], Bf[k], acc, 0, 0, 0); acc2 = __builtin_amdgcn_mfma_f32_32x32x16_bf16(A[k + 1], Bf[k + 1], acc2, 0, 0, 0); }
            __builtin_amdgcn_sched_barrier(0);
            tok += NP; wf += 8 * 64;
        }
        acc += acc2;
        if (kh == 1) {
#pragma unroll
            for (int r = 0; r < 16; ++r) red[(cb * 32 + (r & 3) + 8 * (r >> 2) + 4 * hi) * 33 + r32] = acc[r];
        }
        __syncthreads();
        if (kh == 0) { float cst = 0.f;
            { const float* cp = (const float*)(P.ws + WS_CST) + (size_t)((l * 2 + which) * 64) * 128 + cb * 32 + r32;
#pragma unroll 1
              for (int s0 = 0; s0 < 64; s0 += 16) {
                  float cv[16];
#pragma unroll
                  for (int i = 0; i < 16; ++i) cv[i] = cp[i * 128];
                  __builtin_amdgcn_sched_barrier(0);
#pragma unroll
                  for (int i = 0; i < 16; ++i) cst += cv[i];
                  __builtin_amdgcn_sched_barrier(0);
                  cp += 16 * 128; } }
#pragma unroll
            for (int r = 0; r < 16; ++r) { const int rw = (r & 3) + 8 * (r >> 2) + 4 * hi;
                hid[rw * 136 + cb * 32 + r32] = (bf16)f2bf(geluf_(acc[r] + red[(cb * 32 + rw) * 33 + r32] + cst)); } }
        __syncthreads();
    }
    if (wid < 4) {
        const bf16x8* w2f = (const bf16x8*)(P.ws + WS_W2F) + ((size_t)((l * 2 + which) * 4 + wid) * 8) * 64 + lane;
        f32x16 acc = f32x16{};
        bf16x8 wb[8];
#pragma unroll
        for (int ks = 0; ks < 8; ++ks) wb[ks] = w2f[ks * 64];
        __builtin_amdgcn_sched_barrier(0);
#pragma unroll
        for (int ks = 0; ks < 8; ++ks) acc = __builtin_amdgcn_mfma_f32_32x32x16_bf16(*(const LAS bf16x8*)(hid + r32 * 136 + 16 * ks + 8 * hi), wb[ks], acc, 0, 0, 0);
#pragma unroll
        for (int r = 0; r < 16; ++r) ot[((r & 3) + 8 * (r >> 2) + 4 * hi) * 132 + wid * 32 + r32] = acc[r];
    }
    __syncthreads();
    {
        const int r = tid >> 4, jg = tid & 15, j2 = jg * 8;
        float o[8];
        { const f32x4 oa = *(const LAS f32x4*)(ot + r * 132 + j2), ob = *(const LAS f32x4*)(ot + r * 132 + j2 + 4);
#pragma unroll
          for (int e = 0; e < 4; ++e) { o[e] = oa[e]; o[4 + e] = ob[e]; } }
        const int n = n0 + r;
        if (which == 0) {
            float ss = 0.f;
#pragma unroll
            for (int e = 0; e < 8; ++e) ss += o[e] * o[e];
            ss += __shfl_xor(ss, 1); ss += __shfl_xor(ss, 2); ss += __shfl_xor(ss, 4); ss += __shfl_xor(ss, 8);
            const float rs = 1.0f / sqrtf(ss * (1.0f / 128.0f) + EPSN);
            const float* kcn = P.in[7] + l * 128 + j2;
            const float2* cs = (const float2*)(P.ws + WS_ROPE) + (size_t)min(16 * n + 31, SEQ - 1) * 16 + (jg & 1) * 8;
#pragma unroll
            for (int e = 0; e < 8; ++e) { o[e] = o[e] * rs * kcn[e];
                const float other = __shfl_xor(o[e], 2);
                if (jg < 4) { const float2 c = cs[e]; o[e] = (jg < 2) ? (o[e] * c.x - other * c.y) : (o[e] * c.x + other * c.y); } }
        }
        u32x4 w; w.x = pk2(o[0], o[1]); w.y = pk2(o[2], o[3]); w.z = pk2(o[4], o[5]); w.w = pk2(o[6], o[7]);
        if (n >= NCMP) w = (u32x4){0u, 0u, 0u, 0u};
        *(u32x4*)((bf16*)(P.ws + WS_CMPB) + ((size_t)(which * NB + b) * 256 + n) * 128 + j2) = w;
    }
}
__device__ __forceinline__ void prep_w1(const Params& P, LAS unsigned char* lds) {
    const int tid = otid();
    const int gt = blockIdx.x * 512 + tid, GT = gridDim.x * 512;
    for (int fl = gt; fl < NL * 2 * 65536; fl += GT) {
        const int lw = fl >> 16, rem = fl & 65535, lane = rem & 63, ks = (rem >> 6) & 255, cb = rem >> 14;
        const float* w1 = P.in[(lw & 1) ? 14 : 12] + (size_t)(lw >> 1) * 4096 * 128;
        const float* src = w1 + (size_t)(16 * ks + 8 * (lane >> 5)) * 128 + 32 * cb + (lane & 31);
        u32x4 o; o.x = pk2(src[0], src[128]); o.y = pk2(src[256], src[384]); o.z = pk2(src[512], src[640]); o.w = pk2(src[768], src[896]);
        *(u32x4*)((bf16*)(P.ws + WS_W1F) + (size_t)fl * 8) = o;
    }
    for (int fl = gt; fl < NL * 2 * 4 * 8 * 64; fl += GT) {
        const int lw = fl >> 11, cb = (fl >> 9) & 3, ks = (fl >> 6) & 7, lane = fl & 63;
        const float* w2 = P.in[(lw & 1) ? 15 : 13] + (size_t)(lw >> 1) * 16384 + (size_t)(16 * ks + 8 * (lane >> 5)) * 128 + 32 * cb + (lane & 31);
        u32x4 o; o.x = pk2(w2[0], w2[128]); o.y = pk2(w2[256], w2[384]); o.z = pk2(w2[512], w2[640]); o.w = pk2(w2[768], w2[896]);
        *(u32x4*)((bf16*)(P.ws + WS_W2F) + (size_t)fl * 8) = o;
    }
    for (int fl = gt; fl < NL * 128 * 64; fl += GT) {
        const int l = fl >> 13, ks = (fl >> 6) & 127, lane = fl & 63, n = lane & 31, k0 = 16 * ks + 8 * (lane >> 5);
        float v[8];
#pragma unroll
        for (int e = 0; e < 8; ++e) v[e] = (n < 12) ? P.in[1][l * DM + k0 + e] * P.in[2][(size_t)l * DM * INW + (size_t)(k0 + e) * INW + SRC_NG + n] : 0.f;
        u32x4 o; o.x = pk2(v[0], v[1]); o.y = pk2(v[2], v[3]); o.z = pk2(v[4], v[5]); o.w = pk2(v[6], v[7]);
        *(u32x4*)((bf16*)(P.ws + WS_WGF) + (size_t)fl * 8) = o;
    }
    for (int t = blockIdx.x; t < NL * 2 * 64; t += gridDim.x) {
        const int lw = t >> 6, sl = t & 63;
        const float* w1 = P.in[(lw & 1) ? 14 : 12] + (size_t)(lw >> 1) * 4096 * 128;
        const float* pe = P.in[(lw & 1) ? 11 : 10] + (size_t)(lw >> 1) * 4096;
        const int j = tid & 127, kq = tid >> 7;
        float s = 0.f;
#pragma unroll
        for (int i = 0; i < 16; ++i) { const int k = sl * 64 + kq * 16 + i; s += pe[k] * w1[(size_t)k * 128 + j]; }
        LAS float* red = (LAS float*)lds;
        __syncthreads();
        red[tid] = s;
        __syncthreads();
        if (tid < 128) ((float*)(P.ws + WS_CST))[(size_t)t * 128 + tid] = (red[tid] + red[128 + tid]) + (red[256 + tid] + red[384 + tid]);
    }
}
}

__device__ __forceinline__ void unit_done(unsigned* cnt) {
    asm volatile("s_waitcnt vmcnt(0)" ::: "memory");
    __syncthreads();
    if (otid() == 0) { __builtin_amdgcn_fence(__ATOMIC_RELEASE, "agent"); asm volatile("s_waitcnt vmcnt(0)" ::: "memory");
        __hip_atomic_fetch_add(cnt, 1u, __ATOMIC_RELAXED, __HIP_MEMORY_SCOPE_AGENT); }
}
__device__ __forceinline__ void unit_wait(unsigned* cnt, unsigned target) {
    if (otid() == 0) { unsigned sp = 0u;
        while (__hip_atomic_load(cnt, __ATOMIC_RELAXED, __HIP_MEMORY_SCOPE_AGENT) < target) { __builtin_amdgcn_s_sleep(4); if (++sp > (1u << 22)) break; }
        __builtin_amdgcn_fence(__ATOMIC_ACQUIRE, "agent"); asm volatile("s_waitcnt vmcnt(0)" ::: "memory"); }
    __syncthreads();
}
struct OneUnit { int pm, pn; __device__ __forceinline__ bool next(int i, pg8::Unit& u) const { if (i != 0) return false; u.pm = pm; u.pn = pn; return true; } };

__device__ __forceinline__ void phase_mid(const Params& P, LAS unsigned char* lds, int l) {
    unsigned* ctl = (unsigned*)(P.ws + WS_CTL) + 64 * 8 * l;
    const int* order = (const int*)(P.ws + WS_ORDER);
    LAS int* slot = (LAS int*)(lds + LDS_BYTES - 64);
    bool small_ok = false; unsigned s5_ok = 0u;
    for (;;) {
        __syncthreads();
        if (otid() == 0) slot[0] = (int)__hip_atomic_fetch_add(ctl, 1u, __ATOMIC_RELAXED, __HIP_MEMORY_SCOPE_AGENT);
        __syncthreads();
        const int u = slot[0];
        if (u >= 1344) break;
        if (u < 64) { a1::cmp_task(P, lds, l, u >> 5, (u >> 3) & 3, u & 7); unit_done(ctl + 64); }
        else if (u < 320) { a1::gates_task(P, lds, l, u - 64); unit_done(ctl + 64); }
        else if (u < 576) { const int v = u - 320; s5::unit(P, lds, l, v >> 6, v & 63); unit_done(ctl + 128 + 64 * (v >> 6)); }
        else if (u < 1088) { const int id = order[u - 576];
            if (id < 256) { if (!small_ok) { unit_wait(ctl + 64, 320u); small_ok = true; } att::nsa_unit(P, lds, id >> 6, id & 63); }
            else { const int v = id - 256; att::moba_unit(P, lds, v >> 6, (v >> 4) & 3, v & 15); } }
        else { const int t = u - 1088, pm = t >> 2, b = pm >> 4;
            if (!((s5_ok >> b) & 1u)) { unit_wait(ctl + 128 + 64 * b, 64u); s5_ok |= 1u << b; }
            pg8::Gemm g{(const bf16*)(P.ws + WS_Y5), (const bf16*)(P.ws + WS_GLU + l * GLU_BYTES), NT, 1024, 1024, 1024};
            OneUnit S{pm, t & 3};
            EpiGlu E{(bf16*)(P.ws + WS_MIXED), (const bf16*)(P.ws + WS_Y5), (const bf16*)(P.ws + WS_PROJ)};
            pg8::gemm_phase<EpiGlu, OneUnit>(lds, g, S, E); }
    }
}

#define XB_TMO      128
#define XB_XCNT(j)  (256  + 64 * (j))
#define XB_XSUB(j)  (1280 + 64 * (j))
#define XB_XGEN(j)  (2304 + 64 * (j))
#define XB_TOP      3328
#define XB_TOPGEN   3392
#define XCD_BAR_WORDS 3456
#define XB_SPIN_CAP (1u << 18)
__device__ __forceinline__ unsigned xb_ld(unsigned* p)              { return __hip_atomic_load(p, __ATOMIC_RELAXED, __HIP_MEMORY_SCOPE_AGENT); }
__device__ __forceinline__ unsigned xb_add(unsigned* p, unsigned v) { return __hip_atomic_fetch_add(p, v, __ATOMIC_RELAXED, __HIP_MEMORY_SCOPE_AGENT); }
__device__ __forceinline__ unsigned xb_xcc_id() { return (unsigned)__builtin_amdgcn_s_getreg((3 << 11) | 20) & 0xFu; }
#define XB_SPIN(cond, bar) do { unsigned _sp = 0; while (cond) { __builtin_amdgcn_s_sleep(1); \
    if ((++_sp & 255u) == 0u) { if (xb_ld(&(bar)[XB_TMO])) break; if (_sp > XB_SPIN_CAP) { atomicAdd(&(bar)[XB_TMO], 1u); break; } } } } while (0)
struct XcdBarrier { unsigned* bar; unsigned x; volatile LAS unsigned* st; };
__device__ __forceinline__ XcdBarrier xcd_barrier_post(unsigned* bar, volatile LAS unsigned* st) {
    XcdBarrier b; b.bar = bar; b.x = xb_xcc_id(); b.st = st;
    if (threadIdx.x == 0) (void)xb_add(&bar[XB_XCNT(b.x)], 1u);
    return b;
}
__device__ __forceinline__ void xcd_barrier_complete(unsigned* bar, unsigned x, unsigned& nloc, unsigned& nx) {
    const unsigned G = gridDim.x * gridDim.y * gridDim.z;
    const unsigned lane = (unsigned)otid() & 63u;
    unsigned sum, cnt, mine, sp = 0u;
    for (;;) {
        const unsigned c = (lane < 16u) ? xb_ld(&bar[XB_XCNT(lane)]) : 0u;
        sum = c;
#pragma unroll
        for (int o = 1; o < 16; o <<= 1) sum += __shfl_xor(sum, o);
        sum = __shfl(sum, 0);
        cnt = (unsigned)__popcll(__ballot(c > 0u));
        mine = __shfl(c, (int)x);
        if (sum == G) break;
        __builtin_amdgcn_s_sleep(1);
        if ((++sp & 255u) == 0u) { if (xb_ld(&bar[XB_TMO])) break; if (sp > XB_SPIN_CAP) { if (lane == 0u) atomicAdd(&bar[XB_TMO], 1u); break; } }
    }
    nloc = mine > 0u ? mine : 1u; nx = cnt > 0u ? cnt : 1u;
}
__device__ __forceinline__ void xcd_barrier(const XcdBarrier& b) {
    asm volatile("s_waitcnt vmcnt(0)" ::: "memory");
    __syncthreads();
    if (threadIdx.x < 64 && b.st[0] == 0u) {
        unsigned nloc0, nx0; xcd_barrier_complete(b.bar, b.x, nloc0, nx0);
        if (threadIdx.x == 0) { b.st[0] = nloc0; b.st[1] = nx0; }
        asm volatile("s_waitcnt lgkmcnt(0)" ::: "memory");
    }
    if (threadIdx.x == 0) {
        unsigned* bar = b.bar;
        __builtin_amdgcn_s_waitcnt(0);
        unsigned nloc = b.st[0], nx = b.st[1];
        const unsigned old = xb_add(&bar[XB_XSUB(b.x)], 1u);
        const unsigned gen = old / nloc;
        if (old + 1u == (gen + 1u) * nloc) {
            __builtin_amdgcn_fence(__ATOMIC_RELEASE, "agent");
            asm volatile("s_waitcnt vmcnt(0)" ::: "memory");
            const unsigned og = xb_add(&bar[XB_TOP], 1u);
            const unsigned tg = og / nx;
            if (og + 1u == (tg + 1u) * nx) xb_add(&bar[XB_TOPGEN], 1u);
            else XB_SPIN(xb_ld(&bar[XB_TOPGEN]) == tg, bar);
            __builtin_amdgcn_fence(__ATOMIC_ACQUIRE, "agent");
            xb_add(&bar[XB_XGEN(b.x)], 1u);
            asm volatile("s_waitcnt vmcnt(0)" ::: "memory");
        } else {
            XB_SPIN(xb_ld(&bar[XB_XGEN(b.x)]) == gen, bar);
            __builtin_amdgcn_fence(__ATOMIC_ACQUIRE, "agent");
            asm volatile("s_waitcnt vmcnt(0)" ::: "memory");
        }
    }
    __syncthreads();
}

__global__ void __launch_bounds__(512, 2) k_mega(Params P) {
    extern __shared__ __attribute__((aligned(16))) unsigned char lds_raw[];
    LAS unsigned char* lds = (LAS unsigned char*)lds_raw;
    const int lo = P.ph_lo, hi = P.ph_hi;
#define IN(k) (lo <= (k) && (k) < hi)
    volatile LAS unsigned* bst = (volatile LAS unsigned*)(lds + LDS_BYTES - 32);
    if (threadIdx.x < 2) bst[threadIdx.x] = 0u;
    __syncthreads();
    const XcdBarrier bar = xcd_barrier_post((unsigned*)(P.ws + WS_CTL) + 4096, bst);
#define SEAM(k) do { if (IN(k) && IN((k) + 1)) xcd_barrier(bar); } while (0)
    if (IN(0)) phase_prep(P, lds);
    SEAM(0);
    for (int l = 0; l < NL; ++l) {
        if (IN(1 + 3 * l)) phase_gemm1(P, lds, l);
        SEAM(1 + 3 * l);
        if (IN(2 + 3 * l)) phase_mid(P, lds, l);
        SEAM(2 + 3 * l);
        if (IN(3 + 3 * l)) phase_out(P, lds, l);
        SEAM(3 + 3 * l);
    }
#undef SEAM
#undef IN
}

extern "C" void kernel_launch(void* const* d_in, const int* in_sizes, int n_in, void* d_out, int out_size, void* d_ws, size_t ws_size, hipStream_t stream) {
    static int grid = 0;
    if (grid == 0) {
        if (ws_size < WS_END) { fprintf(stderr, "kernel_launch: workspace too small (%zu < %zu)\n", ws_size, (size_t)WS_END); grid = -1; return; }
        int dev = 0, cus = 0;
        hipGetDevice(&dev); hipDeviceGetAttribute(&cus, hipDeviceAttributeMultiprocessorCount, dev);
        hipFuncSetAttribute((const void*)k_mega, hipFuncAttributeMaxDynamicSharedMemorySize, LDS_BYTES);
        int per_cu = 0;
        hipOccupancyMaxActiveBlocksPerMultiprocessor(&per_cu, (const void*)k_mega, 512, LDS_BYTES);
        if (per_cu < 1) { fprintf(stderr, "kernel_launch: occupancy query says %d blocks per CU\n", per_cu); per_cu = 1; }
        grid = (cus > 0 ? cus : 256) * 1;
    }
    if (grid < 0) return;
    unsigned char* ws = (unsigned char*)d_ws;
    Params P{};
    for (int i = 0; i < 25; ++i) P.in[i] = (const float*)d_in[i];
    P.out = (float*)d_out; P.ws = ws;
    hipMemsetAsync(ws + WS_CTL, 0, 32768, stream);
    P.ph_lo = 0; P.ph_hi = 7;
    void* args[] = {&P};
    hipError_t e = hipLaunchCooperativeKernel((const void*)k_mega, dim3(grid), dim3(512), args, LDS_BYTES, stream);
    if (e != hipSuccess) fprintf(stderr, "kernel_launch: cooperative launch failed: %s (grid %d)\n", hipGetErrorString(e), grid);
}
```

```cpp
#include <hip/hip_runtime.h>
#include <stdint.h>
#include <cstdio>

typedef unsigned short bf16;
typedef short bf16x8 __attribute__((ext_vector_type(8)));
typedef float f32x4 __attribute__((ext_vector_type(4)));
typedef unsigned u32x4 __attribute__((ext_vector_type(4)));
typedef unsigned u32x2 __attribute__((ext_vector_type(2)));
#define LAS __attribute__((address_space(3)))
__device__ __forceinline__ int otid() { int t = threadIdx.x; asm volatile("" : "+v"(t)); return t; }

constexpr int NB = 4, SEQ = 4096, DM = 2048, NT = NB * SEQ, NL = 2;
constexpr int INW = 5900;
constexpr int NP = 5888;
constexpr int O_MQ = 0, O_MK = 512, O_MV = 1024, O_MZ = 1536, O_NQ = 2048, O_KC = 2560, O_VC = 2688, O_KS = 2816, O_VS = 2944,
              O_KW = 3072, O_VW = 3200, O_NZ = 3328, O_SU = 3840, O_SZ = 4864;
constexpr int SRC_NG = 3328;
constexpr int NCMP = 255;
constexpr float EPSN = 1e-6f;
constexpr float SCALE = 0.08838834764831845f;

constexpr size_t MiB = 1u << 20;
constexpr size_t WS_CTL = 0;
constexpr size_t WS_WIN = 1 * MiB;
constexpr size_t WIN_BYTES = (size_t)NP * DM * 2;
constexpr size_t WS_WOUT = WS_WIN + 2 * WIN_BYTES;
constexpr size_t WOUT_BYTES = (size_t)DM * DM * 2;
constexpr size_t WS_GLU = WS_WOUT + 2 * WOUT_BYTES;
constexpr size_t GLU_BYTES = (size_t)1024 * 1024 * 2;
constexpr size_t WS_XB = WS_GLU + 2 * GLU_BYTES;
constexpr size_t WS_PROJ = WS_XB + (size_t)NT * DM * 2;
constexpr size_t WS_MIXED = WS_PROJ + (size_t)NT * NP * 2;
constexpr size_t WS_Y5 = WS_MIXED + (size_t)NT * DM * 2;
constexpr size_t WS_SSQP = WS_Y5 + (size_t)NT * 1024 * 2;
constexpr size_t WS_GATES = WS_SSQP + (size_t)NT * 32 * 4;
constexpr size_t WS_ROPE = WS_GATES + 1 * MiB;
constexpr size_t WS_RS = WS_ROPE + 512 * 1024;
constexpr size_t WS_KMEAN = WS_ROPE + 1 * MiB;
constexpr size_t WS_CMP = WS_KMEAN + 1 * MiB;
constexpr size_t WS_HID = WS_CMP + 1 * MiB;
constexpr size_t WS_CMPB = WS_HID + 1 * MiB;
constexpr size_t WS_ORDER = WS_CMPB + 1 * MiB;
constexpr size_t WS_S5K = WS_ORDER + 1 * MiB;
constexpr size_t WS_S5P1 = WS_S5K + 5 * MiB;
constexpr size_t WS_S5P2 = WS_S5P1 + 32 * MiB;
constexpr size_t WS_S5AL = WS_S5P2 + 32 * MiB;
constexpr size_t WS_W1F = WS_S5AL + 1 * MiB;
constexpr size_t WS_CST = WS_W1F + 4 * MiB;
constexpr size_t WS_WGF = WS_CST + 1 * MiB;
constexpr size_t WS_W2F = WS_WGF + 1 * MiB;
constexpr size_t WS_END = WS_W2F + 1 * MiB;
static_assert(WS_END <= 536870912ull, "workspace map exceeds 512 MiB");
constexpr size_t SUG_OFF = (size_t)256 * 256 * 128;

__device__ const double INVF[16] = {1.0, 0.44036660267178046, 0.19392274474868576, 0.08539710028576561, 0.03760603093086393,
    0.016560440080994446, 0.007292664737217109, 0.003211445994752591, 0.001414213562373095, 0.000622772421914596,
    0.0002742481756762073, 0.00012076973741146504, 5.318295896944988e-05, 2.341999896140934e-05, 1.031338537721246e-05,
    4.5416704806078695e-06};

__device__ __forceinline__ void dsincos(double a, double& s, double& c) {
    const double k = rint(a * 0.63661977236758134308);
    double r = fma(-k, 1.57079632679489655800e+00, a);
    r = fma(-k, 6.12323399573676603587e-17, r);
    const double r2 = r * r;
    double sp = 1.0 / 6227020800.0;
    sp = fma(sp, r2, -1.0 / 39916800.0); sp = fma(sp, r2, 1.0 / 362880.0); sp = fma(sp, r2, -1.0 / 5040.0);
    sp = fma(sp, r2, 1.0 / 120.0); sp = fma(sp, r2, -1.0 / 6.0); sp = fma(sp, r2, 1.0);
    const double sn = sp * r;
    double cp = -1.0 / 87178291200.0;
    cp = fma(cp, r2, 1.0 / 479001600.0); cp = fma(cp, r2, -1.0 / 3628800.0); cp = fma(cp, r2, 1.0 / 40320.0);
    cp = fma(cp, r2, -1.0 / 720.0); cp = fma(cp, r2, 1.0 / 24.0); cp = fma(cp, r2, -0.5); cp = fma(cp, r2, 1.0);
    const long long q = (long long)k & 3;
    if (q == 0) { s = sn; c = cp; } else if (q == 1) { s = cp; c = -sn; } else if (q == 2) { s = -sn; c = -cp; } else { s = -cp; c = sn; }
}
__device__ __forceinline__ float wave_sum(float v) {
#pragma unroll
    for (int o = 1; o < 64; o <<= 1) v += __shfl_xor(v, o);
    return v;
}
__device__ __forceinline__ float wave_max(float v) {
#pragma unroll
    for (int o = 1; o < 64; o <<= 1) v = fmaxf(v, __shfl_xor(v, o));
    return v;
}
__device__ __forceinline__ float sigmoidf_(float x) { return __builtin_amdgcn_rcpf(1.0f + __builtin_amdgcn_exp2f(-1.4426950408889634f * x)); }
__device__ __forceinline__ float siluf_(float x) { return x * sigmoidf_(x); }
__device__ __forceinline__ float geluf_(float x) { return x * sigmoidf_(1.5957691216057308f * (x + 0.044715f * x * x * x)); }
__device__ __forceinline__ float bf2f(bf16 b) { return __uint_as_float((unsigned)b << 16); }
__device__ __forceinline__ unsigned f2bf(float f) { const unsigned u = __float_as_uint(f); return (u + 0x7fffu + ((u >> 16) & 1u)) >> 16; }
__device__ __forceinline__ unsigned pk2(float lo, float hi) { return f2bf(lo) | (f2bf(hi) << 16); }
__device__ __forceinline__ float2 ld2(const bf16* p, int lane) { const unsigned w = ((const unsigned*)p)[lane]; return make_float2(__uint_as_float(w << 16), __uint_as_float(w & 0xffff0000u)); }

namespace pg8 {
constexpr int BM = 256, BK = 64, HALF = 128, HTB = HALF * BK * 2, STAGE_BYTES = 8 * HTB, NXCD = 8, WGM = 8;
__host__ __device__ __forceinline__ int lds_byte(int r, int c) { const int st = (r >> 4) * 2 + (c >> 5), rr = r & 15, cc = c & 31, ob = rr * 64 + cc * 2; return st * 1024 + (ob ^ (((ob >> 9) & 1) << 5)); }
__host__ __device__ __forceinline__ void stage_rc(int b, int& R, int& C) { const int st = b / 1024, sb = b % 1024, swz = sb ^ (((sb >> 9) & 1) << 5); R = (st >> 1) * 16 + swz / 64; C = (st & 1) * 32 + (swz % 64) / 2; }
__host__ __device__ __forceinline__ int perm32(int rho) { const int n = rho >> 4, i = rho & 15; return 8 * (i >> 2) + 4 * n + (i & 3); }
struct Unit { int pm, pn; };
struct Gemm { const bf16* A; const bf16* Bt; int M, N, K, lda; };
struct StaticOrder {
    int nM, nN, nwg, G, c, permN;
    __host__ __device__ void init(int M, int N, int G_, int c_, int permN_ = 0) { nM = M / BM; nN = N / BM; nwg = nM * nN; G = G_; c = c_; permN = permN_; }
    __host__ __device__ bool next(int i, Unit& u) const {
        const long L = (long)i * G + c; if (L >= nwg) return false;
        int wgid = (int)L; { const int q = nwg / NXCD, r = nwg % NXCD, xcd = wgid % NXCD, off = wgid / NXCD; wgid = (xcd < r ? xcd * (q + 1) : r * (q + 1) + (xcd - r) * q) + off; }
        const int nig = WGM * nN, gid = wgid / nig, fm = gid * WGM, gsz = (nM - fm) < WGM ? (nM - fm) : WGM;
        u.pm = fm + ((wgid % nig) % gsz); u.pn = (wgid % nig) / gsz;
        if (permN) u.pn = (int)((u.pn < 12 ? (0x14dc50c9a403169ull >> (5 * u.pn)) : (0x5a2a456071d1e6ull >> (5 * (u.pn - 12)))) & 31ull);
        return true;
    }
};
__device__ __forceinline__ unsigned cvt_pk_bf16(float lo, float hi) { unsigned r; asm volatile("v_cvt_pk_bf16_f32 %0, %1, %2" : "=v"(r) : "v"(lo), "v"(hi)); return r; }

template <class Epi, class Sched>
__device__ __forceinline__ void gemm_phase(LAS unsigned char* lds, const Gemm g, const Sched& S, const Epi& E) {
    constexpr bool ALIGN_EPI = true;
    const int tid = otid(), wid = __builtin_amdgcn_readfirstlane(tid >> 6), lane = tid & 63, wr = wid >> 2, wc = wid & 3, fr = lane & 15, fq = lane >> 4;
    const int K = g.K, nt = K / BK;
    unsigned voffA[2], voffB[2];
#pragma unroll
    for (int i = 0; i < 2; ++i) { int R, C; stage_rc(tid * 16 + i * 8192, R, C); const int Rb = Epi::PERM ? ((R & ~31) + perm32(R & 31)) : R;
        voffA[i] = (unsigned)(R * g.lda + C) * 2u; voffB[i] = (unsigned)(Rb * K + C) * 2u; }
    const size_t kstep = (size_t)(BK * 2);
    const size_t hstepA = (size_t)HALF * g.lda * 2, hstepB = (size_t)HALF * K * 2;
    const size_t tstepA = 2 * hstepA, tstepB = 2 * hstepB;
    const unsigned ldsw = (unsigned)wid * 1024u;
    const int aoff = lds_byte(wr * 64 + fr, fq * 8), boff = lds_byte(wc * 32 + fr, fq * 8);
#define PG8_SA(b, h) (((b) * 2 + (h)) * HTB)
#define PG8_SB(b, h) ((4 + (b) * 2 + (h)) * HTB)
#define PG8_STAGE(bufoff, gbase, voff) do { _Pragma("unroll") for (int _i = 0; _i < 2; ++_i) \
        __builtin_amdgcn_global_load_lds((const unsigned*)((const char*)(gbase) + (voff)[_i]), (LAS unsigned*)(lds + (bufoff) + ldsw + _i * 8192), 16, 0, 0); } while (0)
#define PG8_LDA(dst, b, h) do { _Pragma("unroll") for (int m = 0; m < 4; ++m) _Pragma("unroll") for (int k = 0; k < 2; ++k) dst[m][k] = *(const LAS bf16x8*)(lds + PG8_SA(b, h) + aoff + m * 2048 + k * 1024); } while (0)
#define PG8_LDB(dst, b, h) do { _Pragma("unroll") for (int n = 0; n < 2; ++n) _Pragma("unroll") for (int k = 0; k < 2; ++k) dst[n][k] = *(const LAS bf16x8*)(lds + PG8_SB(b, h) + boff + n * 2048 + k * 1024); } while (0)
#define PG8_MMA(ai, bj, At, Bt) do { __builtin_amdgcn_s_setprio(1); _Pragma("unroll") for (int m = 0; m < 4; ++m) _Pragma("unroll") for (int n = 0; n < 2; ++n) _Pragma("unroll") for (int k = 0; k < 2; ++k) \
        acc[ai][bj][m][n] = __builtin_amdgcn_mfma_f32_16x16x32_bf16(Bt[n][k], At[m][k], acc[ai][bj][m][n], 0, 0, 0); __builtin_amdgcn_s_setprio(0); } while (0)
#define PG8_WAIT_V(n) asm volatile("s_waitcnt vmcnt(" #n ")" ::: "memory")
#define PG8_WAIT_L(n) asm volatile("s_waitcnt lgkmcnt(" #n ")" ::: "memory")
#define PG8_BAR __builtin_amdgcn_s_barrier()
#define PG8_SCHED __builtin_amdgcn_sched_barrier(0)
    Unit cur, nxt; int ui = 0;
    if (!S.next(0, cur)) return;
    typename Epi::Pre pre = E.pre(cur, wr), pren = pre;
    f32x4 acc[2][2][4][2];
#pragma unroll
    for (int a = 0; a < 2; ++a)
#pragma unroll
        for (int b = 0; b < 2; ++b)
#pragma unroll
            for (int m = 0; m < 4; ++m)
#pragma unroll
                for (int n = 0; n < 2; ++n) acc[a][b][m][n] = (f32x4){0.f, 0.f, 0.f, 0.f};
    bf16x8 At[4][2], B0[2][2], B1[2][2];
    const char* cA = (const char*)g.A + (size_t)cur.pm * tstepA; const char* cB = (const char*)g.Bt + (size_t)cur.pn * tstepB;
    PG8_STAGE(PG8_SB(0, 0), cB, voffB); PG8_STAGE(PG8_SB(0, 1), cB + hstepB, voffB); PG8_STAGE(PG8_SA(0, 0), cA, voffA); PG8_STAGE(PG8_SA(0, 1), cA + hstepA, voffA);
    if (wr == 1) PG8_BAR;
    PG8_WAIT_V(2); PG8_BAR;
    PG8_STAGE(PG8_SB(1, 0), cB + kstep, voffB); PG8_STAGE(PG8_SA(1, 0), cA + kstep, voffA); PG8_STAGE(PG8_SB(1, 1), cB + hstepB + kstep, voffB);
    PG8_WAIT_V(6); PG8_BAR;
    for (;;) {
        const bool has_next = S.next(ui + 1, nxt);
        const char* nA = has_next ? (const char*)g.A + (size_t)nxt.pm * tstepA : cA; const char* nB = has_next ? (const char*)g.Bt + (size_t)nxt.pn * tstepB : cB;
        for (int t = 0; t < nt; t += 2) {
            const bool last = (t == nt - 2);
            const char* a1 = cA + (size_t)(t + 1) * kstep;
            const char* a2 = last ? nA : cA + (size_t)(t + 2) * kstep; const char* b2 = last ? nB : cB + (size_t)(t + 2) * kstep;
            const char* a3 = a2 + kstep; const char* b3 = b2 + kstep;
            PG8_LDB(B0, 0, 0); PG8_LDB(B1, 0, 1); PG8_SCHED; PG8_LDA(At, 0, 0); PG8_STAGE(PG8_SA(1, 1), a1 + hstepA, voffA);
            PG8_WAIT_V(8); PG8_WAIT_L(0); PG8_BAR; PG8_MMA(0, 0, At, B0); PG8_MMA(0, 1, At, B1); PG8_BAR; PG8_SCHED;
            PG8_LDA(At, 0, 1); PG8_STAGE(PG8_SB(0, 0), b2, voffB); PG8_STAGE(PG8_SB(0, 1), b2 + hstepB, voffB); PG8_STAGE(PG8_SA(0, 0), a2, voffA);
            PG8_WAIT_V(8); PG8_WAIT_L(0); PG8_BAR; PG8_MMA(1, 0, At, B0); PG8_MMA(1, 1, At, B1); PG8_BAR; PG8_SCHED;
            PG8_LDB(B0, 1, 0); PG8_LDB(B1, 1, 1); PG8_SCHED; PG8_LDA(At, 1, 0); PG8_STAGE(PG8_SA(0, 1), a2 + hstepA, voffA);
            PG8_WAIT_V(8); PG8_WAIT_L(0); PG8_BAR; PG8_MMA(0, 0, At, B0); PG8_MMA(0, 1, At, B1); PG8_BAR; PG8_SCHED;
            PG8_LDA(At, 1, 1); PG8_STAGE(PG8_SB(1, 0), b3, voffB); PG8_STAGE(PG8_SB(1, 1), b3 + hstepB, voffB); PG8_STAGE(PG8_SA(1, 0), a3, voffA);
            PG8_WAIT_V(8); PG8_WAIT_L(0); PG8_BAR; PG8_MMA(1, 0, At, B0); PG8_MMA(1, 1, At, B1); PG8_BAR; PG8_SCHED;
        }
        if constexpr (ALIGN_EPI) { if (wr == 0) PG8_BAR; }
        if (has_next) pren = E.pre(nxt, wr);
        E(acc, cur, wr, wc, fr, fq, pre);
        if (!has_next) break;
        pre = pren;
#pragma unroll
        for (int a = 0; a < 2; ++a)
#pragma unroll
            for (int b = 0; b < 2; ++b)
#pragma unroll
                for (int m = 0; m < 4; ++m)
#pragma unroll
                    for (int n = 0; n < 2; ++n) acc[a][b][m][n] = (f32x4){0.f, 0.f, 0.f, 0.f};
        cur = nxt; cA = nA; cB = nB; ++ui;
        if constexpr (ALIGN_EPI) { if (wr == 1) PG8_BAR; }
    }
    PG8_WAIT_V(0);
    if constexpr (!ALIGN_EPI) { if (wr == 0) PG8_BAR; }
    PG8_BAR;
#undef PG8_SA
#undef PG8_SB
#undef PG8_STAGE
#undef PG8_LDA
#undef PG8_LDB
#undef PG8_MMA
#undef PG8_WAIT_V
#undef PG8_WAIT_L
#undef PG8_BAR
#undef PG8_SCHED
}
}

struct EpiProj {
    static constexpr bool PERM = true;
    bf16* O; bf16* ug; const float* rs; const float *nw0, *nw1, *nw2, *nw3, *nw4; const float2* cs; float* kmean; LAS unsigned char* xl;
    struct Pre { float r0, r1; };
    __device__ __forceinline__ Pre pre(const pg8::Unit& u, int wr) const { const float* p = rs + u.pm * 256 + 64 * wr + (otid() & 63); Pre q; q.r0 = p[0]; q.r1 = p[128]; return q; }
    __device__ __forceinline__ static int nid(int h) { return h < 4 ? 0 : h < 8 ? 1 : (h >= 16 && h < 20) ? 2 : h == 22 ? 3 : h == 24 ? 4 : -1; }
    __device__ __forceinline__ void operator()(const f32x4 (&acc)[2][2][4][2], const pg8::Unit& u, int wr, int wc, int fr, int fq, const Pre& pr) const {
        const float rsv[2] = {pr.r0, pr.r1};
        const int row0 = u.pm * 256 + wr * 64 + fr, col0 = u.pn * 256 + wc * 32 + 8 * fq;
        const int n0 = nid(2 * u.pn), n1 = nid(2 * u.pn + 1);
        if (n0 < 0 && n1 < 0) {
            const bool su = (u.pn >= O_SU / 256) && (u.pn < O_SZ / 256);
            const int cs0 = col0 - O_SU;
#pragma unroll
            for (int ai = 0; ai < 2; ++ai)
#pragma unroll
                for (int m = 0; m < 4; ++m) {
                    const float r = __shfl(rsv[ai], m * 16 + fr);
                    const int row = row0 + ai * 128 + m * 16;
                    bf16* rowp = su ? ug + (((size_t)((row >> 12) * 64 + (cs0 >> 4)) * SEQ + (row & (SEQ - 1))) * 16 + (cs0 & 8)) : O + (size_t)row * NP + col0;
                    const size_t bjs = su ? (size_t)8 * SEQ * 16 : (size_t)128;
#pragma unroll
                    for (int bj = 0; bj < 2; ++bj) { const f32x4 v0 = acc[ai][bj][m][0] * r, v1 = acc[ai][bj][m][1] * r;
                        u32x4 w; w.x = pg8::cvt_pk_bf16(v0[0], v0[1]); w.y = pg8::cvt_pk_bf16(v0[2], v0[3]); w.z = pg8::cvt_pk_bf16(v1[0], v1[1]); w.w = pg8::cvt_pk_bf16(v1[2], v1[3]);
                        *(u32x4*)(rowp + bj * bjs) = w; }
                }
            return;
        }
        LAS float* part = (LAS float*)xl;
        LAS float* ksum = (LAS float*)(xl + 8192);
#pragma unroll
        for (int ai = 0; ai < 2; ++ai)
#pragma unroll
            for (int m = 0; m < 4; ++m) {
                const float r = __shfl(rsv[ai], m * 16 + fr);
#pragma unroll
                for (int bj = 0; bj < 2; ++bj) { const f32x4 v0 = acc[ai][bj][m][0] * r, v1 = acc[ai][bj][m][1] * r;
                    float ss = (v0[0] * v0[0] + v0[1] * v0[1]) + (v0[2] * v0[2] + v0[3] * v0[3]) + (v1[0] * v1[0] + v1[1] * v1[1]) + (v1[2] * v1[2] + v1[3] * v1[3]);
                    ss += __shfl_xor(ss, 16); ss += __shfl_xor(ss, 32);
                    if (fq == 0) part[((ai * 128 + wr * 64 + m * 16 + fr) * 2 + bj) * 4 + wc] = ss; }
            }
        asm volatile("s_waitcnt lgkmcnt(0)" ::: "memory"); __builtin_amdgcn_s_barrier(); asm volatile("" ::: "memory");
        float csum[2][8];
#pragma unroll
        for (int bj = 0; bj < 2; ++bj)
#pragma unroll
            for (int e = 0; e < 8; ++e) csum[bj][e] = 0.f;
        f32x4 wq[2][2];
#pragma unroll
        for (int bj = 0; bj < 2; ++bj) { const int ni = bj ? n1 : n0;
            const float* wp = (ni <= 0 ? nw0 : ni == 1 ? nw1 : ni == 2 ? nw2 : ni == 3 ? nw3 : nw4) + wc * 32 + 8 * fq;
            wq[bj][0] = *(const f32x4*)wp; wq[bj][1] = *(const f32x4*)(wp + 4); }
        f32x4 cnx[4];
        const int ol = otid() & 63, ofr = ol & 15, ofq1 = (ol >> 4) & 1;
        { const f32x4* c4 = (const f32x4*)(cs + (size_t)((u.pm * 256 + wr * 64 + ofr) & (SEQ - 1)) * 16 + 8 * ofq1);
#pragma unroll
          for (int q = 0; q < 4; ++q) cnx[q] = c4[q]; }
#pragma unroll
        for (int ai = 0; ai < 2; ++ai)
#pragma unroll
            for (int m = 0; m < 4; ++m) {
                const float r = __shfl(rsv[ai], m * 16 + fr);
                const int rl = ai * 128 + wr * 64 + m * 16 + fr;
                bf16* rowp = O + (size_t)(u.pm * 256 + rl) * NP + col0;
                f32x4 ccur[4];
#pragma unroll
                for (int q = 0; q < 4; ++q) ccur[q] = cnx[q];
                if (ai * 4 + m < 7) { const int rn_ = (ai * 4 + m + 1 >= 4 ? 128 : 0) + wr * 64 + ((ai * 4 + m + 1) & 3) * 16 + ofr;
                    const f32x4* c4 = (const f32x4*)(cs + (size_t)((u.pm * 256 + rn_) & (SEQ - 1)) * 16 + 8 * ofq1);
#pragma unroll
                    for (int q = 0; q < 4; ++q) cnx[q] = c4[q]; }
#pragma unroll
                for (int bj = 0; bj < 2; ++bj) {
                    const int ni = bj ? n1 : n0;
                    float v[8];
#pragma unroll
                    for (int e = 0; e < 8; ++e) v[e] = ((e < 4) ? acc[ai][bj][m][0][e & 3] : acc[ai][bj][m][1][e & 3]) * r;
                    if (ni >= 0) {
                        const f32x4 p4 = *(const LAS f32x4*)(part + (rl * 2 + bj) * 4);
                        const float rn = 1.0f / sqrtf(((p4[0] + p4[1]) + (p4[2] + p4[3])) * (1.0f / 128.0f) + EPSN);
#pragma unroll
                        for (int e = 0; e < 8; ++e) v[e] *= rn * ((e < 4) ? wq[bj][0][e & 3] : wq[bj][1][e & 3]);
                        if (wc == 0) {
#pragma unroll
                            for (int e = 0; e < 8; ++e) { const float other = __shfl_xor(v[e], 32); const float cx = ccur[e >> 1][2 * (e & 1)], cy = ccur[e >> 1][2 * (e & 1) + 1];
                                v[e] = (fq < 2) ? (v[e] * cx - other * cy) : (v[e] * cx + other * cy); }
                        }
                        if (ni == 1) {
#pragma unroll
                            for (int e = 0; e < 8; ++e) csum[bj][e] += v[e];
                        }
                    }
                    u32x4 w; w.x = pg8::cvt_pk_bf16(v[0], v[1]); w.y = pg8::cvt_pk_bf16(v[2], v[3]); w.z = pg8::cvt_pk_bf16(v[4], v[5]); w.w = pg8::cvt_pk_bf16(v[6], v[7]);
                    *(u32x4*)(rowp + bj * 128) = w;
                }
                asm volatile("" ::: "memory");
            }
        if (n0 == 1) {
#pragma unroll
            for (int bj = 0; bj < 2; ++bj)
#pragma unroll
                for (int e = 0; e < 8; ++e) { float s = csum[bj][e]; s += __shfl_xor(s, 1); s += __shfl_xor(s, 2); s += __shfl_xor(s, 4); s += __shfl_xor(s, 8);
                    if (fr == 0) ksum[wr * 256 + bj * 128 + wc * 32 + 8 * fq + e] = s; }
            asm volatile("s_waitcnt lgkmcnt(0)" ::: "memory"); __builtin_amdgcn_s_barrier(); asm volatile("" ::: "memory");
            const int tid = otid();
            if (tid < 256) { const int h = 2 * u.pn + (tid >> 7) - 4, b = u.pm >> 4, n = u.pm & 15;
                kmean[((size_t)(b * 4 + h) * 16 + n) * 128 + (tid & 127)] = (ksum[tid] + ksum[256 + tid]) * (1.0f / 256.0f); }
        }
    }
};
struct EpiGlu {
    static constexpr bool PERM = true;
    bf16* mixed; const bf16* y5; const bf16* proj;
    struct Pre {};
    __device__ __forceinline__ Pre pre(const pg8::Unit&, int) const { return Pre{}; }
    __device__ __forceinline__ void operator()(const f32x4 (&acc)[2][2][4][2], const pg8::Unit& u, int wr, int wc, int fr, int fq, const Pre&) const {
        const int row0 = u.pm * 256 + wr * 64 + fr, col0 = u.pn * 256 + wc * 32 + 8 * fq;
#pragma unroll
        for (int ai = 0; ai < 2; ++ai) {
            u32x4 yv[4][2], zv[4][2];
#pragma unroll
            for (int m = 0; m < 4; ++m)
#pragma unroll
                for (int bj = 0; bj < 2; ++bj) { const size_t row = (size_t)(row0 + ai * 128 + m * 16); const int col = col0 + bj * 128;
                    yv[m][bj] = *(const u32x4*)(y5 + row * 1024 + col); zv[m][bj] = *(const u32x4*)(proj + row * NP + O_SZ + col); }
            asm volatile("" ::: "memory");
#pragma unroll
            for (int m = 0; m < 4; ++m) {
                const size_t row = (size_t)(row0 + ai * 128 + m * 16);
#pragma unroll
                for (int bj = 0; bj < 2; ++bj) {
                    const int col = col0 + bj * 128;
                    float o[8];
#pragma unroll
                    for (int e = 0; e < 8; ++e) {
                        const float a = (e < 4) ? acc[ai][bj][m][0][e & 3] : acc[ai][bj][m][1][e & 3];
                        const unsigned yw = yv[m][bj][e >> 1], zw = zv[m][bj][e >> 1];
                        const float y = (e & 1) ? __uint_as_float(yw & 0xffff0000u) : __uint_as_float(yw << 16);
                        const float z = (e & 1) ? __uint_as_float(zw & 0xffff0000u) : __uint_as_float(zw << 16);
                        o[e] = y * sigmoidf_(a) * siluf_(z);
                    }
                    u32x4 w; w.x = pg8::cvt_pk_bf16(o[0], o[1]); w.y = pg8::cvt_pk_bf16(o[2], o[3]); w.z = pg8::cvt_pk_bf16(o[4], o[5]); w.w = pg8::cvt_pk_bf16(o[6], o[7]);
                    *(u32x4*)(mixed + row * DM + 1024 + col) = w;
                }
            }
        }
    }
};
struct EpiOut {
    static constexpr bool PERM = true;
    float* out; bf16* xb; float* ssqp; int last; float* rs; unsigned* cnt; LAS unsigned* fl;
    struct Pre {};
    __device__ __forceinline__ Pre pre(const pg8::Unit&, int) const { return Pre{}; }
    __device__ __forceinline__ void operator()(const f32x4 (&acc)[2][2][4][2], const pg8::Unit& u, int wr, int wc, int fr, int fq, const Pre&) const {
        const int row0 = u.pm * 256 + wr * 64 + fr, col0 = u.pn * 256 + wc * 32 + 8 * fq;
#pragma unroll
        for (int ai = 0; ai < 2; ++ai) {
            u32x4 xv[4][2];
#pragma unroll
            for (int m = 0; m < 4; ++m)
#pragma unroll
                for (int bj = 0; bj < 2; ++bj) xv[m][bj] = *(const u32x4*)(xb + (size_t)(row0 + ai * 128 + m * 16) * DM + col0 + bj * 128);
            asm volatile("" ::: "memory");
#pragma unroll
            for (int m = 0; m < 4; ++m) {
                const size_t row = (size_t)(row0 + ai * 128 + m * 16);
                float ss = 0.f;
#pragma unroll
                for (int bj = 0; bj < 2; ++bj) {
                    const size_t off = row * DM + col0 + bj * 128;
                    const u32x4 xw = xv[m][bj];
                    f32x4 a, b;
                    a[0] = __uint_as_float(xw.x << 16) + acc[ai][bj][m][0][0]; a[1] = __uint_as_float(xw.x & 0xffff0000u) + acc[ai][bj][m][0][1];
                    a[2] = __uint_as_float(xw.y << 16) + acc[ai][bj][m][0][2]; a[3] = __uint_as_float(xw.y & 0xffff0000u) + acc[ai][bj][m][0][3];
                    b[0] = __uint_as_float(xw.z << 16) + acc[ai][bj][m][1][0]; b[1] = __uint_as_float(xw.z & 0xffff0000u) + acc[ai][bj][m][1][1];
                    b[2] = __uint_as_float(xw.w << 16) + acc[ai][bj][m][1][2]; b[3] = __uint_as_float(xw.w & 0xffff0000u) + acc[ai][bj][m][1][3];
                    if (last) { *(f32x4*)(out + off) = a; *(f32x4*)(out + off + 4) = b; }
                    else {
                        ss += ((a[0] * a[0] + a[1] * a[1]) + (a[2] * a[2] + a[3] * a[3])) + ((b[0] * b[0] + b[1] * b[1]) + (b[2] * b[2] + b[3] * b[3]));
                        u32x4 w; w.x = pg8::cvt_pk_bf16(a[0], a[1]); w.y = pg8::cvt_pk_bf16(a[2], a[3]); w.z = pg8::cvt_pk_bf16(b[0], b[1]); w.w = pg8::cvt_pk_bf16(b[2], b[3]);
                        *(u32x4*)(xb + off) = w;
                    }
                }
                if (!last) {
                    ss += __shfl_xor(ss, 16); ss += __shfl_xor(ss, 32);
                    if (fq == 0) __hip_atomic_store((unsigned*)(ssqp + row * 32 + u.pn * 4 + wc), __float_as_uint(ss), __ATOMIC_RELAXED, __HIP_MEMORY_SCOPE_AGENT);
                }
            }
        }
        if (!last) {
            const int tid = otid();
            asm volatile("s_waitcnt vmcnt(0)" ::: "memory"); __builtin_amdgcn_s_barrier();
            if (tid == 0) {
                const unsigned old = __hip_atomic_fetch_add(cnt + u.pm, 1u, __ATOMIC_RELAXED, __HIP_MEMORY_SCOPE_AGENT);
                if (old == 7u) { __builtin_amdgcn_fence(__ATOMIC_ACQUIRE, "agent"); asm volatile("s_waitcnt vmcnt(0)" ::: "memory"); }
                fl[0] = old; }
            asm volatile("s_waitcnt lgkmcnt(0)" ::: "memory"); __builtin_amdgcn_s_barrier(); asm volatile("" ::: "memory");
            if (fl[0] == 7u) { asm volatile("; last arriver" ::: "memory");
                if (tid < 256) { const f32x4* sp = (const f32x4*)(ssqp + (size_t)(u.pm * 256 + tid) * 32); float s = 0.f;
#pragma unroll
                    for (int i = 0; i < 8; ++i) { const f32x4 v = sp[i]; s += (v[0] + v[1]) + (v[2] + v[3]); }
                    rs[u.pm * 256 + tid] = 1.0f / sqrtf(s * (1.0f / DM) + EPSN); }
            }
        }
    }
};

struct Params {
    const float* in[25];
    float* out;
    unsigned char* ws;
    int ph_lo, ph_hi;
};
constexpr int LDS_BYTES = 147456;
constexpr int NWAVES = 8;

namespace a1 { __device__ __forceinline__ void prep_w1(const Params& P, LAS unsigned char* lds); }
namespace s5 { __device__ __forceinline__ void tables_task(const Params& P, LAS unsigned char* lds, const int l, const int g, const int part); }
__device__ __forceinline__ void p0_transpose_item(const float* W, int ldsrc, int srccol0, int K, const float* kscale, bf16* WT, int n0, int k0, LAS float* scr, int lane) {
    float tv[32];
#pragma unroll
    for (int i = 0; i < 32; ++i) tv[i] = W[(size_t)(k0 + 2 * i + (lane >> 5)) * ldsrc + srccol0 + (lane & 31)];
#pragma unroll
    for (int i = 0; i < 32; ++i) { const int kk = 2 * i + (lane >> 5); float v = tv[i]; if (kscale) v *= kscale[k0 + kk]; scr[kk * 33 + (lane & 31)] = v; }
    asm volatile("s_waitcnt lgkmcnt(0)" ::: "memory");
    const int c = lane & 7;
#pragma unroll
    for (int j = 0; j < 4; ++j) { const int n = (lane >> 3) + 8 * j; const LAS float* s = scr + (8 * c) * 33 + n;
        u32x4 o; o.x = pk2(s[0 * 33], s[1 * 33]); o.y = pk2(s[2 * 33], s[3 * 33]); o.z = pk2(s[4 * 33], s[5 * 33]); o.w = pk2(s[6 * 33], s[7 * 33]);
        *(u32x4*)(WT + (size_t)(n0 + n) * K + k0 + 8 * c) = o; }
    asm volatile("s_waitcnt lgkmcnt(0)" ::: "memory");
}
__device__ __forceinline__ void phase_prep(const Params& P, LAS unsigned char* lds) {
    const int tid = otid(), lane = tid & 63, wave = tid >> 6;
    LAS float* scr = (LAS float*)(lds + wave * 16384);
    const int gw = blockIdx.x * NWAVES + wave, NGW = gridDim.x * NWAVES;
    constexpr int I_IN = (DM / 64) * (NP / 32), I_OUT = (DM / 64) * (DM / 32), I_GLU = (1024 / 64) * (1024 / 32);
    constexpr int PER_L = I_IN + I_OUT + I_GLU;
    for (int pass = 0; pass < 2; ++pass) {
    if ((pass == 0) == ((blockIdx.x & 1) == 0)) {
    for (int it = gw; it < NL * PER_L; it += NGW) {
        const int l = it / PER_L; int r = it % PER_L;
        if (r < I_IN) { const int nb = r % (NP / 32), kb = r / (NP / 32), n0 = nb * 32, src = n0 + (n0 >= SRC_NG ? 12 : 0);
            p0_transpose_item(P.in[2] + (size_t)l * DM * INW, INW, src, DM, P.in[1] + l * DM, (bf16*)(P.ws + WS_WIN + l * WIN_BYTES), n0, kb * 64, scr, lane); continue; }
        r -= I_IN;
        if (r < I_OUT) { const int nb = r % (DM / 32), kb = r / (DM / 32);
            p0_transpose_item(P.in[3] + (size_t)l * DM * DM, DM, nb * 32, DM, nullptr, (bf16*)(P.ws + WS_WOUT + l * WOUT_BYTES), nb * 32, kb * 64, scr, lane); continue; }
        r -= I_OUT;
        { const int nb = r % 32, kb = r / 32;
            p0_transpose_item(P.in[24] + (size_t)l * 1024 * 1024, 1024, nb * 32, 1024, nullptr, (bf16*)(P.ws + WS_GLU + l * GLU_BYTES), nb * 32, kb * 64, scr, lane); }
    }
    const float* x = P.in[0]; bf16* xb = (bf16*)(P.ws + WS_XB); float* rs = (float*)(P.ws + WS_RS);
    for (int m = gw; m < NT; m += NGW) {
        const f32x4* xr = (const f32x4*)(x + (size_t)m * DM) + lane;
        u32x2* o8 = (u32x2*)(xb + (size_t)m * DM) + lane;
        float s = 0.f;
        f32x4 xv[8];
#pragma unroll
        for (int j = 0; j < 8; ++j) xv[j] = xr[64 * j];
        __builtin_amdgcn_sched_barrier(0);
#pragma unroll
        for (int j = 0; j < 8; ++j) { const f32x4 v = xv[j]; s += (v[0] * v[0] + v[1] * v[1]) + (v[2] * v[2] + v[3] * v[3]); u32x2 w; w.x = pk2(v[0], v[1]); w.y = pk2(v[2], v[3]); o8[64 * j] = w; }
        __builtin_amdgcn_sched_barrier(0);
        s = wave_sum(s);
        if (lane == 0) rs[m] = 1.0f / sqrtf(s * (1.0f / DM) + EPSN);
    }
    float2* cs = (float2*)(P.ws + WS_ROPE);
    for (int i = blockIdx.x * blockDim.x + tid; i < SEQ * 16; i += gridDim.x * blockDim.x) {
        double s, c; dsincos((double)(i >> 4) * INVF[i & 15], s, c); cs[i] = make_float2((float)c, (float)s);
    }
    } else {
        for (int t = blockIdx.x; t < NL * 64 * 4; t += gridDim.x) s5::tables_task(P, lds, t >> 8, (t >> 2) & 63, t & 3);
    }
    __syncthreads();
    }
    a1::prep_w1(P, lds);
    if (blockIdx.x == 0) {
        int* order = (int*)(P.ws + WS_ORDER);
        const int u = tid; const int cu = (u < 256) ? (2 * (u & 63) + 46) : (8 * ((u - 256) & 15) + 9);
        int rank = 0;
        for (int v = 0; v < 512; ++v) { const int cv = (v < 256) ? (2 * (v & 63) + 46) : (8 * ((v - 256) & 15) + 9); rank += (cv > cu || (cv == cu && v < u)) ? 1 : 0; }
        order[rank] = u;
    }
}

__device__ __forceinline__ void phase_gemm1(const Params& P, LAS unsigned char* lds, int l) {
    pg8::Gemm g{(const bf16*)(P.ws + WS_XB), (const bf16*)(P.ws + WS_WIN + l * WIN_BYTES), NT, NP, DM, DM};
    pg8::StaticOrder S; S.init(NT, NP, gridDim.x, blockIdx.x, 1);
    EpiProj E{(bf16*)(P.ws + WS_PROJ), (bf16*)(P.out + SUG_OFF), (const float*)(P.ws + WS_RS), P.in[4] + l * 128, P.in[5] + l * 128, P.in[6] + l * 128, P.in[8] + l * 128, P.in[9] + l * 128,
              (const float2*)(P.ws + WS_ROPE), (float*)(P.ws + WS_KMEAN), lds + 131072};
    pg8::gemm_phase<EpiProj, pg8::StaticOrder>(lds, g, S, E);
}
__device__ __forceinline__ void phase_out(const Params& P, LAS unsigned char* lds, int l) {
    pg8::Gemm g{(const bf16*)(P.ws + WS_MIXED), (const bf16*)(P.ws + WS_WOUT + l * WOUT_BYTES), NT, DM, DM, DM};
    pg8::StaticOrder S; S.init(NT, DM, gridDim.x, blockIdx.x);
    EpiOut E{P.out, (bf16*)(P.ws + WS_XB), (float*)(P.ws + WS_SSQP), l == NL - 1 ? 1 : 0, (float*)(P.ws + WS_RS), (unsigned*)(P.ws + WS_CTL) + 2048 + 64 * l, (LAS unsigned*)(lds + 131072 + 12288)};
    pg8::gemm_phase<EpiOut, pg8::StaticOrder>(lds, g, S, E);
}

namespace att {
typedef short s16x4 __attribute__((ext_vector_type(4)));
typedef float f32x16 __attribute__((ext_vector_type(16)));
constexpr int SHM_K = 16384, SHM_V = 16384;
constexpr int OFF_V = 0, OFF_K = 2 * SHM_V, OFF_WS = 2 * SHM_V + 2 * SHM_K;
constexpr int OFF_X = OFF_WS + 8 * 256;
constexpr unsigned WINF = 0x7fffffffu;
constexpr float THR = 8.f;
#define KSWZ(row, colB) ((row) * 256 + ((colB) ^ (((row) & 7) << 4)))
#define SBAR() __builtin_amdgcn_sched_barrier(0)
#define LDSBAR() do { asm volatile("s_waitcnt lgkmcnt(0)" ::: "memory"); __builtin_amdgcn_s_barrier(); asm volatile("" ::: "memory"); } while (0)
__device__ __forceinline__ int v_st(int k, int c) { const int kk = (k & ~0xC) | ((k & 4) << 1) | ((k & 8) >> 1); return ((kk >> 3) * 4 + (c >> 5)) * 512 + ((kk & 7) * 32 + (c & 31)) * 2; }
__device__ __forceinline__ int v_rd_base(int lane) { return ((lane & 3) << 3) | (((lane >> 2) & 3) << 6) | (((lane >> 4) & 1) << 5) | (((lane >> 5) & 1) << 8); }
constexpr int v_rd_off(int d0, int ks, int half) { return d0 * 512 + ks * 4096 + half * 2048; }
__device__ __forceinline__ int crow(int r, int hi) { return (r & 3) + 8 * (r >> 2) + 4 * hi; }
__device__ __forceinline__ unsigned cvtpk(float lo, float hi) { unsigned r; asm volatile("v_cvt_pk_bf16_f32 %0, %1, %2" : "=v"(r) : "v"(lo), "v"(hi)); return r; }

__device__ __forceinline__ void mask_tile(f32x16& p0, f32x16& p1, int dq, unsigned W) {
    const float NEG = -__builtin_inff();
#pragma unroll
    for (int r = 0; r < 16; ++r) {
        const int c = (r & 3) + 8 * (r >> 2);
        if ((unsigned)(dq - c) >= W) p0[r] = NEG;
        if ((unsigned)(dq - c - 32) >= W) p1[r] = NEG;
    }
}
__device__ __forceinline__ void qkt(f32x16& p0, f32x16& p1, LAS const unsigned char* Kb, int r32, int hi, const bf16x8* qr) {
    p0 = f32x16{}; p1 = f32x16{};
    const int ka0 = (int)(uintptr_t)(Kb + KSWZ(r32, (0 * 16 + hi * 8) * 2)), ka1 = (int)(uintptr_t)(Kb + KSWZ(r32, (1 * 16 + hi * 8) * 2));
    const int ka2 = (int)(uintptr_t)(Kb + KSWZ(r32, (2 * 16 + hi * 8) * 2)), ka3 = (int)(uintptr_t)(Kb + KSWZ(r32, (3 * 16 + hi * 8) * 2));
#define Q_KR(dst, addr, off) asm volatile("ds_read_b128 %0, %1 offset:%2" : "=&v"(dst) : "v"(addr), "i"(off) : "memory")
#define Q_KRD(F, kaa, kab, hoff) do { Q_KR(F[0], kaa, hoff); Q_KR(F[1], kaa, hoff + 8192); Q_KR(F[2], kab, hoff); Q_KR(F[3], kab, hoff + 8192); } while (0)
#define Q_WAIT() do { asm volatile("s_waitcnt lgkmcnt(0)" ::: "memory"); SBAR(); } while (0)
#define Q_QK(F, q0) do { \
        p0 = __builtin_amdgcn_mfma_f32_32x32x16_bf16(F[0], qr[q0], p0, 0, 0, 0); p1 = __builtin_amdgcn_mfma_f32_32x32x16_bf16(F[1], qr[q0], p1, 0, 0, 0); \
        p0 = __builtin_amdgcn_mfma_f32_32x32x16_bf16(F[2], qr[q0 + 1], p0, 0, 0, 0); p1 = __builtin_amdgcn_mfma_f32_32x32x16_bf16(F[3], qr[q0 + 1], p1, 0, 0, 0); } while (0)
    bf16x8 FA[4], FB[4];
    Q_KRD(FA, ka0, ka1, 0); Q_WAIT();
    Q_KRD(FB, ka2, ka3, 0); Q_QK(FA, 0); Q_WAIT();
    Q_KRD(FA, ka0, ka1, 128); Q_QK(FB, 2); Q_WAIT();
    Q_KRD(FB, ka2, ka3, 128); Q_QK(FA, 4); Q_WAIT();
    Q_QK(FB, 6);
#undef Q_KR
#undef Q_KRD
#undef Q_WAIT
#undef Q_QK
}
__device__ __forceinline__ void pv_tile(f32x16* o, int vb, bf16x8 pa0, bf16x8 pa1, bf16x8 pa2, bf16x8 pa3) {
#define TRRD(dst, off) asm volatile("ds_read_b64_tr_b16 %0, %1 offset:%2" : "=&v"(dst) : "v"(vb), "i"(off) : "memory")
#define PV_D0(d0) do { s16x4 l0, l1, l2, l3, h0, h1, h2, h3; constexpr int b_ = v_rd_off(d0, 0, 0); \
        TRRD(l0, b_); TRRD(h0, b_ + 2048); TRRD(l1, b_ + 4096); TRRD(h1, b_ + 6144); TRRD(l2, b_ + 8192); TRRD(h2, b_ + 10240); TRRD(l3, b_ + 12288); TRRD(h3, b_ + 14336); \
        asm volatile("s_waitcnt lgkmcnt(0)" ::: "memory"); SBAR(); \
        o[d0] = __builtin_amdgcn_mfma_f32_32x32x16_bf16(pa0, (bf16x8){l0[0], l0[1], l0[2], l0[3], h0[0], h0[1], h0[2], h0[3]}, o[d0], 0, 0, 0); \
        o[d0] = __builtin_amdgcn_mfma_f32_32x32x16_bf16(pa1, (bf16x8){l1[0], l1[1], l1[2], l1[3], h1[0], h1[1], h1[2], h1[3]}, o[d0], 0, 0, 0); \
        o[d0] = __builtin_amdgcn_mfma_f32_32x32x16_bf16(pa2, (bf16x8){l2[0], l2[1], l2[2], l2[3], h2[0], h2[1], h2[2], h2[3]}, o[d0], 0, 0, 0); \
        o[d0] = __builtin_amdgcn_mfma_f32_32x32x16_bf16(pa3, (bf16x8){l3[0], l3[1], l3[2], l3[3], h3[0], h3[1], h3[2], h3[3]}, o[d0], 0, 0, 0); } while (0)
    PV_D0(0); PV_D0(1); PV_D0(2); PV_D0(3);
#undef PV_D0
#undef TRRD
}

template <bool IMP>
__device__ __forceinline__ void attn_tiles(LAS unsigned char* lds, const bf16x8 (&qr)[8], const bf16* Kp, const bf16* Vp, const int kvs,
                                           unsigned long long tilemask, const int pos, const int wlo, const int whi, const unsigned W,
                                           const unsigned long long rowmask, const int shift,
                                           f32x16 (&o)[4], float& m_reg, float& l_reg, float (&imp)[32]) {
    const int tid = otid(), wid = __builtin_amdgcn_readfirstlane(tid >> 6), lane = tid & 63, r32 = lane & 31, hi = lane >> 5;
    LAS unsigned char* V_lds = lds + OFF_V; LAS unsigned char* K_lds = lds + OFF_K;
    LAS float* al_l = (LAS float*)(lds + OFF_WS) + wid * 64 + 32;
    const int sr = tid >> 4, sc = (tid & 15) * 8;
    const int vst0 = v_st(sr, sc), vst1 = v_st(32 + sr, sc), kws = KSWZ(sr, sc * 2);
    const int vb0 = (int)(uintptr_t)V_lds + v_rd_base(lane);
    const int qm = pos - 4 * hi;
    constexpr float C2 = 1.4426950408889634f * SCALE;
    bf16x8 st_k0, st_k1, st_v0, st_v1;
#define A_LOAD(j_) do { const size_t r0_ = (size_t)((j_) * 64 + sr) * kvs + sc, r1_ = r0_ + (size_t)32 * kvs; \
        st_v0 = *(const bf16x8*)(Vp + r0_); st_v1 = *(const bf16x8*)(Vp + r1_); st_k0 = *(const bf16x8*)(Kp + r0_); st_k1 = *(const bf16x8*)(Kp + r1_); } while (0)
#define A_WRITE(bf_) do { *(LAS bf16x8*)(K_lds + (bf_) * SHM_K + kws) = st_k0; *(LAS bf16x8*)(K_lds + (bf_) * SHM_K + kws + 32 * 256) = st_k1; \
        *(LAS bf16x8*)(V_lds + (bf_) * SHM_V + vst0) = st_v0; *(LAS bf16x8*)(V_lds + (bf_) * SHM_V + vst1) = st_v1; } while (0)
    if (tilemask == 0ull) return;
    int j = __ffsll((long long)tilemask) - 1; tilemask &= tilemask - 1;
    A_LOAD(j); A_WRITE(0);
    LDSBAR();
    int jn = -1;
    if (tilemask) { jn = __ffsll((long long)tilemask) - 1; tilemask &= tilemask - 1; A_LOAD(jn); }
    int buf = 0; float carry = 0.f;
    for (;;) {
        const int kb = j * 64;
        const bool act = (kb <= whi) && ((long long)kb + 63 + (long long)W > (long long)wlo);
        if (act) {
            f32x16 p0, p1;
            SBAR(); qkt(p0, p1, K_lds + buf * SHM_K, r32, hi, qr); SBAR();
            const bool needm = (kb + 63 > wlo) || ((long long)kb + (long long)W <= (long long)whi);
            if (needm) { asm volatile("; boundary tile" ::: "memory"); mask_tile(p0, p1, qm - kb, W); }
            const bool rowsel = ((rowmask >> (kb >> shift)) & 1ull) != 0ull;
            if (!__all(rowsel)) { asm volatile("; row-select mask" ::: "memory"); const float NEG = -__builtin_inff();
#pragma unroll
                for (int r = 0; r < 16; ++r) { p0[r] = rowsel ? p0[r] : NEG; p1[r] = rowsel ? p1[r] : NEG; } }
            float pmax;
            { float m0 = fmaxf(fmaxf(p0[0], p0[1]), p0[2]), m1 = fmaxf(fmaxf(p0[3], p0[4]), p0[5]), m2 = fmaxf(fmaxf(p0[6], p0[7]), p0[8]), m3 = fmaxf(fmaxf(p0[9], p0[10]), p0[11]);
              float m4 = fmaxf(fmaxf(p0[12], p0[13]), p0[14]), m5 = fmaxf(fmaxf(p0[15], p1[0]), p1[1]), m6 = fmaxf(fmaxf(p1[2], p1[3]), p1[4]), m7 = fmaxf(fmaxf(p1[5], p1[6]), p1[7]);
              float m8 = fmaxf(fmaxf(p1[8], p1[9]), p1[10]), m9 = fmaxf(fmaxf(p1[11], p1[12]), p1[13]), ma = fmaxf(p1[14], p1[15]);
              m0 = fmaxf(fmaxf(m0, m1), m2); m3 = fmaxf(fmaxf(m3, m4), m5); m6 = fmaxf(fmaxf(m6, m7), m8); m9 = fmaxf(m9, ma);
              pmax = fmaxf(fmaxf(m0, m3), fmaxf(m6, m9)); }
            { auto rr = __builtin_amdgcn_permlane32_swap(__float_as_uint(pmax), __float_as_uint(pmax), false, false);
              pmax = fmaxf(__uint_as_float(rr[0]), __uint_as_float(rr[1])); }
            float mn, alpha;
            if (__all((pmax - m_reg) * SCALE <= THR)) { mn = m_reg; alpha = 1.f; }
            else { mn = fmaxf(m_reg, pmax); alpha = __builtin_amdgcn_exp2f((m_reg - mn) * C2); m_reg = mn; }
            const float mnL = -mn * C2;
#pragma unroll
            for (int r = 0; r < 16; ++r) { p0[r] = __builtin_amdgcn_exp2f(fmaf(p0[r], C2, mnL)); p1[r] = __builtin_amdgcn_exp2f(fmaf(p1[r], C2, mnL)); }
            float ps;
            { float s0 = (p0[0] + p0[1]) + (p0[2] + p0[3]), s1 = (p0[4] + p0[5]) + (p0[6] + p0[7]), s2 = (p0[8] + p0[9]) + (p0[10] + p0[11]), s3 = (p0[12] + p0[13]) + (p0[14] + p0[15]);
              float s4 = (p1[0] + p1[1]) + (p1[2] + p1[3]), s5_ = (p1[4] + p1[5]) + (p1[6] + p1[7]), s6 = (p1[8] + p1[9]) + (p1[10] + p1[11]), s7 = (p1[12] + p1[13]) + (p1[14] + p1[15]);
              ps = ((s0 + s1) + (s2 + s3)) + ((s4 + s5_) + (s6 + s7)); }
            { auto rr = __builtin_amdgcn_permlane32_swap(__float_as_uint(ps), __float_as_uint(ps), false, false);
              ps = __uint_as_float(rr[0]) + __uint_as_float(rr[1]); }
            l_reg = l_reg * alpha + ps;
            if (__any(alpha < 1.f)) {
                asm volatile("; rescale" ::: "memory");
                if (hi == 0) al_l[r32] = alpha;
                asm volatile("s_waitcnt lgkmcnt(0)" ::: "memory");
#pragma unroll
                for (int r = 0; r < 16; ++r) { const float a = al_l[crow(r, hi)];
#pragma unroll
                    for (int d_ = 0; d_ < 4; ++d_) o[d_][r] *= a; }
            }
            if constexpr (IMP) {
                float e3[4], f3[4], s0[4], s1[4];
#pragma unroll
                for (int q = 0; q < 4; ++q) { e3[q] = __shfl_xor(p0[4 * q + 3], 32); f3[q] = __shfl_xor(p1[4 * q + 3], 32);
                    s0[q] = (p0[4 * q] + p0[4 * q + 1]) + (p0[4 * q + 2] + p0[4 * q + 3]); s1[q] = (p1[4 * q] + p1[4 * q + 1]) + (p1[4 * q + 2] + p1[4 * q + 3]); }
                carry *= alpha;
#pragma unroll
                for (int q = 0; q < 4; ++q) {
                    s0[q] += hi ? e3[q] : (q > 0 ? e3[q > 0 ? q - 1 : 0] : carry);
                    s1[q] += hi ? f3[q] : (q > 0 ? f3[q > 0 ? q - 1 : 0] : e3[3]);
                }
                carry = f3[3];
#pragma unroll
                for (int i = 0; i < 32; ++i) imp[i] *= alpha;
#pragma unroll
                for (int tt = 0; tt < 4; ++tt) if (j == tt) {
#pragma unroll
                    for (int q = 0; q < 4; ++q) { imp[(tt * 2 + 0) * 4 + q] += s0[q]; imp[(tt * 2 + 1) * 4 + q] += s1[q]; } }
            }
            bf16x8 pa0, pa1, pa2, pa3;
#define PK4(P_, B_, OUT) do { const unsigned a0 = cvtpk(P_[B_ + 0], P_[B_ + 1]), a1 = cvtpk(P_[B_ + 2], P_[B_ + 3]); \
        const unsigned b0 = cvtpk(P_[B_ + 4], P_[B_ + 5]), b1 = cvtpk(P_[B_ + 6], P_[B_ + 7]); \
        auto r0 = __builtin_amdgcn_permlane32_swap(a0, b0, false, false); auto r1 = __builtin_amdgcn_permlane32_swap(a1, b1, false, false); \
        u32x4 w = {r0[0], r1[0], r0[1], r1[1]}; OUT = *reinterpret_cast<bf16x8*>(&w); } while (0)
            PK4(p0, 0, pa0); PK4(p0, 8, pa1); PK4(p1, 0, pa2); PK4(p1, 8, pa3);
#undef PK4
            SBAR();
            pv_tile(o, vb0 + buf * SHM_V, pa0, pa1, pa2, pa3);
        } else if (IMP) carry = 0.f;
        if (jn < 0) break;
        A_WRITE(buf ^ 1);
        LDSBAR();
        j = jn; buf ^= 1;
        if (tilemask) { jn = __ffsll((long long)tilemask) - 1; tilemask &= tilemask - 1; A_LOAD(jn); } else jn = -1;
    }
    LDSBAR();
#undef A_LOAD
#undef A_WRITE
}

template <int BR>
__device__ __forceinline__ void nsa_epi(const f32x16 (&o)[4], const float il, LAS float* li_l, float* accb, const float* gt, int r32, int hi, bf16* mixed, const bf16* zb) {
    asm volatile("" : "+v"(r32), "+v"(hi));
    if (hi == 0) li_l[r32] = il;
    asm volatile("s_waitcnt lgkmcnt(0)" ::: "memory");
#pragma unroll
    for (int rh = 0; rh < 2; ++rh) {
        float sv[8], av[8][4], zv[8][4];
#pragma unroll
        for (int q = 0; q < 8; ++q) { const int r = rh * 8 + q, rw = crow(r, hi);
            sv[q] = li_l[rw] * gt[rw * 12 + BR];
#pragma unroll
            for (int d0 = 0; d0 < 4; ++d0) { const int col = d0 * 32 + r32;
                if (BR >= 1) av[q][d0] = accb[rw * 128 + col];
                if (BR == 2) zv[q][d0] = bf2f(zb[(size_t)rw * NP + col]); } }
#pragma unroll
        for (int q = 0; q < 8; ++q) { const int r = rh * 8 + q, rw = crow(r, hi);
#pragma unroll
            for (int d0 = 0; d0 < 4; ++d0) { const int col = d0 * 32 + r32;
                if (BR == 0) accb[rw * 128 + col] = o[d0][r] * sv[q];
                else if (BR == 1) accb[rw * 128 + col] = av[q][d0] + o[d0][r] * sv[q];
                else { const float v = (av[q][d0] + o[d0][r] * sv[q]) * siluf_(zv[q][d0]);
                    const float vn = __shfl_xor(v, 1);
                    if ((r32 & 1) == 0) *(unsigned*)(mixed + (size_t)rw * DM + col) = cvtpk(v, vn); } } }
        asm volatile("" ::: "memory");
    }
}

__device__ __forceinline__ void nsa_unit(const Params& P, LAS unsigned char* lds, const int b, const int c) {
    const int tid = otid(), wid = __builtin_amdgcn_readfirstlane(tid >> 6), lane = tid & 63, r32 = lane & 31, hi = lane >> 5;
    const int head = wid >> 1, half = wid & 1;
    const int t_base = c * 64, trow = t_base + half * 32, pos = trow + r32;
    const bf16* proj = (const bf16*)(P.ws + WS_PROJ);
    const bf16* pb = proj + (size_t)b * SEQ * NP;
    const bf16* prow = pb + (size_t)pos * NP;
    bf16x8 qr[8];
#pragma unroll
    for (int d0 = 0; d0 < 8; ++d0) qr[d0] = *(const bf16x8*)(prow + O_NQ + head * 128 + d0 * 16 + hi * 8);
    LAS float* li_l = (LAS float*)(lds + OFF_WS) + wid * 64;
    float* accb = P.out + ((size_t)blockIdx.x * 256 + wid * 32) * 128;
    const float* gt = (const float*)(P.ws + WS_GATES) + (size_t)(b * SEQ + trow) * 12 + head * 3;
    const bf16* cmpk = (const bf16*)(P.ws + WS_CMPB) + (size_t)(0 * NB + b) * 256 * 128;
    const bf16* cmpv = (const bf16*)(P.ws + WS_CMPB) + (size_t)(1 * NB + b) * 256 * 128;
    f32x16 o[4]; float m_reg, l_reg;
    float dummy[32];
    {
        float imp[32];
#pragma unroll
        for (int i = 0; i < 32; ++i) imp[i] = 0.f;
#pragma unroll
        for (int d = 0; d < 4; ++d) o[d] = f32x16{};
        m_reg = -1e30f; l_reg = 0.f;
        const int posc = (pos - 31) >> 4, wloc = (trow - 31) >> 4, whic = trow >> 4;
        const int maxc = (t_base + 32) >> 4;
        const int ntile = (maxc >> 6) + 1;
        attn_tiles<true>(lds, qr, cmpk, cmpv, 128, (1ull << ntile) - 1ull, posc, wloc, whic, WINF, ~0ull, 12, o, m_reg, l_reg, imp);
        const float il = l_reg > 0.f ? 1.f / l_reg : 0.f;
        nsa_epi<0>(o, il, li_l, accb, gt, r32, hi, nullptr, nullptr);
        LAS float* impH = (LAS float*)lds;
        LAS float* ih = impH + ((head * 64 + half * 32 + r32) * 64);
#pragma unroll
        for (int tt = 0; tt < 4; ++tt)
#pragma unroll
            for (int hh = 0; hh < 2; ++hh)
#pragma unroll
                for (int q = 0; q < 4; ++q) ih[tt * 16 + hh * 8 + 2 * q + hi] = imp[(tt * 2 + hh) * 4 + q] * il;
    }
    LDSBAR();
    LAS float* score = (LAS float*)(lds + OFF_X);
    LAS unsigned char* selb = lds + OFF_X + 64 * 65 * 4;
    LAS unsigned* un = (LAS unsigned*)(lds + OFF_X + 64 * 65 * 4 + 512);
    {
        const int row = tid >> 3, part = tid & 7;
        const LAS float* impH = (const LAS float*)lds;
#pragma unroll
        for (int e = 0; e < 8; ++e) { const int jj = part * 8 + e;
            float s = (impH[(0 * 64 + row) * 64 + jj] + impH[(1 * 64 + row) * 64 + jj]) + (impH[(2 * 64 + row) * 64 + jj] + impH[(3 * 64 + row) * 64 + jj]);
            if (jj > c) s = -__builtin_inff();
            if (jj == 0 || jj == c || jj == c - 1) s = __builtin_inff();
            score[row * 65 + jj] = s; }
        if (tid < 2) un[tid] = 0u;
        LDSBAR();
        float sv[64];
#pragma unroll
        for (int j2 = 0; j2 < 64; ++j2) sv[j2] = score[row * 65 + j2];
        unsigned byte = 0u;
#pragma unroll
        for (int e = 0; e < 8; ++e) { const int jj = part * 8 + e; const float sj = score[row * 65 + jj]; int rank = 0;
#pragma unroll
            for (int j2 = 0; j2 < 64; ++j2) rank += (sv[j2] > sj || (sv[j2] == sj && j2 < jj)) ? 1 : 0;
            if (rank < 16 && jj <= c) byte |= 1u << e; }
        selb[row * 8 + part] = (unsigned char)byte;
        __hip_atomic_fetch_or(&un[part >> 2], byte << (8 * (part & 3)), __ATOMIC_RELAXED, __HIP_MEMORY_SCOPE_WORKGROUP);
    }
    LDSBAR();
    const unsigned long long rowmask = *(const LAS unsigned long long*)(selb + (half * 32 + r32) * 8);
    const unsigned long long selt = (unsigned long long)un[0] | ((unsigned long long)un[1] << 32);
    {
#pragma unroll
        for (int d = 0; d < 4; ++d) o[d] = f32x16{};
        m_reg = -1e30f; l_reg = 0.f;
        attn_tiles<false>(lds, qr, pb + O_KS, pb + O_VS, NP, selt, pos, trow, trow + 31, WINF, rowmask, 6, o, m_reg, l_reg, dummy);
        nsa_epi<1>(o, 1.f / l_reg, li_l, accb, gt, r32, hi, nullptr, nullptr);
    }
    {
#pragma unroll
        for (int d = 0; d < 4; ++d) o[d] = f32x16{};
        m_reg = -1e30f; l_reg = 0.f;
        const int lo = c > 8 ? c - 8 : 0;
        const unsigned long long upto = (c == 63) ? ~0ull : ((1ull << (c + 1)) - 1ull);
        const unsigned long long wt = upto & ~((1ull << lo) - 1ull);
        attn_tiles<false>(lds, qr, pb + O_KW, pb + O_VW, NP, wt, pos, trow, trow + 31, 512u, ~0ull, 12, o, m_reg, l_reg, dummy);
        bf16* mixed = (bf16*)(P.ws + WS_MIXED) + (size_t)(b * SEQ + trow) * DM + 512 + head * 128;
        const bf16* zb = pb + (size_t)trow * NP + O_NZ + head * 128;
        nsa_epi<2>(o, 1.f / l_reg, li_l, accb, gt, r32, hi, mixed, zb);
    }
}

__device__ __forceinline__ void moba_unit(const Params& P, LAS unsigned char* lds, const int b, const int h, const int own) {
    const int tid = otid(), wid = __builtin_amdgcn_readfirstlane(tid >> 6), lane = tid & 63, r32 = lane & 31, hi = lane >> 5;
    const int trow = own * 256 + wid * 32, pos = trow + r32;
    const bf16* proj = (const bf16*)(P.ws + WS_PROJ);
    const bf16* pb = proj + (size_t)b * SEQ * NP;
    const bf16* prow = pb + (size_t)pos * NP;
    bf16x8 qr[8];
#pragma unroll
    for (int d0 = 0; d0 < 8; ++d0) qr[d0] = *(const bf16x8*)(prow + O_MQ + h * 128 + d0 * 16 + hi * 8);
    LAS float* li_l = (LAS float*)(lds + OFF_WS) + wid * 64;
    LAS float* kml = (LAS float*)(lds + OFF_X);
    LAS unsigned* un = (LAS unsigned*)(lds + OFF_X + 8192);
    {
        const f32x4* src = (const f32x4*)((const float*)(P.ws + WS_KMEAN) + (size_t)(b * 4 + h) * 16 * 128);
        ((LAS f32x4*)kml)[tid] = src[tid];
        if (tid == 0) un[0] = 0u;
    }
    LDSBAR();
    float g[15];
#pragma unroll
    for (int n = 0; n < 15; ++n) g[n] = 0.f;
#pragma unroll
    for (int d0 = 0; d0 < 8; ++d0) {
        float qf[8];
#pragma unroll
        for (int e = 0; e < 8; ++e) qf[e] = bf2f((bf16)qr[d0][e]);
#pragma unroll
        for (int n = 0; n < 15; ++n) if (n < own) {
            const f32x4 k0 = *(const LAS f32x4*)(kml + n * 128 + d0 * 16 + hi * 8), k1 = *(const LAS f32x4*)(kml + n * 128 + d0 * 16 + hi * 8 + 4);
            g[n] += (qf[0] * k0[0] + qf[1] * k0[1]) + (qf[2] * k0[2] + qf[3] * k0[3]) + (qf[4] * k1[0] + qf[5] * k1[1]) + (qf[6] * k1[2] + qf[7] * k1[3]);
        }
    }
#pragma unroll
    for (int n = 0; n < 15; ++n) { g[n] += __shfl_xor(g[n], 32); if (n >= own) g[n] = -__builtin_inff(); }
    unsigned sel = 1u << own;
#pragma unroll
    for (int n = 0; n < 15; ++n) { int rank = 0;
#pragma unroll
        for (int n2 = 0; n2 < 15; ++n2) rank += (g[n2] > g[n] || (g[n2] == g[n] && n2 < n)) ? 1 : 0;
        if (n < own && rank < 3) sel |= 1u << n; }
    __hip_atomic_fetch_or(&un[0], sel, __ATOMIC_RELAXED, __HIP_MEMORY_SCOPE_WORKGROUP);
    LDSBAR();
    const unsigned blocks = un[0];
    unsigned long long tmask = 0ull;
#pragma unroll
    for (int n = 0; n < 16; ++n) if ((blocks >> n) & 1u) tmask |= 0xFull << (4 * n);
    f32x16 o[4]; float m_reg = -1e30f, l_reg = 0.f; float dummy[32];
#pragma unroll
    for (int d = 0; d < 4; ++d) o[d] = f32x16{};
    attn_tiles<false>(lds, qr, pb + O_MK + h * 128, pb + O_MV + h * 128, NP, tmask, pos, trow, trow + 31, WINF, (unsigned long long)sel, 8, o, m_reg, l_reg, dummy);
    const float il = 1.f / l_reg;
    if (hi == 0) li_l[r32] = il;
    asm volatile("s_waitcnt lgkmcnt(0)" ::: "memory");
    bf16* mixed = (bf16*)(P.ws + WS_MIXED) + (size_t)(b * SEQ + trow) * DM + h * 128;
    const bf16* zb = pb + (size_t)trow * NP + O_MZ + h * 128;
#pragma unroll
    for (int rh = 0; rh < 2; ++rh) {
        float zv[8][4];
#pragma unroll
        for (int q = 0; q < 8; ++q) { const int rw = crow(rh * 8 + q, hi);
#pragma unroll
            for (int d0 = 0; d0 < 4; ++d0) zv[q][d0] = bf2f(zb[(size_t)rw * NP + d0 * 32 + r32]); }
#pragma unroll
        for (int q = 0; q < 8; ++q) { const int r = rh * 8 + q, rw = crow(r, hi); const float s = li_l[rw];
#pragma unroll
            for (int d0 = 0; d0 < 4; ++d0) { const int col = d0 * 32 + r32;
                const float v = o[d0][r] * s * siluf_(zv[q][d0]);
                const float vn = __shfl_xor(v, 1);
                if ((r32 & 1) == 0) *(unsigned*)(mixed + (size_t)rw * DM + col) = cvtpk(v, vn); } }
        asm volatile("" ::: "memory");
    }
}
#undef KSWZ
#undef SBAR
#undef LDSBAR
}

namespace s5 {
typedef float f32x16 __attribute__((ext_vector_type(16)));
typedef float f32x2 __attribute__((ext_vector_type(2)));
constexpr int KT_ELEMS = 65 * 256, KT_BYTES = KT_ELEMS * 2, PF_ELEMS = 131072;
constexpr int UCOL = 2064, XCOL = 272, SROW = 129;
constexpr int L_U = 0, L_KT = 32 * UCOL, L_S = L_KT + KT_BYTES, L_XB = L_S + 32 * SROW * 4, L_CARRY = L_XB + 32 * XCOL, L_END = L_CARRY + 512;
static_assert(L_END <= 147456 && (L_KT % 16) == 0 && (L_S % 16) == 0 && (L_XB % 16) == 0, "s5 lds map");

__device__ __forceinline__ void tables_task(const Params& P, LAS unsigned char* lds, const int l, const int g, const int part) {
    const int tid = otid();
    LAS f32x2* pw = (LAS f32x2*)lds;
    LAS f32x2* fz = (LAS f32x2*)(lds + 65 * 64 * 8);
    __syncthreads();
    if (tid < 64) {
        const int p = tid;
        const double dt = exp((double)P.in[23][l * 64 + g]);
        const double ar = P.in[16][l * 4096 + g * 64 + p], ai = P.in[17][l * 4096 + g * 64 + p];
        const double mag = exp(dt * ar);
        double sn, cs; dsincos(dt * ai, sn, cs);
        const double abr = mag * cs, abi = mag * sn;
        const double nr = abr - 1.0, ni = abi, den = ar * ar + ai * ai;
        fz[p] = (f32x2){(float)((nr * ar + ni * ai) / den), (float)((ni * ar - nr * ai) / den)};
        double pr = 1.0, pi = 0.0;
        for (int n = 0; n <= 64; ++n) { pw[n * 64 + p] = (f32x2){(float)pr, (float)pi}; const double t = pr * abr - pi * abi; pi = pr * abi + pi * abr; pr = t; }
        if (part == 0) ((f32x2*)(P.ws + WS_S5AL))[(l * 64 + g) * 64 + p] = pw[64 * 64 + p];
    }
    __syncthreads();
    LAS float* bre = (LAS float*)(lds + 65 * 64 * 8 + 512);
    LAS float* bim = bre + 1024;
    LAS float* cre = bim + 1024;
    LAS float* cim = cre + 1024;
    { const float* gb = P.in[18] + (size_t)l * 65536 + g * 1024; const float* gbi = P.in[19] + (size_t)l * 65536 + g * 1024;
      const float* gc = P.in[20] + (size_t)l * 65536 + g * 1024; const float* gci = P.in[21] + (size_t)l * 65536 + g * 1024;
      for (int i = tid; i < 1024; i += 512) { bre[i] = gb[i]; bim[i] = gbi[i]; cre[i] = gc[i]; cim[i] = gci[i]; } }
    __syncthreads();
    bf16* P1 = (bf16*)(P.ws + WS_S5P1) + (size_t)(l * 64 + g) * PF_ELEMS;
    bf16* P2 = (bf16*)(P.ws + WS_S5P2) + (size_t)(l * 64 + g) * PF_ELEMS;
    bf16* KT = (bf16*)(P.ws + WS_S5K) + (size_t)(l * 64 + g) * KT_ELEMS;
    if (part == 0) for (int fl = tid; fl < 16384; fl += 512) {
        const int lane = fl & 63, ks = (fl >> 6) & 63, mb = fl >> 12;
        const int row = 32 * mb + (lane & 31), p = row & 63, isim = row >> 6, c0 = 8 * (lane >> 5);
        const f32x2 w = pw[(63 - ks) * 64 + p], f = fz[p];
        const float zr = w.x * f.x - w.y * f.y, zi = w.x * f.y + w.y * f.x;
        float v[8];
#pragma unroll
        for (int j = 0; j < 8; ++j) { const float br = bre[p * 16 + c0 + j], bi = bim[p * 16 + c0 + j]; v[j] = isim ? (zr * bi + zi * br) : (zr * br - zi * bi); }
        u32x4 o; o.x = pg8::cvt_pk_bf16(v[0], v[1]); o.y = pg8::cvt_pk_bf16(v[2], v[3]); o.z = pg8::cvt_pk_bf16(v[4], v[5]); o.w = pg8::cvt_pk_bf16(v[6], v[7]);
        *(u32x4*)(P1 + (size_t)fl * 8) = o;
    }
    if (part == 1) for (int fl = tid; fl < 16384; fl += 512) {
        const int lane = fl & 63, ks = (fl >> 6) & 7, rb = fl >> 9;
        const int r = lane & 31, t = 2 * rb + (r >> 4), c = r & 15, kk0 = 16 * ks + 8 * (lane >> 5);
        float v[8];
#pragma unroll
        for (int j = 0; j < 8; ++j) { const int kk = kk0 + j, p = kk & 63; const f32x2 w = pw[(t + 1) * 64 + p];
            const float cr = cre[c * 64 + p], ci = cim[c * 64 + p];
            v[j] = (kk >> 6) ? -(cr * w.y + ci * w.x) : (cr * w.x - ci * w.y); }
        u32x4 o; o.x = pg8::cvt_pk_bf16(v[0], v[1]); o.y = pg8::cvt_pk_bf16(v[2], v[3]); o.z = pg8::cvt_pk_bf16(v[4], v[5]); o.w = pg8::cvt_pk_bf16(v[6], v[7]);
        *(u32x4*)(P2 + (size_t)fl * 8) = o;
    }
    if (part >= 2) for (int pr_ = (part - 2) * 512 + tid; pr_ < (part - 1) * 512; pr_ += 512) {
        const int tau = pr_ >> 4, c = pr_ & 15;
        float acc[16];
#pragma unroll
        for (int j = 0; j < 16; ++j) acc[j] = 0.f;
        for (int p = 0; p < 64; ++p) {
            const f32x2 w = pw[tau * 64 + p], f = fz[p];
            const float zr = w.x * f.x - w.y * f.y, zi = w.x * f.y + w.y * f.x;
            const float cr = cre[c * 64 + p], ci = cim[c * 64 + p];
            const float czr = cr * zr - ci * zi, czi = cr * zi + ci * zr;
#pragma unroll
            for (int q = 0; q < 4; ++q) { const f32x4 br4 = *(const LAS f32x4*)(bre + p * 16 + 4 * q), bi4 = *(const LAS f32x4*)(bim + p * 16 + 4 * q);
#pragma unroll
                for (int e = 0; e < 4; ++e) acc[4 * q + e] += czr * br4[e] - czi * bi4[e]; }
        }
        u32x4 o0, o1; o0.x = pg8::cvt_pk_bf16(acc[0], acc[1]); o0.y = pg8::cvt_pk_bf16(acc[2], acc[3]); o0.z = pg8::cvt_pk_bf16(acc[4], acc[5]); o0.w = pg8::cvt_pk_bf16(acc[6], acc[7]);
        o1.x = pg8::cvt_pk_bf16(acc[8], acc[9]); o1.y = pg8::cvt_pk_bf16(acc[10], acc[11]); o1.z = pg8::cvt_pk_bf16(acc[12], acc[13]); o1.w = pg8::cvt_pk_bf16(acc[14], acc[15]);
        u32x4* dst = (u32x4*)(KT + (size_t)(tau + 1) * 256 + c * 16); dst[0] = o0; dst[1] = o1;
    }
    if (part == 2 && tid < 32) ((u32x4*)KT)[tid] = (u32x4){0u, 0u, 0u, 0u};
}

__device__ __forceinline__ void unit(const Params& P, LAS unsigned char* lds, const int l, const int b, const int g) {
    const int tid = otid(), wid = __builtin_amdgcn_readfirstlane(tid >> 6), lane = tid & 63, n32 = lane & 31, hi = lane >> 5;
    const bf16* KT = (const bf16*)(P.ws + WS_S5K) + (size_t)(l * 64 + g) * KT_ELEMS;
    const bf16x8* P1 = (const bf16x8*)((const bf16*)(P.ws + WS_S5P1) + (size_t)(l * 64 + g) * PF_ELEMS);
    const bf16x8* P2 = (const bf16x8*)((const bf16*)(P.ws + WS_S5P2) + (size_t)(l * 64 + g) * PF_ELEMS);
    const f32x2* AL = (const f32x2*)(P.ws + WS_S5AL) + (l * 64 + g) * 64;
    const bf16* ub = (const bf16*)(P.out + SUG_OFF) + (size_t)(b * 64 + g) * SEQ * 16;
    bf16* yb = (bf16*)(P.ws + WS_Y5) + (size_t)b * SEQ * 1024 + g * 16;
    const float* dsk = P.in[22] + l * 1024 + g * 16;
    LAS float* Sl = (LAS float*)(lds + L_S);
    LAS float* car = (LAS float*)(lds + L_CARRY);
    __syncthreads();
    { u32x4 kt[5];
#pragma unroll
      for (int it = 0; it < 5; ++it) { const int i = tid + 512 * it; if (i < KT_BYTES / 16) kt[it] = ((const u32x4*)KT)[i]; }
      __builtin_amdgcn_sched_barrier(0);
#pragma unroll
      for (int it = 0; it < 5; ++it) { const int i = tid + 512 * it; if (i < KT_BYTES / 16) ((LAS u32x4*)(lds + L_KT))[i] = kt[it]; } }
    const f32x4 dvA = *(const f32x4*)(dsk + 4 * hi), dvB = *(const f32x4*)(dsk + 8 + 4 * hi);
    if (tid < 128) car[tid] = 0.f;
    u32x4 ua0[4], ua1[4];
#define S5_LOADU(hh_) do { _Pragma("unroll") for (int it = 0; it < 4; ++it) { const int rr = tid + 512 * it, n = rr >> 6, s = rr & 63; \
        const u32x4* src = (const u32x4*)(ub + (size_t)((32 * (hh_) + n) * 64 + s) * 16); ua0[it] = src[0]; ua1[it] = src[1]; } } while (0)
    S5_LOADU(0);
    for (int hh = 0; hh < 2; ++hh) {
        __builtin_amdgcn_sched_barrier(0);
#pragma unroll
        for (int it = 0; it < 4; ++it) { const int rr = tid + 512 * it, n = rr >> 6, s = rr & 63;
            *(LAS u32x4*)(lds + L_U + n * UCOL + s * 32) = ua0[it]; *(LAS u32x4*)(lds + L_U + n * UCOL + s * 32 + 16) = ua1[it]; }
        __syncthreads();
        {
            const int mb = wid & 3, kh = wid >> 2;
            f32x16 acc0 = f32x16{}, acc1 = f32x16{};
            const bf16x8* pa = P1 + (size_t)(mb * 64 + kh * 32) * 64 + lane;
            LAS const unsigned char* ua = lds + L_U + n32 * UCOL + hi * 16 + kh * 32 * 32;
#pragma unroll 1
            for (int kb = 0; kb < 4; ++kb) {
                const bf16x8* qa = pa + 4 * 64;
                bf16x8 fa[8];
#pragma unroll
                for (int i = 0; i < 4; ++i) { fa[i] = pa[i * 64]; fa[4 + i] = qa[i * 64]; }
                __builtin_amdgcn_sched_barrier(0);
#pragma unroll
                for (int i = 0; i < 8; i += 2) {
                    acc0 = __builtin_amdgcn_mfma_f32_32x32x16_bf16(fa[i], *(LAS const bf16x8*)(ua + i * 32), acc0, 0, 0, 0);
                    acc1 = __builtin_amdgcn_mfma_f32_32x32x16_bf16(fa[i + 1], *(LAS const bf16x8*)(ua + (i + 1) * 32), acc1, 0, 0, 0); }
                __builtin_amdgcn_sched_barrier(0);
                pa += 8 * 64; ua += 8 * 32;
            }
            acc0 += acc1;
            if (kh == 1) {
#pragma unroll
                for (int r = 0; r < 16; ++r) Sl[n32 * SROW + 32 * mb + (r & 3) + 8 * (r >> 2) + 4 * hi] = acc0[r];
            }
            __syncthreads();
            if (kh == 0) {
#pragma unroll
                for (int r = 0; r < 16; ++r) Sl[n32 * SROW + 32 * mb + (r & 3) + 8 * (r >> 2) + 4 * hi] += acc0[r];
            }
        }
        __syncthreads();
        if (tid < 64) {
            const int p = tid; const f32x2 al = AL[p];
            float xr = car[p], xi = car[64 + p];
            float sre[32], sim[32];
#pragma unroll
            for (int n = 0; n < 32; ++n) { sre[n] = Sl[n * SROW + p]; sim[n] = Sl[n * SROW + 64 + p]; }
#pragma unroll
            for (int n = 0; n < 32; ++n) {
                *(LAS bf16*)(lds + L_XB + n * XCOL + p * 2) = (bf16)f2bf(xr); *(LAS bf16*)(lds + L_XB + n * XCOL + (64 + p) * 2) = (bf16)f2bf(xi);
                const float nx = al.x * xr - al.y * xi + sre[n], ni = al.x * xi + al.y * xr + sim[n]; xr = nx; xi = ni; }
            car[p] = xr; car[64 + p] = xi;
        }
        __syncthreads();
        if (hh == 0) { S5_LOADU(1); __builtin_amdgcn_sched_barrier(0); }
        for (int q4 = 0; q4 < 4; ++q4) {
            const int rb = (q4 == 0) ? wid : (q4 == 1) ? 15 - wid : (q4 == 2) ? 16 + wid : 31 - wid;
            const int t0 = 2 * rb;
            f32x16 acc = f32x16{};
            bf16x8 pf[8];
            { const bf16x8* p2 = P2 + (size_t)(rb * 8) * 64 + lane;
#pragma unroll
              for (int ks = 0; ks < 8; ++ks) pf[ks] = p2[ks * 64]; }
            LAS const unsigned char* ka = lds + L_KT + (t0 + 1) * 512 + n32 * 32 + hi * 16;
            LAS const unsigned char* ua = lds + L_U + n32 * UCOL + hi * 16;
            f32x16 acc2 = f32x16{};
#pragma unroll 4
            for (int s0 = 0; s0 <= t0 + 1; s0 += 2) {
                acc = __builtin_amdgcn_mfma_f32_32x32x16_bf16(*(LAS const bf16x8*)(ka - s0 * 512), *(LAS const bf16x8*)(ua + s0 * 32), acc, 0, 0, 0);
                acc2 = __builtin_amdgcn_mfma_f32_32x32x16_bf16(*(LAS const bf16x8*)(ka - (s0 + 1) * 512), *(LAS const bf16x8*)(ua + (s0 + 1) * 32), acc2, 0, 0, 0); }
            LAS const unsigned char* xa = lds + L_XB + n32 * XCOL + hi * 16;
#pragma unroll
            for (int ks = 0; ks < 8; ks += 2) {
                acc = __builtin_amdgcn_mfma_f32_32x32x16_bf16(pf[ks], *(LAS const bf16x8*)(xa + ks * 32), acc, 0, 0, 0);
                acc2 = __builtin_amdgcn_mfma_f32_32x32x16_bf16(pf[ks + 1], *(LAS const bf16x8*)(xa + (ks + 1) * 32), acc2, 0, 0, 0); }
            acc += acc2;
#pragma unroll
            for (int r4 = 0; r4 < 4; ++r4) {
                const int t = t0 + (r4 >> 1), c0 = 8 * (r4 & 1) + 4 * hi;
                const u32x2 uw = *(LAS const u32x2*)(lds + L_U + n32 * UCOL + t * 32 + c0 * 2);
                const f32x4 dv = (r4 & 1) ? dvB : dvA;
                const float u0 = __uint_as_float(uw.x << 16), u1 = __uint_as_float(uw.x & 0xffff0000u), u2 = __uint_as_float(uw.y << 16), u3 = __uint_as_float(uw.y & 0xffff0000u);
                const float y0 = geluf_(acc[4 * r4 + 0] + dv[0] * u0), y1 = geluf_(acc[4 * r4 + 1] + dv[1] * u1);
                const float y2 = geluf_(acc[4 * r4 + 2] + dv[2] * u2), y3 = geluf_(acc[4 * r4 + 3] + dv[3] * u3);
                u32x2 w; w.x = pk2(y0, y1); w.y = pk2(y2, y3);
                *(u32x2*)(yb + (size_t)((32 * hh + n32) * 64 + t) * 1024 + c0) = w;
            }
        }
        asm volatile("s_waitcnt lgkmcnt(0)" ::: "memory"); __builtin_amdgcn_s_barrier(); asm volatile("" ::: "memory");
    }
#undef S5_LOADU
}
}

namespace a1 {
typedef float f32x16 __attribute__((ext_vector_type(16)));
__device__ __forceinline__ void norm_task(const Params& P, LAS unsigned char* lds, const int l, const int blk, const int vec) {
    const int tid = otid(), wid = __builtin_amdgcn_readfirstlane(tid >> 6), lane = tid & 63;
    int off; const float* nw;
    if (vec < 4) { off = O_MQ + vec * 128; nw = P.in[4]; }
    else if (vec < 8) { off = O_MK + (vec - 4) * 128; nw = P.in[5]; }
    else if (vec < 12) { off = O_NQ + (vec - 8) * 128; nw = P.in[6]; }
    else if (vec == 12) { off = O_KS; nw = P.in[8]; }
    else { off = O_KW; nw = P.in[9]; }
    nw += l * 128;
    const float2* cs = (const float2*)(P.ws + WS_ROPE);
    bf16* base = (bf16*)(P.ws + WS_PROJ) + (size_t)(blk * 256 + wid * 32) * NP + off;
    const int pos0 = (blk * 256 + wid * 32) % SEQ;
    const float wa = nw[lane], wb = nw[lane + 64];
    float sa = 0.f, sb = 0.f;
#pragma unroll 4
    for (int i = 0; i < 32; ++i) {
        bf16* v = base + (size_t)i * NP;
        float a = bf2f(v[lane]), b = bf2f(v[lane + 64]);
        const float ss = wave_sum(a * a + b * b);
        const float r = 1.0f / sqrtf(ss * (1.0f / 128.0f) + EPSN);
        a = a * r * wa; b = b * r * wb;
        const float other = __shfl_xor(a, 16);
        if (lane < 32) { const float2 c = cs[(pos0 + i) * 16 + (lane & 15)]; a = (lane < 16) ? (a * c.x - other * c.y) : (a * c.x + other * c.y); }
        v[lane] = (bf16)f2bf(a); v[lane + 64] = (bf16)f2bf(b);
        sa += a; sb += b;
    }
    if (vec >= 4 && vec < 8) {
        LAS float* red = (LAS float*)lds;
        red[wid * 128 + lane] = sa; red[wid * 128 + lane + 64] = sb;
        __syncthreads();
        if (tid < 128) { float s = 0.f;
#pragma unroll
            for (int w = 0; w < 8; ++w) s += red[w * 128 + tid];
            const int b = blk >> 4, n = blk & 15, h = vec - 4;
            ((float*)(P.ws + WS_KMEAN))[((size_t)(b * 4 + h) * 16 + n) * 128 + tid] = s * (1.0f / 256.0f); }
    }
}
__device__ __forceinline__ void gates_task(const Params& P, LAS unsigned char* lds, const int l, const int task) {
    const int tid = otid(), wid = __builtin_amdgcn_readfirstlane(tid >> 6), lane = tid & 63, r32 = lane & 31, hi = lane >> 5;
    const bf16* xb = (const bf16*)(P.ws + WS_XB) + (size_t)(task * 64 + r32) * DM + wid * 256 + 8 * hi;
    const bf16x8* wf = (const bf16x8*)(P.ws + WS_WGF) + ((size_t)l * 128 + wid * 16) * 64 + lane;
    f32x16 acc0 = f32x16{}, acc1 = f32x16{};
#pragma unroll 1
    for (int kb = 0; kb < 2; ++kb) {
        bf16x8 a0[8], a1[8], bw[8];
        const bf16* xq = xb + (size_t)32 * DM;
#pragma unroll
        for (int k = 0; k < 8; ++k) { a0[k] = *(const bf16x8*)(xb + 16 * k); a1[k] = *(const bf16x8*)(xq + 16 * k); bw[k] = wf[k * 64]; }
        __builtin_amdgcn_sched_barrier(0);
#pragma unroll
        for (int k = 0; k < 8; ++k) { acc0 = __builtin_amdgcn_mfma_f32_32x32x16_bf16(a0[k], bw[k], acc0, 0, 0, 0); acc1 = __builtin_amdgcn_mfma_f32_32x32x16_bf16(a1[k], bw[k], acc1, 0, 0, 0); }
        __builtin_amdgcn_sched_barrier(0);
        xb += 128; wf += 8 * 64;
    }
    LAS float* red = (LAS float*)lds;
    LAS float* rsl = red + 8 * 64 * 12;
    if (r32 < 12) {
#pragma unroll
        for (int r = 0; r < 16; ++r) { const int rw = (r & 3) + 8 * (r >> 2) + 4 * hi;
            red[(wid * 64 + rw) * 12 + r32] = acc0[r]; red[(wid * 64 + 32 + rw) * 12 + r32] = acc1[r]; }
    }
    if (tid < 64) rsl[tid] = ((const float*)(P.ws + WS_RS))[task * 64 + tid];
    __syncthreads();
    for (int i = tid; i < 64 * 12; i += 512) { float s = 0.f;
#pragma unroll
        for (int w = 0; w < 8; ++w) s += red[w * 768 + i];
        __hip_atomic_store((unsigned*)(P.ws + WS_GATES) + (size_t)task * 768 + i, __float_as_uint(sigmoidf_(s * rsl[i / 12])), __ATOMIC_RELAXED, __HIP_MEMORY_SCOPE_AGENT); }
}
__device__ __forceinline__ void cmp_task(const Params& P, LAS unsigned char* lds, const int l, const int which, const int b, const int nb) {
    const int tid = otid(), wid = __builtin_amdgcn_readfirstlane(tid >> 6), lane = tid & 63, r32 = lane & 31, hi = lane >> 5;
    const int n0 = 32 * nb, cb = wid & 3, kh = wid >> 2;
    LAS float* red = (LAS float*)lds;
    LAS bf16* hid = (LAS bf16*)(lds + 4 * 32 * 33 * 4);
    LAS float* ot = (LAS float*)(lds + 4 * 32 * 33 * 4 + 32 * 136 * 2);
    {
        const int n = min(n0 + r32, NCMP - 1);
        const bf16* tokbase = (const bf16*)(P.ws + WS_PROJ) + (size_t)(b * SEQ + 16 * n) * NP + (which ? O_VC : O_KC) + 8 * hi;
        const bf16x8* wf = (const bf16x8*)(P.ws + WS_W1F) + ((size_t)((l * 2 + which) * 4 + cb) * 256 + kh * 128) * 64 + lane;
        const bf16* tok = tokbase + (size_t)(kh * 16) * NP;
        f32x16 acc = f32x16{}, acc2 = f32x16{};
#pragma unroll 1
        for (int t = 0; t < 16; ++t) {
            bf16x8 A[8], Bf[8];
            const bf16x8* wq = wf + 4 * 64;
#pragma unroll
            for (int k = 0; k < 4; ++k) { A[k] = *(const bf16x8*)(tok + k * 16); A[4 + k] = *(const bf16x8*)(tok + (4 + k) * 16); Bf[k] = wf[k * 64]; Bf[4 + k] = wq[k * 64]; }
            __builtin_amdgcn_sched_barrier(0);
#pragma unroll
            for (int k = 0; k < 8; k += 2) { acc = __builtin_amdgcn_mfma_f32_32x32x16_bf16(A[k], Bf[k], acc, 0, 0, 0); acc2 = __builtin_amdgcn_mfma_f32_32x32x16_bf16(A[k + 1], Bf[k + 1], acc2, 0, 0, 0); }
            __builtin_amdgcn_sched_barrier(0);
            tok += NP; wf += 8 * 64;
        }
        acc += acc2;
        if (kh == 1) {
#pragma unroll
            for (int r = 0; r < 16; ++r) red[(cb * 32 + (r & 3) + 8 * (r >> 2) + 4 * hi) * 33 + r32] = acc[r];
        }
        __syncthreads();
        if (kh == 0) { float cst = 0.f;
            { const float* cp = (const float*)(P.ws + WS_CST) + (size_t)((l * 2 + which) * 64) * 128 + cb * 32 + r32;
#pragma unroll 1
              for (int s0 = 0; s0 < 64; s0 += 16) {
                  float cv[16];
#pragma unroll
                  for (int i = 0; i < 16; ++i) cv[i] = cp[i * 128];
                  __builtin_amdgcn_sched_barrier(0);
#pragma unroll
                  for (int i = 0; i < 16; ++i) cst += cv[i];
                  __builtin_amdgcn_sched_barrier(0);
                  cp += 16 * 128; } }
#pragma unroll
            for (int r = 0; r < 16; ++r) { const int rw = (r & 3) + 8 * (r >> 2) + 4 * hi;
                hid[rw * 136 + cb * 32 + r32] = (bf16)f2bf(geluf_(acc[r] + red[(cb * 32 + rw) * 33 + r32] + cst)); } }
        __syncthreads();
    }
    if (wid < 4) {
        const bf16x8* w2f = (const bf16x8*)(P.ws + WS_W2F) + ((size_t)((l * 2 + which) * 4 + wid) * 8) * 64 + lane;
        f32x16 acc = f32x16{};
        bf16x8 wb[8];
#pragma unroll
        for (int ks = 0; ks < 8; ++ks) wb[ks] = w2f[ks * 64];
        __builtin_amdgcn_sched_barrier(0);
#pragma unroll
        for (int ks = 0; ks < 8; ++ks) acc = __builtin_amdgcn_mfma_f32_32x32x16_bf16(*(const LAS bf16x8*)(hid + r32 * 136 + 16 * ks + 8 * hi), wb[ks], acc, 0, 0, 0);
#pragma unroll
        for (int r = 0; r < 16; ++r) ot[((r & 3) + 8 * (r >> 2) + 4 * hi) * 132 + wid * 32 + r32] = acc[r];
    }
    __syncthreads();
    {
        const int r = tid >> 4, jg = tid & 15, j2 = jg * 8;
        float o[8];
        { const f32x4 oa = *(const LAS f32x4*)(ot + r * 132 + j2), ob = *(const LAS f32x4*)(ot + r * 132 + j2 + 4);
#pragma unroll
          for (int e = 0; e < 4; ++e) { o[e] = oa[e]; o[4 + e] = ob[e]; } }
        const int n = n0 + r;
        if (which == 0) {
            float ss = 0.f;
#pragma unroll
            for (int e = 0; e < 8; ++e) ss += o[e] * o[e];
            ss += __shfl_xor(ss, 1); ss += __shfl_xor(ss, 2); ss += __shfl_xor(ss, 4); ss += __shfl_xor(ss, 8);
            const float rs = 1.0f / sqrtf(ss * (1.0f / 128.0f) + EPSN);
            const float* kcn = P.in[7] + l * 128 + j2;
            const float2* cs = (const float2*)(P.ws + WS_ROPE) + (size_t)min(16 * n + 31, SEQ - 1) * 16 + (jg & 1) * 8;
#pragma unroll
            for (int e = 0; e < 8; ++e) { o[e] = o[e] * rs * kcn[e];
                const float other = __shfl_xor(o[e], 2);
                if (jg < 4) { const float2 c = cs[e]; o[e] = (jg < 2) ? (o[e] * c.x - other * c.y) : (o[e] * c.x + other * c.y); } }
        }
        u32x4 w; w.x = pk2(o[0], o[1]); w.y = pk2(o[2], o[3]); w.z = pk2(o[4], o[5]); w.w = pk2(o[6], o[7]);
        if (n >= NCMP) w = (u32x4){0u, 0u, 0u, 0u};
        { bf16* dst = (bf16*)(P.ws + WS_CMPB) + ((size_t)(which * NB + b) * 256 + n) * 128 + j2;
          asm volatile("global_store_dwordx4 %0, %1, off sc1" :: "v"(dst), "v"(w) : "memory"); }
    }
}
__device__ __forceinline__ void prep_w1(const Params& P, LAS unsigned char* lds) {
    const int tid = otid();
    const int gt = blockIdx.x * 512 + tid, GT = gridDim.x * 512;
    for (int fl = gt; fl < NL * 2 * 65536; fl += GT) {
        const int lw = fl >> 16, rem = fl & 65535, lane = rem & 63, ks = (rem >> 6) & 255, cb = rem >> 14;
        const float* w1 = P.in[(lw & 1) ? 14 : 12] + (size_t)(lw >> 1) * 4096 * 128;
        const float* src = w1 + (size_t)(16 * ks + 8 * (lane >> 5)) * 128 + 32 * cb + (lane & 31);
        u32x4 o; o.x = pk2(src[0], src[128]); o.y = pk2(src[256], src[384]); o.z = pk2(src[512], src[640]); o.w = pk2(src[768], src[896]);
        *(u32x4*)((bf16*)(P.ws + WS_W1F) + (size_t)fl * 8) = o;
    }
    for (int fl = gt; fl < NL * 2 * 4 * 8 * 64; fl += GT) {
        const int lw = fl >> 11, cb = (fl >> 9) & 3, ks = (fl >> 6) & 7, lane = fl & 63;
        const float* w2 = P.in[(lw & 1) ? 15 : 13] + (size_t)(lw >> 1) * 16384 + (size_t)(16 * ks + 8 * (lane >> 5)) * 128 + 32 * cb + (lane & 31);
        u32x4 o; o.x = pk2(w2[0], w2[128]); o.y = pk2(w2[256], w2[384]); o.z = pk2(w2[512], w2[640]); o.w = pk2(w2[768], w2[896]);
        *(u32x4*)((bf16*)(P.ws + WS_W2F) + (size_t)fl * 8) = o;
    }
    for (int fl = gt; fl < NL * 128 * 64; fl += GT) {
        const int l = fl >> 13, ks = (fl >> 6) & 127, lane = fl & 63, n = lane & 31, k0 = 16 * ks + 8 * (lane >> 5);
        float v[8];
#pragma unroll
        for (int e = 0; e < 8; ++e) v[e] = (n < 12) ? P.in[1][l * DM + k0 + e] * P.in[2][(size_t)l * DM * INW + (size_t)(k0 + e) * INW + SRC_NG + n] : 0.f;
        u32x4 o; o.x = pk2(v[0], v[1]); o.y = pk2(v[2], v[3]); o.z = pk2(v[4], v[5]); o.w = pk2(v[6], v[7]);
        *(u32x4*)((bf16*)(P.ws + WS_WGF) + (size_t)fl * 8) = o;
    }
    for (int t = blockIdx.x; t < NL * 2 * 64; t += gridDim.x) {
        const int lw = t >> 6, sl = t & 63;
        const float* w1 = P.in[(lw & 1) ? 14 : 12] + (size_t)(lw >> 1) * 4096 * 128;
        const float* pe = P.in[(lw & 1) ? 11 : 10] + (size_t)(lw >> 1) * 4096;
        const int j = tid & 127, kq = tid >> 7;
        float s = 0.f;
#pragma unroll
        for (int i = 0; i < 16; ++i) { const int k = sl * 64 + kq * 16 + i; s += pe[k] * w1[(size_t)k * 128 + j]; }
        LAS float* red = (LAS float*)lds;
        __syncthreads();
        red[tid] = s;
        __syncthreads();
        if (tid < 128) ((float*)(P.ws + WS_CST))[(size_t)t * 128 + tid] = (red[tid] + red[128 + tid]) + (red[256 + tid] + red[384 + tid]);
    }
}
}

__device__ __forceinline__ void unit_done(unsigned* cnt) {
    asm volatile("s_waitcnt vmcnt(0)" ::: "memory");
    __syncthreads();
    if (otid() == 0) { __builtin_amdgcn_fence(__ATOMIC_RELEASE, "agent"); asm volatile("s_waitcnt vmcnt(0)" ::: "memory");
        __hip_atomic_fetch_add(cnt, 1u, __ATOMIC_RELAXED, __HIP_MEMORY_SCOPE_AGENT); }
}
__device__ __forceinline__ void unit_done_wt(unsigned* cnt) {
    asm volatile("s_waitcnt vmcnt(0)" ::: "memory");
    __syncthreads();
    if (otid() == 0) __hip_atomic_fetch_add(cnt, 1u, __ATOMIC_RELAXED, __HIP_MEMORY_SCOPE_AGENT);
}
__device__ __forceinline__ void unit_wait(unsigned* cnt, unsigned target) {
    if (otid() == 0) { unsigned sp = 0u;
        while (__hip_atomic_load(cnt, __ATOMIC_RELAXED, __HIP_MEMORY_SCOPE_AGENT) < target) { __builtin_amdgcn_s_sleep(4); if (++sp > (1u << 22)) break; }
        __builtin_amdgcn_fence(__ATOMIC_ACQUIRE, "agent"); asm volatile("s_waitcnt vmcnt(0)" ::: "memory"); }
    __syncthreads();
}
struct OneUnit { int pm, pn; __device__ __forceinline__ bool next(int i, pg8::Unit& u) const { if (i != 0) return false; u.pm = pm; u.pn = pn; return true; } };

__device__ __forceinline__ void phase_mid(const Params& P, LAS unsigned char* lds, int l) {
    unsigned* ctl = (unsigned*)(P.ws + WS_CTL) + 64 * 8 * l;
    const int* order = (const int*)(P.ws + WS_ORDER);
    LAS int* slot = (LAS int*)(lds + LDS_BYTES - 64);
    bool small_ok = false; unsigned s5_ok = 0u;
    for (;;) {
        __syncthreads();
        if (otid() == 0) slot[0] = (int)__hip_atomic_fetch_add(ctl, 1u, __ATOMIC_RELAXED, __HIP_MEMORY_SCOPE_AGENT);
        __syncthreads();
        const int u = slot[0];
        if (u >= 1344) break;
        if (u < 64) { a1::cmp_task(P, lds, l, u >> 5, (u >> 3) & 3, u & 7); unit_done_wt(ctl + 64); }
        else if (u < 320) { a1::gates_task(P, lds, l, u - 64); unit_done_wt(ctl + 64); }
        else if (u < 576) { const int v = u - 320; s5::unit(P, lds, l, v >> 6, v & 63); unit_done(ctl + 128 + 64 * (v >> 6)); }
        else if (u < 1088) { const int id = order[u - 576];
            if (id < 256) { if (!small_ok) { unit_wait(ctl + 64, 320u); small_ok = true; } att::nsa_unit(P, lds, id >> 6, id & 63); }
            else { const int v = id - 256; att::moba_unit(P, lds, v >> 6, (v >> 4) & 3, v & 15); } }
        else { const int t = u - 1088, pm = t >> 2, b = pm >> 4;
            if (!((s5_ok >> b) & 1u)) { unit_wait(ctl + 128 + 64 * b, 64u); s5_ok |= 1u << b; }
            pg8::Gemm g{(const bf16*)(P.ws + WS_Y5), (const bf16*)(P.ws + WS_GLU + l * GLU_BYTES), NT, 1024, 1024, 1024};
            OneUnit S{pm, t & 3};
            EpiGlu E{(bf16*)(P.ws + WS_MIXED), (const bf16*)(P.ws + WS_Y5), (const bf16*)(P.ws + WS_PROJ)};
            pg8::gemm_phase<EpiGlu, OneUnit>(lds, g, S, E); }
    }
}

#define XB_TMO      128
#define XB_XCNT(j)  (256  + 64 * (j))
#define XB_XSUB(j)  (1280 + 64 * (j))
#define XB_XGEN(j)  (2304 + 64 * (j))
#define XB_TOP      3328
#define XB_TOPGEN   3392
#define XCD_BAR_WORDS 3456
#define XB_SPIN_CAP (1u << 18)
__device__ __forceinline__ unsigned xb_ld(unsigned* p)              { return __hip_atomic_load(p, __ATOMIC_RELAXED, __HIP_MEMORY_SCOPE_AGENT); }
__device__ __forceinline__ unsigned xb_add(unsigned* p, unsigned v) { return __hip_atomic_fetch_add(p, v, __ATOMIC_RELAXED, __HIP_MEMORY_SCOPE_AGENT); }
__device__ __forceinline__ unsigned xb_xcc_id() { return (unsigned)__builtin_amdgcn_s_getreg((3 << 11) | 20) & 0xFu; }
#define XB_SPIN(cond, bar) do { unsigned _sp = 0; while (cond) { __builtin_amdgcn_s_sleep(1); \
    if ((++_sp & 255u) == 0u) { if (xb_ld(&(bar)[XB_TMO])) break; if (_sp > XB_SPIN_CAP) { atomicAdd(&(bar)[XB_TMO], 1u); break; } } } } while (0)
struct XcdBarrier { unsigned* bar; unsigned x; volatile LAS unsigned* st; };
__device__ __forceinline__ XcdBarrier xcd_barrier_post(unsigned* bar, volatile LAS unsigned* st) {
    XcdBarrier b; b.bar = bar; b.x = xb_xcc_id(); b.st = st;
    if (threadIdx.x == 0) (void)xb_add(&bar[XB_XCNT(b.x)], 1u);
    return b;
}
__device__ __forceinline__ void xcd_barrier_complete(unsigned* bar, unsigned x, unsigned& nloc, unsigned& nx) {
    const unsigned G = gridDim.x * gridDim.y * gridDim.z;
    const unsigned lane = (unsigned)otid() & 63u;
    unsigned sum, cnt, mine, sp = 0u;
    for (;;) {
        const unsigned c = (lane < 16u) ? xb_ld(&bar[XB_XCNT(lane)]) : 0u;
        sum = c;
#pragma unroll
        for (int o = 1; o < 16; o <<= 1) sum += __shfl_xor(sum, o);
        sum = __shfl(sum, 0);
        cnt = (unsigned)__popcll(__ballot(c > 0u));
        mine = __shfl(c, (int)x);
        if (sum == G) break;
        __builtin_amdgcn_s_sleep(1);
        if ((++sp & 255u) == 0u) { if (xb_ld(&bar[XB_TMO])) break; if (sp > XB_SPIN_CAP) { if (lane == 0u) atomicAdd(&bar[XB_TMO], 1u); break; } }
    }
    nloc = mine > 0u ? mine : 1u; nx = cnt > 0u ? cnt : 1u;
}
__device__ __forceinline__ void xcd_barrier(const XcdBarrier& b) {
    asm volatile("s_waitcnt vmcnt(0)" ::: "memory");
    __syncthreads();
    if (threadIdx.x < 64 && b.st[0] == 0u) {
        unsigned nloc0, nx0; xcd_barrier_complete(b.bar, b.x, nloc0, nx0);
        if (threadIdx.x == 0) { b.st[0] = nloc0; b.st[1] = nx0; }
        asm volatile("s_waitcnt lgkmcnt(0)" ::: "memory");
    }
    if (threadIdx.x == 0) {
        unsigned* bar = b.bar;
        __builtin_amdgcn_s_waitcnt(0);
        unsigned nloc = b.st[0], nx = b.st[1];
        const unsigned old = xb_add(&bar[XB_XSUB(b.x)], 1u);
        const unsigned gen = old / nloc;
        if (old + 1u == (gen + 1u) * nloc) {
            __builtin_amdgcn_fence(__ATOMIC_RELEASE, "agent");
            asm volatile("s_waitcnt vmcnt(0)" ::: "memory");
            const unsigned og = xb_add(&bar[XB_TOP], 1u);
            const unsigned tg = og / nx;
            if (og + 1u == (tg + 1u) * nx) xb_add(&bar[XB_TOPGEN], 1u);
            else XB_SPIN(xb_ld(&bar[XB_TOPGEN]) == tg, bar);
            __builtin_amdgcn_fence(__ATOMIC_ACQUIRE, "agent");
            xb_add(&bar[XB_XGEN(b.x)], 1u);
            asm volatile("s_waitcnt vmcnt(0)" ::: "memory");
        } else {
            XB_SPIN(xb_ld(&bar[XB_XGEN(b.x)]) == gen, bar);
            __builtin_amdgcn_fence(__ATOMIC_ACQUIRE, "agent");
            asm volatile("s_waitcnt vmcnt(0)" ::: "memory");
        }
    }
    __syncthreads();
}

__global__ void __launch_bounds__(512, 2) k_mega(Params P) {
    extern __shared__ __attribute__((aligned(16))) unsigned char lds_raw[];
    LAS unsigned char* lds = (LAS unsigned char*)lds_raw;
    const int lo = P.ph_lo, hi = P.ph_hi;
#define IN(k) (lo <= (k) && (k) < hi)
    volatile LAS unsigned* bst = (volatile LAS unsigned*)(lds + LDS_BYTES - 32);
    if (threadIdx.x < 2) bst[threadIdx.x] = 0u;
    __syncthreads();
    const XcdBarrier bar = xcd_barrier_post((unsigned*)(P.ws + WS_CTL) + 4096, bst);
#define SEAM(k) do { if (IN(k) && IN((k) + 1)) xcd_barrier(bar); } while (0)
    if (IN(0)) phase_prep(P, lds);
    SEAM(0);
    for (int l = 0; l < NL; ++l) {
        if (IN(1 + 3 * l)) phase_gemm1(P, lds, l);
        SEAM(1 + 3 * l);
        if (IN(2 + 3 * l)) phase_mid(P, lds, l);
        SEAM(2 + 3 * l);
        if (IN(3 + 3 * l)) phase_out(P, lds, l);
        SEAM(3 + 3 * l);
    }
#undef SEAM
#undef IN
}

extern "C" void kernel_launch(void* const* d_in, const int* in_sizes, int n_in, void* d_out, int out_size, void* d_ws, size_t ws_size, hipStream_t stream) {
    static int grid = 0;
    if (grid == 0) {
        if (ws_size < WS_END) { fprintf(stderr, "kernel_launch: workspace too small (%zu < %zu)\n", ws_size, (size_t)WS_END); grid = -1; return; }
        int dev = 0, cus = 0;
        hipGetDevice(&dev); hipDeviceGetAttribute(&cus, hipDeviceAttributeMultiprocessorCount, dev);
        hipFuncSetAttribute((const void*)k_mega, hipFuncAttributeMaxDynamicSharedMemorySize, LDS_BYTES);
        int per_cu = 0;
        hipOccupancyMaxActiveBlocksPerMultiprocessor(&per_cu, (const void*)k_mega, 512, LDS_BYTES);
        if (per_cu < 1) { fprintf(stderr, "kernel_launch: occupancy query says %d blocks per CU\n", per_cu); per_cu = 1; }
        grid = (cus > 0 ? cus : 256) * 1;
    }
    if (grid < 0) return;
    unsigned char* ws = (unsigned char*)d_ws;
    Params P{};
    for (int i = 0; i < 25; ++i) P.in[i] = (const float*)d_in[i];
    P.out = (float*)d_out; P.ws = ws;
    hipMemsetAsync(ws + WS_CTL, 0, 32768, stream);
    P.ph_lo = 0; P.ph_hi = 7;
    void* args[] = {&P};
    hipError_t e = hipLaunchCooperativeKernel((const void*)k_mega, dim3(grid), dim3(512), args, LDS_BYTES, stream);
    if (e != hipSuccess) fprintf(stderr, "kernel_launch: cooperative launch failed: %s (grid %d)\n", hipGetErrorString(e), grid);
}
```

```cpp
#include <hip/hip_runtime.h>
#include <stdint.h>
#include <cstdio>

typedef unsigned short bf16;
typedef short bf16x8 __attribute__((ext_vector_type(8)));
typedef float f32x4 __attribute__((ext_vector_type(4)));
typedef unsigned u32x4 __attribute__((ext_vector_type(4)));
typedef unsigned u32x2 __attribute__((ext_vector_type(2)));
#define LAS __attribute__((address_space(3)))
__device__ __forceinline__ int otid() { int t = threadIdx.x; asm volatile("" : "+v"(t)); return t; }

constexpr int NB = 4, SEQ = 4096, DM = 2048, NT = NB * SEQ, NL = 2;
constexpr int INW = 5900;
constexpr int NP = 5888;
constexpr int O_MQ = 0, O_MK = 512, O_MV = 1024, O_MZ = 1536, O_NQ = 2048, O_KC = 2560, O_VC = 2688, O_KS = 2816, O_VS = 2944,
              O_KW = 3072, O_VW = 3200, O_NZ = 3328, O_SU = 3840, O_SZ = 4864;
constexpr int SRC_NG = 3328;
constexpr int NCMP = 255;
constexpr float EPSN = 1e-6f;
constexpr float SCALE = 0.08838834764831845f;

constexpr size_t MiB = 1u << 20;
constexpr size_t WS_CTL = 0;
constexpr size_t WS_WIN = 1 * MiB;
constexpr size_t WIN_BYTES = (size_t)NP * DM * 2;
constexpr size_t WS_WOUT = WS_WIN + 2 * WIN_BYTES;
constexpr size_t WOUT_BYTES = (size_t)DM * DM * 2;
constexpr size_t WS_GLU = WS_WOUT + 2 * WOUT_BYTES;
constexpr size_t GLU_BYTES = (size_t)1024 * 1024 * 2;
constexpr size_t WS_XB = WS_GLU + 2 * GLU_BYTES;
constexpr size_t WS_PROJ = WS_XB + (size_t)NT * DM * 2;
constexpr size_t WS_MIXED = WS_PROJ + (size_t)NT * NP * 2;
constexpr size_t WS_Y5 = WS_MIXED + (size_t)NT * DM * 2;
constexpr size_t WS_SSQP = WS_Y5 + (size_t)NT * 1024 * 2;
constexpr size_t WS_GATES = WS_SSQP + (size_t)NT * 32 * 4;
constexpr size_t WS_ROPE = WS_GATES + 1 * MiB;
constexpr size_t WS_RS = WS_ROPE + 512 * 1024;
constexpr size_t WS_KMEAN = WS_ROPE + 1 * MiB;
constexpr size_t WS_CMP = WS_KMEAN + 1 * MiB;
constexpr size_t WS_HID = WS_CMP + 1 * MiB;
constexpr size_t WS_CMPB = WS_HID + 1 * MiB;
constexpr size_t WS_ORDER = WS_CMPB + 1 * MiB;
constexpr size_t WS_S5K = WS_ORDER + 1 * MiB;
constexpr size_t WS_S5P1 = WS_S5K + 5 * MiB;
constexpr size_t WS_S5P2 = WS_S5P1 + 32 * MiB;
constexpr size_t WS_S5AL = WS_S5P2 + 32 * MiB;
constexpr size_t WS_W1F = WS_S5AL + 1 * MiB;
constexpr size_t WS_CST = WS_W1F + 4 * MiB;
constexpr size_t WS_WGF = WS_CST + 1 * MiB;
constexpr size_t WS_W2F = WS_WGF + 1 * MiB;
constexpr size_t WS_END = WS_W2F + 1 * MiB;
static_assert(WS_END <= 536870912ull, "workspace map exceeds 512 MiB");
constexpr size_t SUG_OFF = (size_t)256 * 256 * 128;

__device__ const double INVF[16] = {1.0, 0.44036660267178046, 0.19392274474868576, 0.08539710028576561, 0.03760603093086393,
    0.016560440080994446, 0.007292664737217109, 0.003211445994752591, 0.001414213562373095, 0.000622772421914596,
    0.0002742481756762073, 0.00012076973741146504, 5.318295896944988e-05, 2.341999896140934e-05, 1.031338537721246e-05,
    4.5416704806078695e-06};

__device__ __forceinline__ void dsincos(double a, double& s, double& c) {
    const double k = rint(a * 0.63661977236758134308);
    double r = fma(-k, 1.57079632679489655800e+00, a);
    r = fma(-k, 6.12323399573676603587e-17, r);
    const double r2 = r * r;
    double sp = 1.0 / 6227020800.0;
    sp = fma(sp, r2, -1.0 / 39916800.0); sp = fma(sp, r2, 1.0 / 362880.0); sp = fma(sp, r2, -1.0 / 5040.0);
    sp = fma(sp, r2, 1.0 / 120.0); sp = fma(sp, r2, -1.0 / 6.0); sp = fma(sp, r2, 1.0);
    const double sn = sp * r;
    double cp = -1.0 / 87178291200.0;
    cp = fma(cp, r2, 1.0 / 479001600.0); cp = fma(cp, r2, -1.0 / 3628800.0); cp = fma(cp, r2, 1.0 / 40320.0);
    cp = fma(cp, r2, -1.0 / 720.0); cp = fma(cp, r2, 1.0 / 24.0); cp = fma(cp, r2, -0.5); cp = fma(cp, r2, 1.0);
    const long long q = (long long)k & 3;
    if (q == 0) { s = sn; c = cp; } else if (q == 1) { s = cp; c = -sn; } else if (q == 2) { s = -sn; c = -cp; } else { s = -cp; c = sn; }
}
__device__ __forceinline__ float wave_sum(float v) {
#pragma unroll
    for (int o = 1; o < 64; o <<= 1) v += __shfl_xor(v, o);
    return v;
}
__device__ __forceinline__ float wave_max(float v) {
#pragma unroll
    for (int o = 1; o < 64; o <<= 1) v = fmaxf(v, __shfl_xor(v, o));
    return v;
}
__device__ __forceinline__ float sigmoidf_(float x) { return __builtin_amdgcn_rcpf(1.0f + __builtin_amdgcn_exp2f(-1.4426950408889634f * x)); }
__device__ __forceinline__ float siluf_(float x) { return x * sigmoidf_(x); }
__device__ __forceinline__ float geluf_(float x) { return x * sigmoidf_(1.5957691216057308f * (x + 0.044715f * x * x * x)); }
__device__ __forceinline__ float bf2f(bf16 b) { return __uint_as_float((unsigned)b << 16); }
__device__ __forceinline__ unsigned f2bf(float f) { const unsigned u = __float_as_uint(f); return (u + 0x7fffu + ((u >> 16) & 1u)) >> 16; }
__device__ __forceinline__ unsigned pk2(float lo, float hi) { return f2bf(lo) | (f2bf(hi) << 16); }
__device__ __forceinline__ float2 ld2(const bf16* p, int lane) { const unsigned w = ((const unsigned*)p)[lane]; return make_float2(__uint_as_float(w << 16), __uint_as_float(w & 0xffff0000u)); }

__device__ __forceinline__ void st16_wt(const void* p, u32x4 v) { asm volatile("global_store_dwordx4 %0, %1, off sc1\n\ts_nop 1" :: "v"(p), "v"(v) : "memory"); }
namespace pg8 {
constexpr int BM = 256, BK = 64, HALF = 128, HTB = HALF * BK * 2, STAGE_BYTES = 8 * HTB, NXCD = 8, WGM = 8;
__host__ __device__ __forceinline__ int lds_byte(int r, int c) { const int st = (r >> 4) * 2 + (c >> 5), rr = r & 15, cc = c & 31, ob = rr * 64 + cc * 2; return st * 1024 + (ob ^ (((ob >> 9) & 1) << 5)); }
__host__ __device__ __forceinline__ void stage_rc(int b, int& R, int& C) { const int st = b / 1024, sb = b % 1024, swz = sb ^ (((sb >> 9) & 1) << 5); R = (st >> 1) * 16 + swz / 64; C = (st & 1) * 32 + (swz % 64) / 2; }
__host__ __device__ __forceinline__ int perm32(int rho) { const int n = rho >> 4, i = rho & 15; return 8 * (i >> 2) + 4 * n + (i & 3); }
struct Unit { int pm, pn; };
struct Gemm { const bf16* A; const bf16* Bt; int M, N, K, lda; };
struct StaticOrder {
    int nM, nN, nwg, G, c, permN;
    __host__ __device__ void init(int M, int N, int G_, int c_, int permN_ = 0) { nM = M / BM; nN = N / BM; nwg = nM * nN; G = G_; c = c_; permN = permN_; }
    __host__ __device__ bool next(int i, Unit& u) const {
        const long L = (long)i * G + c; if (L >= nwg) return false;
        int wgid = (int)L; { const int q = nwg / NXCD, r = nwg % NXCD, xcd = wgid % NXCD, off = wgid / NXCD; wgid = (xcd < r ? xcd * (q + 1) : r * (q + 1) + (xcd - r) * q) + off; }
        const int nig = WGM * nN, gid = wgid / nig, fm = gid * WGM, gsz = (nM - fm) < WGM ? (nM - fm) : WGM;
        u.pm = fm + ((wgid % nig) % gsz); u.pn = (wgid % nig) / gsz;
        if (permN) u.pn = (int)((u.pn < 12 ? (0x14dc50c9a403169ull >> (5 * u.pn)) : (0x5a2a456071d1e6ull >> (5 * (u.pn - 12)))) & 31ull);
        return true;
    }
};
__device__ __forceinline__ unsigned cvt_pk_bf16(float lo, float hi) { unsigned r; asm volatile("v_cvt_pk_bf16_f32 %0, %1, %2" : "=v"(r) : "v"(lo), "v"(hi)); return r; }

template <class Epi, class Sched>
__device__ __forceinline__ void gemm_phase(LAS unsigned char* lds, const Gemm g, const Sched& S, const Epi& E) {
    constexpr bool ALIGN_EPI = true;
    const int tid = otid(), wid = __builtin_amdgcn_readfirstlane(tid >> 6), lane = tid & 63, wr = wid >> 2, wc = wid & 3, fr = lane & 15, fq = lane >> 4;
    const int K = g.K, nt = K / BK;
    unsigned voffA[2], voffB[2];
#pragma unroll
    for (int i = 0; i < 2; ++i) { int R, C; stage_rc(tid * 16 + i * 8192, R, C); const int Rb = Epi::PERM ? ((R & ~31) + perm32(R & 31)) : R;
        voffA[i] = (unsigned)(R * g.lda + C) * 2u; voffB[i] = (unsigned)(Rb * K + C) * 2u; }
    const size_t kstep = (size_t)(BK * 2);
    const size_t hstepA = (size_t)HALF * g.lda * 2, hstepB = (size_t)HALF * K * 2;
    const size_t tstepA = 2 * hstepA, tstepB = 2 * hstepB;
    const unsigned ldsw = (unsigned)wid * 1024u;
    const int aoff = lds_byte(wr * 64 + fr, fq * 8), boff = lds_byte(wc * 32 + fr, fq * 8);
#define PG8_SA(b, h) (((b) * 2 + (h)) * HTB)
#define PG8_SB(b, h) ((4 + (b) * 2 + (h)) * HTB)
#define PG8_STAGE(bufoff, gbase, voff) do { _Pragma("unroll") for (int _i = 0; _i < 2; ++_i) \
        __builtin_amdgcn_global_load_lds((const unsigned*)((const char*)(gbase) + (voff)[_i]), (LAS unsigned*)(lds + (bufoff) + ldsw + _i * 8192), 16, 0, 0); } while (0)
#define PG8_LDA(dst, b, h) do { _Pragma("unroll") for (int m = 0; m < 4; ++m) _Pragma("unroll") for (int k = 0; k < 2; ++k) dst[m][k] = *(const LAS bf16x8*)(lds + PG8_SA(b, h) + aoff + m * 2048 + k * 1024); } while (0)
#define PG8_LDB(dst, b, h) do { _Pragma("unroll") for (int n = 0; n < 2; ++n) _Pragma("unroll") for (int k = 0; k < 2; ++k) dst[n][k] = *(const LAS bf16x8*)(lds + PG8_SB(b, h) + boff + n * 2048 + k * 1024); } while (0)
#define PG8_MMA(ai, bj, At, Bt) do { __builtin_amdgcn_s_setprio(1); _Pragma("unroll") for (int m = 0; m < 4; ++m) _Pragma("unroll") for (int n = 0; n < 2; ++n) _Pragma("unroll") for (int k = 0; k < 2; ++k) \
        acc[ai][bj][m][n] = __builtin_amdgcn_mfma_f32_16x16x32_bf16(Bt[n][k], At[m][k], acc[ai][bj][m][n], 0, 0, 0); __builtin_amdgcn_s_setprio(0); } while (0)
#define PG8_WAIT_V(n) asm volatile("s_waitcnt vmcnt(" #n ")" ::: "memory")
#define PG8_WAIT_L(n) asm volatile("s_waitcnt lgkmcnt(" #n ")" ::: "memory")
#define PG8_BAR __builtin_amdgcn_s_barrier()
#define PG8_SCHED __builtin_amdgcn_sched_barrier(0)
    Unit cur, nxt; int ui = 0;
    if (!S.next(0, cur)) return;
    typename Epi::Pre pre = E.pre(cur, wr), pren = pre;
    f32x4 acc[2][2][4][2];
#pragma unroll
    for (int a = 0; a < 2; ++a)
#pragma unroll
        for (int b = 0; b < 2; ++b)
#pragma unroll
            for (int m = 0; m < 4; ++m)
#pragma unroll
                for (int n = 0; n < 2; ++n) acc[a][b][m][n] = (f32x4){0.f, 0.f, 0.f, 0.f};
    bf16x8 At[4][2], B0[2][2], B1[2][2];
    const char* cA = (const char*)g.A + (size_t)cur.pm * tstepA; const char* cB = (const char*)g.Bt + (size_t)cur.pn * tstepB;
    PG8_STAGE(PG8_SB(0, 0), cB, voffB); PG8_STAGE(PG8_SB(0, 1), cB + hstepB, voffB); PG8_STAGE(PG8_SA(0, 0), cA, voffA); PG8_STAGE(PG8_SA(0, 1), cA + hstepA, voffA);
    if (wr == 1) PG8_BAR;
    PG8_WAIT_V(2); PG8_BAR;
    PG8_STAGE(PG8_SB(1, 0), cB + kstep, voffB); PG8_STAGE(PG8_SA(1, 0), cA + kstep, voffA); PG8_STAGE(PG8_SB(1, 1), cB + hstepB + kstep, voffB);
    PG8_WAIT_V(6); PG8_BAR;
    for (;;) {
        const bool has_next = S.next(ui + 1, nxt);
        const char* nA = has_next ? (const char*)g.A + (size_t)nxt.pm * tstepA : cA; const char* nB = has_next ? (const char*)g.Bt + (size_t)nxt.pn * tstepB : cB;
        for (int t = 0; t < nt; t += 2) {
            const bool last = (t == nt - 2);
            const char* a1 = cA + (size_t)(t + 1) * kstep;
            const char* a2 = last ? nA : cA + (size_t)(t + 2) * kstep; const char* b2 = last ? nB : cB + (size_t)(t + 2) * kstep;
            const char* a3 = a2 + kstep; const char* b3 = b2 + kstep;
            PG8_LDB(B0, 0, 0); PG8_LDB(B1, 0, 1); PG8_SCHED; PG8_LDA(At, 0, 0); PG8_STAGE(PG8_SA(1, 1), a1 + hstepA, voffA);
            PG8_WAIT_V(8); PG8_WAIT_L(0); PG8_BAR; PG8_MMA(0, 0, At, B0); PG8_MMA(0, 1, At, B1); PG8_BAR; PG8_SCHED;
            PG8_LDA(At, 0, 1); PG8_STAGE(PG8_SB(0, 0), b2, voffB); PG8_STAGE(PG8_SB(0, 1), b2 + hstepB, voffB); PG8_STAGE(PG8_SA(0, 0), a2, voffA);
            PG8_WAIT_V(8); PG8_WAIT_L(0); PG8_BAR; PG8_MMA(1, 0, At, B0); PG8_MMA(1, 1, At, B1); PG8_BAR; PG8_SCHED;
            PG8_LDB(B0, 1, 0); PG8_LDB(B1, 1, 1); PG8_SCHED; PG8_LDA(At, 1, 0); PG8_STAGE(PG8_SA(0, 1), a2 + hstepA, voffA);
            PG8_WAIT_V(8); PG8_WAIT_L(0); PG8_BAR; PG8_MMA(0, 0, At, B0); PG8_MMA(0, 1, At, B1); PG8_BAR; PG8_SCHED;
            PG8_LDA(At, 1, 1); PG8_STAGE(PG8_SB(1, 0), b3, voffB); PG8_STAGE(PG8_SB(1, 1), b3 + hstepB, voffB); PG8_STAGE(PG8_SA(1, 0), a3, voffA);
            PG8_WAIT_V(8); PG8_WAIT_L(0); PG8_BAR; PG8_MMA(1, 0, At, B0); PG8_MMA(1, 1, At, B1); PG8_BAR; PG8_SCHED;
        }
        if constexpr (ALIGN_EPI) { if (wr == 0) PG8_BAR; }
        if (has_next) pren = E.pre(nxt, wr);
        E(acc, cur, wr, wc, fr, fq, pre);
        if (!has_next) break;
        pre = pren;
#pragma unroll
        for (int a = 0; a < 2; ++a)
#pragma unroll
            for (int b = 0; b < 2; ++b)
#pragma unroll
                for (int m = 0; m < 4; ++m)
#pragma unroll
                    for (int n = 0; n < 2; ++n) acc[a][b][m][n] = (f32x4){0.f, 0.f, 0.f, 0.f};
        cur = nxt; cA = nA; cB = nB; ++ui;
        if constexpr (ALIGN_EPI) { if (wr == 1) PG8_BAR; }
    }
    PG8_WAIT_V(0);
    if constexpr (!ALIGN_EPI) { if (wr == 0) PG8_BAR; }
    PG8_BAR;
#undef PG8_SA
#undef PG8_SB
#undef PG8_STAGE
#undef PG8_LDA
#undef PG8_LDB
#undef PG8_MMA
#undef PG8_WAIT_V
#undef PG8_WAIT_L
#undef PG8_BAR
#undef PG8_SCHED
}
}

struct EpiProj {
    static constexpr bool PERM = true;
    bf16* O; bf16* ug; const float* rs; const float *nw0, *nw1, *nw2, *nw3, *nw4; const float2* cs; float* kmean; LAS unsigned char* xl;
    struct Pre { float r0, r1; };
    __device__ __forceinline__ Pre pre(const pg8::Unit& u, int wr) const { const float* p = rs + u.pm * 256 + 64 * wr + (otid() & 63); Pre q; q.r0 = p[0]; q.r1 = p[128]; return q; }
    __device__ __forceinline__ static int nid(int h) { return h < 4 ? 0 : h < 8 ? 1 : (h >= 16 && h < 20) ? 2 : h == 22 ? 3 : h == 24 ? 4 : -1; }
    __device__ __forceinline__ void operator()(const f32x4 (&acc)[2][2][4][2], const pg8::Unit& u, int wr, int wc, int fr, int fq, const Pre& pr) const {
        const float rsv[2] = {pr.r0, pr.r1};
        const int row0 = u.pm * 256 + wr * 64 + fr, col0 = u.pn * 256 + wc * 32 + 8 * fq;
        const int n0 = nid(2 * u.pn), n1 = nid(2 * u.pn + 1);
        if (n0 < 0 && n1 < 0) {
            const bool su = (u.pn >= O_SU / 256) && (u.pn < O_SZ / 256);
            const int cs0 = col0 - O_SU;
#pragma unroll
            for (int ai = 0; ai < 2; ++ai)
#pragma unroll
                for (int m = 0; m < 4; ++m) {
                    const float r = __shfl(rsv[ai], m * 16 + fr);
                    const int row = row0 + ai * 128 + m * 16;
                    bf16* rowp = su ? ug + (((size_t)((row >> 12) * 64 + (cs0 >> 4)) * SEQ + (row & (SEQ - 1))) * 16 + (cs0 & 8)) : O + (size_t)row * NP + col0;
                    const size_t bjs = su ? (size_t)8 * SEQ * 16 : (size_t)128;
#pragma unroll
                    for (int bj = 0; bj < 2; ++bj) { const f32x4 v0 = acc[ai][bj][m][0] * r, v1 = acc[ai][bj][m][1] * r;
                        u32x4 w; w.x = pg8::cvt_pk_bf16(v0[0], v0[1]); w.y = pg8::cvt_pk_bf16(v0[2], v0[3]); w.z = pg8::cvt_pk_bf16(v1[0], v1[1]); w.w = pg8::cvt_pk_bf16(v1[2], v1[3]);
                        *(u32x4*)(rowp + bj * bjs) = w; }
                }
            return;
        }
        LAS float* part = (LAS float*)xl;
        LAS float* ksum = (LAS float*)(xl + 8192);
#pragma unroll
        for (int ai = 0; ai < 2; ++ai)
#pragma unroll
            for (int m = 0; m < 4; ++m) {
                const float r = __shfl(rsv[ai], m * 16 + fr);
#pragma unroll
                for (int bj = 0; bj < 2; ++bj) { const f32x4 v0 = acc[ai][bj][m][0] * r, v1 = acc[ai][bj][m][1] * r;
                    float ss = (v0[0] * v0[0] + v0[1] * v0[1]) + (v0[2] * v0[2] + v0[3] * v0[3]) + (v1[0] * v1[0] + v1[1] * v1[1]) + (v1[2] * v1[2] + v1[3] * v1[3]);
                    ss += __shfl_xor(ss, 16); ss += __shfl_xor(ss, 32);
                    if (fq == 0) part[((ai * 128 + wr * 64 + m * 16 + fr) * 2 + bj) * 4 + wc] = ss; }
            }
        asm volatile("s_waitcnt lgkmcnt(0)" ::: "memory"); __builtin_amdgcn_s_barrier(); asm volatile("" ::: "memory");
        float csum[2][8];
#pragma unroll
        for (int bj = 0; bj < 2; ++bj)
#pragma unroll
            for (int e = 0; e < 8; ++e) csum[bj][e] = 0.f;
        f32x4 wq[2][2];
#pragma unroll
        for (int bj = 0; bj < 2; ++bj) { const int ni = bj ? n1 : n0;
            const float* wp = (ni <= 0 ? nw0 : ni == 1 ? nw1 : ni == 2 ? nw2 : ni == 3 ? nw3 : nw4) + wc * 32 + 8 * fq;
            wq[bj][0] = *(const f32x4*)wp; wq[bj][1] = *(const f32x4*)(wp + 4); }
        f32x4 cnx[4];
        const int ol = otid() & 63, ofr = ol & 15, ofq1 = (ol >> 4) & 1;
        { const f32x4* c4 = (const f32x4*)(cs + (size_t)((u.pm * 256 + wr * 64 + ofr) & (SEQ - 1)) * 16 + 8 * ofq1);
#pragma unroll
          for (int q = 0; q < 4; ++q) cnx[q] = c4[q]; }
#pragma unroll
        for (int ai = 0; ai < 2; ++ai)
#pragma unroll
            for (int m = 0; m < 4; ++m) {
                const float r = __shfl(rsv[ai], m * 16 + fr);
                const int rl = ai * 128 + wr * 64 + m * 16 + fr;
                bf16* rowp = O + (size_t)(u.pm * 256 + rl) * NP + col0;
                f32x4 ccur[4];
#pragma unroll
                for (int q = 0; q < 4; ++q) ccur[q] = cnx[q];
                if (ai * 4 + m < 7) { const int rn_ = (ai * 4 + m + 1 >= 4 ? 128 : 0) + wr * 64 + ((ai * 4 + m + 1) & 3) * 16 + ofr;
                    const f32x4* c4 = (const f32x4*)(cs + (size_t)((u.pm * 256 + rn_) & (SEQ - 1)) * 16 + 8 * ofq1);
#pragma unroll
                    for (int q = 0; q < 4; ++q) cnx[q] = c4[q]; }
#pragma unroll
                for (int bj = 0; bj < 2; ++bj) {
                    const int ni = bj ? n1 : n0;
                    float v[8];
#pragma unroll
                    for (int e = 0; e < 8; ++e) v[e] = ((e < 4) ? acc[ai][bj][m][0][e & 3] : acc[ai][bj][m][1][e & 3]) * r;
                    if (ni >= 0) {
                        const f32x4 p4 = *(const LAS f32x4*)(part + (rl * 2 + bj) * 4);
                        const float rn = 1.0f / sqrtf(((p4[0] + p4[1]) + (p4[2] + p4[3])) * (1.0f / 128.0f) + EPSN);
#pragma unroll
                        for (int e = 0; e < 8; ++e) v[e] *= rn * ((e < 4) ? wq[bj][0][e & 3] : wq[bj][1][e & 3]);
                        if (wc == 0) {
#pragma unroll
                            for (int e = 0; e < 8; ++e) { const float other = __shfl_xor(v[e], 32); const float cx = ccur[e >> 1][2 * (e & 1)], cy = ccur[e >> 1][2 * (e & 1) + 1];
                                v[e] = (fq < 2) ? (v[e] * cx - other * cy) : (v[e] * cx + other * cy); }
                        }
                        if (ni == 1) {
#pragma unroll
                            for (int e = 0; e < 8; ++e) csum[bj][e] += v[e];
                        }
                    }
                    u32x4 w; w.x = pg8::cvt_pk_bf16(v[0], v[1]); w.y = pg8::cvt_pk_bf16(v[2], v[3]); w.z = pg8::cvt_pk_bf16(v[4], v[5]); w.w = pg8::cvt_pk_bf16(v[6], v[7]);
                    *(u32x4*)(rowp + bj * 128) = w;
                }
                asm volatile("" ::: "memory");
            }
        if (n0 == 1) {
#pragma unroll
            for (int bj = 0; bj < 2; ++bj)
#pragma unroll
                for (int e = 0; e < 8; ++e) { float s = csum[bj][e]; s += __shfl_xor(s, 1); s += __shfl_xor(s, 2); s += __shfl_xor(s, 4); s += __shfl_xor(s, 8);
                    if (fr == 0) ksum[wr * 256 + bj * 128 + wc * 32 + 8 * fq + e] = s; }
            asm volatile("s_waitcnt lgkmcnt(0)" ::: "memory"); __builtin_amdgcn_s_barrier(); asm volatile("" ::: "memory");
            const int tid = otid();
            if (tid < 256) { const int h = 2 * u.pn + (tid >> 7) - 4, b = u.pm >> 4, n = u.pm & 15;
                kmean[((size_t)(b * 4 + h) * 16 + n) * 128 + (tid & 127)] = (ksum[tid] + ksum[256 + tid]) * (1.0f / 256.0f); }
        }
    }
};
struct EpiGlu {
    static constexpr bool PERM = true;
    bf16* mixed; const bf16* y5; const bf16* proj;
    struct Pre {};
    __device__ __forceinline__ Pre pre(const pg8::Unit&, int) const { return Pre{}; }
    __device__ __forceinline__ void operator()(const f32x4 (&acc)[2][2][4][2], const pg8::Unit& u, int wr, int wc, int fr, int fq, const Pre&) const {
        const int row0 = u.pm * 256 + wr * 64 + fr, col0 = u.pn * 256 + wc * 32 + 8 * fq;
#pragma unroll
        for (int ai = 0; ai < 2; ++ai) {
            u32x4 yv[4][2], zv[4][2];
#pragma unroll
            for (int m = 0; m < 4; ++m)
#pragma unroll
                for (int bj = 0; bj < 2; ++bj) { const size_t row = (size_t)(row0 + ai * 128 + m * 16); const int col = col0 + bj * 128;
                    yv[m][bj] = *(const u32x4*)(y5 + row * 1024 + col); zv[m][bj] = *(const u32x4*)(proj + row * NP + O_SZ + col); }
            asm volatile("" ::: "memory");
#pragma unroll
            for (int m = 0; m < 4; ++m) {
                const size_t row = (size_t)(row0 + ai * 128 + m * 16);
#pragma unroll
                for (int bj = 0; bj < 2; ++bj) {
                    const int col = col0 + bj * 128;
                    float o[8];
#pragma unroll
                    for (int e = 0; e < 8; ++e) {
                        const float a = (e < 4) ? acc[ai][bj][m][0][e & 3] : acc[ai][bj][m][1][e & 3];
                        const unsigned yw = yv[m][bj][e >> 1], zw = zv[m][bj][e >> 1];
                        const float y = (e & 1) ? __uint_as_float(yw & 0xffff0000u) : __uint_as_float(yw << 16);
                        const float z = (e & 1) ? __uint_as_float(zw & 0xffff0000u) : __uint_as_float(zw << 16);
                        o[e] = y * sigmoidf_(a) * siluf_(z);
                    }
                    u32x4 w; w.x = pg8::cvt_pk_bf16(o[0], o[1]); w.y = pg8::cvt_pk_bf16(o[2], o[3]); w.z = pg8::cvt_pk_bf16(o[4], o[5]); w.w = pg8::cvt_pk_bf16(o[6], o[7]);
                    *(u32x4*)(mixed + row * DM + 1024 + col) = w;
                }
            }
        }
    }
};
struct EpiOut {
    static constexpr bool PERM = true;
    float* out; bf16* xb; float* ssqp; int last;
    struct Pre {};
    __device__ __forceinline__ Pre pre(const pg8::Unit&, int) const { return Pre{}; }
    __device__ __forceinline__ void operator()(const f32x4 (&acc)[2][2][4][2], const pg8::Unit& u, int wr, int wc, int fr, int fq, const Pre&) const {
        const int row0 = u.pm * 256 + wr * 64 + fr, col0 = u.pn * 256 + wc * 32 + 8 * fq;
#pragma unroll
        for (int ai = 0; ai < 2; ++ai) {
            u32x4 xv[4][2];
#pragma unroll
            for (int m = 0; m < 4; ++m)
#pragma unroll
                for (int bj = 0; bj < 2; ++bj) xv[m][bj] = *(const u32x4*)(xb + (size_t)(row0 + ai * 128 + m * 16) * DM + col0 + bj * 128);
            asm volatile("" ::: "memory");
#pragma unroll
            for (int m = 0; m < 4; ++m) {
                const size_t row = (size_t)(row0 + ai * 128 + m * 16);
                float ss = 0.f;
#pragma unroll
                for (int bj = 0; bj < 2; ++bj) {
                    const size_t off = row * DM + col0 + bj * 128;
                    const u32x4 xw = xv[m][bj];
                    f32x4 a, b;
                    a[0] = __uint_as_float(xw.x << 16) + acc[ai][bj][m][0][0]; a[1] = __uint_as_float(xw.x & 0xffff0000u) + acc[ai][bj][m][0][1];
                    a[2] = __uint_as_float(xw.y << 16) + acc[ai][bj][m][0][2]; a[3] = __uint_as_float(xw.y & 0xffff0000u) + acc[ai][bj][m][0][3];
                    b[0] = __uint_as_float(xw.z << 16) + acc[ai][bj][m][1][0]; b[1] = __uint_as_float(xw.z & 0xffff0000u) + acc[ai][bj][m][1][1];
                    b[2] = __uint_as_float(xw.w << 16) + acc[ai][bj][m][1][2]; b[3] = __uint_as_float(xw.w & 0xffff0000u) + acc[ai][bj][m][1][3];
                    if (last) { *(f32x4*)(out + off) = a; *(f32x4*)(out + off + 4) = b; }
                    else {
                        ss += ((a[0] * a[0] + a[1] * a[1]) + (a[2] * a[2] + a[3] * a[3])) + ((b[0] * b[0] + b[1] * b[1]) + (b[2] * b[2] + b[3] * b[3]));
                        u32x4 w; w.x = pg8::cvt_pk_bf16(a[0], a[1]); w.y = pg8::cvt_pk_bf16(a[2], a[3]); w.z = pg8::cvt_pk_bf16(b[0], b[1]); w.w = pg8::cvt_pk_bf16(b[2], b[3]);
                        *(u32x4*)(xb + off) = w;
                    }
                }
                if (!last) {
                    ss += __shfl_xor(ss, 16); ss += __shfl_xor(ss, 32);
                    if (fq == 0) ssqp[row * 32 + u.pn * 4 + wc] = ss;
                }
            }
        }
    }
};

struct Params {
    const float* in[25];
    float* out;
    unsigned char* ws;
    int ph_lo, ph_hi;
};
constexpr int LDS_BYTES = 147456;
constexpr int NWAVES = 8;

namespace a1 { __device__ __forceinline__ void prep_w1(const Params& P, LAS unsigned char* lds); }
namespace s5 { __device__ __forceinline__ void tables_task(const Params& P, LAS unsigned char* lds, const int l, const int g, const int part); }
__device__ __forceinline__ void p0_transpose_item(const float* W, int ldsrc, int srccol0, int K, const float* kscale, bf16* WT, int n0, int k0, LAS float* scr, int lane) {
    float tv[32];
#pragma unroll
    for (int i = 0; i < 32; ++i) tv[i] = W[(size_t)(k0 + 2 * i + (lane >> 5)) * ldsrc + srccol0 + (lane & 31)];
#pragma unroll
    for (int i = 0; i < 32; ++i) { const int kk = 2 * i + (lane >> 5); float v = tv[i]; if (kscale) v *= kscale[k0 + kk]; scr[kk * 33 + (lane & 31)] = v; }
    asm volatile("s_waitcnt lgkmcnt(0)" ::: "memory");
    const int c = lane & 7;
#pragma unroll
    for (int j = 0; j < 4; ++j) { const int n = (lane >> 3) + 8 * j; const LAS float* s = scr + (8 * c) * 33 + n;
        u32x4 o; o.x = pk2(s[0 * 33], s[1 * 33]); o.y = pk2(s[2 * 33], s[3 * 33]); o.z = pk2(s[4 * 33], s[5 * 33]); o.w = pk2(s[6 * 33], s[7 * 33]);
        *(u32x4*)(WT + (size_t)(n0 + n) * K + k0 + 8 * c) = o; }
    asm volatile("s_waitcnt lgkmcnt(0)" ::: "memory");
}
__device__ __forceinline__ void phase_prep(const Params& P, LAS unsigned char* lds) {
    const int tid = otid(), lane = tid & 63, wave = tid >> 6;
    LAS float* scr = (LAS float*)(lds + wave * 16384);
    const int gw = blockIdx.x * NWAVES + wave, NGW = gridDim.x * NWAVES;
    constexpr int I_IN = (DM / 64) * (NP / 32), I_OUT = (DM / 64) * (DM / 32), I_GLU = (1024 / 64) * (1024 / 32);
    constexpr int PER_L = I_IN + I_OUT + I_GLU;
    for (int pass = 0; pass < 2; ++pass) {
    if ((pass == 0) == ((blockIdx.x & 1) == 0)) {
    for (int it = gw; it < NL * PER_L; it += NGW) {
        const int l = it / PER_L; int r = it % PER_L;
        if (r < I_IN) { const int nb = r % (NP / 32), kb = r / (NP / 32), n0 = nb * 32, src = n0 + (n0 >= SRC_NG ? 12 : 0);
            p0_transpose_item(P.in[2] + (size_t)l * DM * INW, INW, src, DM, P.in[1] + l * DM, (bf16*)(P.ws + WS_WIN + l * WIN_BYTES), n0, kb * 64, scr, lane); continue; }
        r -= I_IN;
        if (r < I_OUT) { const int nb = r % (DM / 32), kb = r / (DM / 32);
            p0_transpose_item(P.in[3] + (size_t)l * DM * DM, DM, nb * 32, DM, nullptr, (bf16*)(P.ws + WS_WOUT + l * WOUT_BYTES), nb * 32, kb * 64, scr, lane); continue; }
        r -= I_OUT;
        { const int nb = r % 32, kb = r / 32;
            p0_transpose_item(P.in[24] + (size_t)l * 1024 * 1024, 1024, nb * 32, 1024, nullptr, (bf16*)(P.ws + WS_GLU + l * GLU_BYTES), nb * 32, kb * 64, scr, lane); }
    }
    const float* x = P.in[0]; bf16* xb = (bf16*)(P.ws + WS_XB); float* rs = (float*)(P.ws + WS_RS);
    for (int m = gw; m < NT; m += NGW) {
        const f32x4* xr = (const f32x4*)(x + (size_t)m * DM) + lane;
        u32x2* o8 = (u32x2*)(xb + (size_t)m * DM) + lane;
        float s = 0.f;
#pragma unroll
        for (int hq = 0; hq < 2; ++hq) {
            f32x4 xv[4];
#pragma unroll
            for (int j = 0; j < 4; ++j) xv[j] = xr[64 * (4 * hq + j)];
            __builtin_amdgcn_sched_barrier(0);
#pragma unroll
            for (int j = 0; j < 4; ++j) { const f32x4 v = xv[j]; s += (v[0] * v[0] + v[1] * v[1]) + (v[2] * v[2] + v[3] * v[3]); u32x2 w; w.x = pk2(v[0], v[1]); w.y = pk2(v[2], v[3]); o8[64 * (4 * hq + j)] = w; }
            __builtin_amdgcn_sched_barrier(0);
        }
        s = wave_sum(s);
        if (lane == 0) rs[m] = 1.0f / sqrtf(s * (1.0f / DM) + EPSN);
    }
    float2* cs = (float2*)(P.ws + WS_ROPE);
    for (int i = blockIdx.x * blockDim.x + tid; i < SEQ * 16; i += gridDim.x * blockDim.x) {
        double s, c; dsincos((double)(i >> 4) * INVF[i & 15], s, c); cs[i] = make_float2((float)c, (float)s);
    }
    } else {
        for (int t = blockIdx.x; t < NL * 64 * 4; t += gridDim.x) s5::tables_task(P, lds, t >> 8, (t >> 2) & 63, t & 3);
    }
    __syncthreads();
    }
    a1::prep_w1(P, lds);
    if (blockIdx.x == 0) {
        int* order = (int*)(P.ws + WS_ORDER);
        const int u = tid; const int cu = (u < 256) ? (2 * (u & 63) + 46) : (8 * ((u - 256) & 15) + 9);
        int rank = 0;
        for (int v = 0; v < 512; ++v) { const int cv = (v < 256) ? (2 * (v & 63) + 46) : (8 * ((v - 256) & 15) + 9); rank += (cv > cu || (cv == cu && v < u)) ? 1 : 0; }
        order[rank] = u;
    }
}

__device__ __forceinline__ void phase_gemm1(const Params& P, LAS unsigned char* lds, int l) {
    pg8::Gemm g{(const bf16*)(P.ws + WS_XB), (const bf16*)(P.ws + WS_WIN + l * WIN_BYTES), NT, NP, DM, DM};
    pg8::StaticOrder S; S.init(NT, NP, gridDim.x, blockIdx.x, 1);
    if (l > 0) {
        const int tid = otid(); float* rs = (float*)(P.ws + WS_RS); const float* ssqp = (const float*)(P.ws + WS_SSQP);
        int lastpm = -1;
        for (int i = 0; ; ++i) { pg8::Unit u; if (!S.next(i, u)) break;
            if (u.pm != lastpm) { lastpm = u.pm;
                if (tid < 256) { const f32x4* sp = (const f32x4*)(ssqp + (size_t)(u.pm * 256 + tid) * 32); f32x4 v[8];
#pragma unroll
                    for (int q = 0; q < 8; ++q) v[q] = sp[q];
                    float sm = 0.f;
#pragma unroll
                    for (int q = 0; q < 8; ++q) sm += (v[q][0] + v[q][1]) + (v[q][2] + v[q][3]);
                    rs[u.pm * 256 + tid] = 1.0f / sqrtf(sm * (1.0f / DM) + EPSN); } } }
        asm volatile("s_waitcnt vmcnt(0)" ::: "memory"); __syncthreads();
    }
    EpiProj E{(bf16*)(P.ws + WS_PROJ), (bf16*)(P.out + SUG_OFF), (const float*)(P.ws + WS_RS), P.in[4] + l * 128, P.in[5] + l * 128, P.in[6] + l * 128, P.in[8] + l * 128, P.in[9] + l * 128,
              (const float2*)(P.ws + WS_ROPE), (float*)(P.ws + WS_KMEAN), lds + 131072};
    pg8::gemm_phase<EpiProj, pg8::StaticOrder>(lds, g, S, E);
}
__device__ __forceinline__ void phase_out(const Params& P, LAS unsigned char* lds, int l) {
    pg8::Gemm g{(const bf16*)(P.ws + WS_MIXED), (const bf16*)(P.ws + WS_WOUT + l * WOUT_BYTES), NT, DM, DM, DM};
    pg8::StaticOrder S; S.init(NT, DM, gridDim.x, blockIdx.x);
    EpiOut E{P.out, (bf16*)(P.ws + WS_XB), (float*)(P.ws + WS_SSQP), l == NL - 1 ? 1 : 0};
    pg8::gemm_phase<EpiOut, pg8::StaticOrder>(lds, g, S, E);
}

namespace att {
typedef short s16x4 __attribute__((ext_vector_type(4)));
typedef float f32x16 __attribute__((ext_vector_type(16)));
constexpr int SHM_K = 16384, SHM_V = 16384;
constexpr int OFF_V = 0, OFF_K = 2 * SHM_V, OFF_WS = 2 * SHM_V + 2 * SHM_K;
constexpr int OFF_X = OFF_WS + 8 * 256;
constexpr unsigned WINF = 0x7fffffffu;
constexpr float THR = 8.f;
#define KSWZ(row, colB) ((row) * 256 + ((colB) ^ (((row) & 7) << 4)))
#define SBAR() __builtin_amdgcn_sched_barrier(0)
#define LDSBAR() do { asm volatile("s_waitcnt lgkmcnt(0)" ::: "memory"); __builtin_amdgcn_s_barrier(); asm volatile("" ::: "memory"); } while (0)
__device__ __forceinline__ int v_st(int k, int c) { const int kk = (k & ~0xC) | ((k & 4) << 1) | ((k & 8) >> 1); return ((kk >> 3) * 4 + (c >> 5)) * 512 + ((kk & 7) * 32 + (c & 31)) * 2; }
__device__ __forceinline__ int v_rd_base(int lane) { return ((lane & 3) << 3) | (((lane >> 2) & 3) << 6) | (((lane >> 4) & 1) << 5) | (((lane >> 5) & 1) << 8); }
constexpr int v_rd_off(int d0, int ks, int half) { return d0 * 512 + ks * 4096 + half * 2048; }
__device__ __forceinline__ int crow(int r, int hi) { return (r & 3) + 8 * (r >> 2) + 4 * hi; }
__device__ __forceinline__ unsigned cvtpk(float lo, float hi) { unsigned r; asm volatile("v_cvt_pk_bf16_f32 %0, %1, %2" : "=v"(r) : "v"(lo), "v"(hi)); return r; }

__device__ __forceinline__ void mask_tile(f32x16& p0, f32x16& p1, int dq, unsigned W) {
    const float NEG = -__builtin_inff();
#pragma unroll
    for (int r = 0; r < 16; ++r) {
        const int c = (r & 3) + 8 * (r >> 2);
        if ((unsigned)(dq - c) >= W) p0[r] = NEG;
        if ((unsigned)(dq - c - 32) >= W) p1[r] = NEG;
    }
}
__device__ __forceinline__ void qkt(f32x16& p0, f32x16& p1, LAS const unsigned char* Kb, int r32, int hi, const bf16x8* qr) {
    p0 = f32x16{}; p1 = f32x16{};
    const int ka0 = (int)(uintptr_t)(Kb + KSWZ(r32, (0 * 16 + hi * 8) * 2)), ka1 = (int)(uintptr_t)(Kb + KSWZ(r32, (1 * 16 + hi * 8) * 2));
    const int ka2 = (int)(uintptr_t)(Kb + KSWZ(r32, (2 * 16 + hi * 8) * 2)), ka3 = (int)(uintptr_t)(Kb + KSWZ(r32, (3 * 16 + hi * 8) * 2));
#define Q_KR(dst, addr, off) asm volatile("ds_read_b128 %0, %1 offset:%2" : "=&v"(dst) : "v"(addr), "i"(off) : "memory")
#define Q_KRD(F, kaa, kab, hoff) do { Q_KR(F[0], kaa, hoff); Q_KR(F[1], kaa, hoff + 8192); Q_KR(F[2], kab, hoff); Q_KR(F[3], kab, hoff + 8192); } while (0)
#define Q_WAIT() do { asm volatile("s_waitcnt lgkmcnt(0)" ::: "memory"); SBAR(); } while (0)
#define Q_QK(F, q0) do { \
        p0 = __builtin_amdgcn_mfma_f32_32x32x16_bf16(F[0], qr[q0], p0, 0, 0, 0); p1 = __builtin_amdgcn_mfma_f32_32x32x16_bf16(F[1], qr[q0], p1, 0, 0, 0); \
        p0 = __builtin_amdgcn_mfma_f32_32x32x16_bf16(F[2], qr[q0 + 1], p0, 0, 0, 0); p1 = __builtin_amdgcn_mfma_f32_32x32x16_bf16(F[3], qr[q0 + 1], p1, 0, 0, 0); } while (0)
    bf16x8 FA[4], FB[4];
    Q_KRD(FA, ka0, ka1, 0); Q_WAIT();
    Q_KRD(FB, ka2, ka3, 0); Q_QK(FA, 0); Q_WAIT();
    Q_KRD(FA, ka0, ka1, 128); Q_QK(FB, 2); Q_WAIT();
    Q_KRD(FB, ka2, ka3, 128); Q_QK(FA, 4); Q_WAIT();
    Q_QK(FB, 6);
#undef Q_KR
#undef Q_KRD
#undef Q_WAIT
#undef Q_QK
}
__device__ __forceinline__ void pv_tile(f32x16* o, int vb, bf16x8 pa0, bf16x8 pa1, bf16x8 pa2, bf16x8 pa3) {
#define TRRD(dst, off) asm volatile("ds_read_b64_tr_b16 %0, %1 offset:%2" : "=&v"(dst) : "v"(vb), "i"(off) : "memory")
#define PV_D0(d0) do { s16x4 l0, l1, l2, l3, h0, h1, h2, h3; constexpr int b_ = v_rd_off(d0, 0, 0); \
        TRRD(l0, b_); TRRD(h0, b_ + 2048); TRRD(l1, b_ + 4096); TRRD(h1, b_ + 6144); TRRD(l2, b_ + 8192); TRRD(h2, b_ + 10240); TRRD(l3, b_ + 12288); TRRD(h3, b_ + 14336); \
        asm volatile("s_waitcnt lgkmcnt(0)" ::: "memory"); SBAR(); \
        o[d0] = __builtin_amdgcn_mfma_f32_32x32x16_bf16(pa0, (bf16x8){l0[0], l0[1], l0[2], l0[3], h0[0], h0[1], h0[2], h0[3]}, o[d0], 0, 0, 0); \
        o[d0] = __builtin_amdgcn_mfma_f32_32x32x16_bf16(pa1, (bf16x8){l1[0], l1[1], l1[2], l1[3], h1[0], h1[1], h1[2], h1[3]}, o[d0], 0, 0, 0); \
        o[d0] = __builtin_amdgcn_mfma_f32_32x32x16_bf16(pa2, (bf16x8){l2[0], l2[1], l2[2], l2[3], h2[0], h2[1], h2[2], h2[3]}, o[d0], 0, 0, 0); \
        o[d0] = __builtin_amdgcn_mfma_f32_32x32x16_bf16(pa3, (bf16x8){l3[0], l3[1], l3[2], l3[3], h3[0], h3[1], h3[2], h3[3]}, o[d0], 0, 0, 0); } while (0)
    PV_D0(0); PV_D0(1); PV_D0(2); PV_D0(3);
#undef PV_D0
#undef TRRD
}

struct Stage4 { bf16x8 k0, k1, v0, v1; };
__device__ __forceinline__ Stage4 att_preload(const bf16* Kp, const bf16* Vp, const int kvs, const int j) {
    const int tid = otid(), sr = tid >> 4, sc = (tid & 15) * 8;
    const size_t r0 = (size_t)(j * 64 + sr) * kvs + sc, r1 = r0 + (size_t)32 * kvs;
    Stage4 s; s.v0 = *(const bf16x8*)(Vp + r0); s.v1 = *(const bf16x8*)(Vp + r1); s.k0 = *(const bf16x8*)(Kp + r0); s.k1 = *(const bf16x8*)(Kp + r1); return s;
}
template <bool IMP>
__device__ __forceinline__ void attn_tiles(LAS unsigned char* lds, const bf16x8 (&qr)[8], const bf16* Kp, const bf16* Vp, const int kvs,
                                           unsigned long long tilemask, const int pos, const int wlo, const int whi, const unsigned W,
                                           const unsigned long long rowmask, const int shift,
                                           f32x16 (&o)[4], float& m_reg, float& l_reg, float (&imp)[32], const bool has_pre = false, const Stage4 pre = Stage4{}) {
    const int tid = otid(), wid = __builtin_amdgcn_readfirstlane(tid >> 6), lane = tid & 63, r32 = lane & 31, hi = lane >> 5;
    LAS unsigned char* V_lds = lds + OFF_V; LAS unsigned char* K_lds = lds + OFF_K;
    LAS float* al_l = (LAS float*)(lds + OFF_WS) + wid * 64 + 32;
    const int sr = tid >> 4, sc = (tid & 15) * 8;
    const int vst0 = v_st(sr, sc), vst1 = v_st(32 + sr, sc), kws = KSWZ(sr, sc * 2);
    const int vb0 = (int)(uintptr_t)V_lds + v_rd_base(lane);
    const int qm = pos - 4 * hi;
    constexpr float C2 = 1.4426950408889634f * SCALE;
    bf16x8 st_k0, st_k1, st_v0, st_v1;
#define A_LOAD(j_) do { const size_t r0_ = (size_t)((j_) * 64 + sr) * kvs + sc, r1_ = r0_ + (size_t)32 * kvs; \
        st_v0 = *(const bf16x8*)(Vp + r0_); st_v1 = *(const bf16x8*)(Vp + r1_); st_k0 = *(const bf16x8*)(Kp + r0_); st_k1 = *(const bf16x8*)(Kp + r1_); } while (0)
#define A_WRITE(bf_) do { *(LAS bf16x8*)(K_lds + (bf_) * SHM_K + kws) = st_k0; *(LAS bf16x8*)(K_lds + (bf_) * SHM_K + kws + 32 * 256) = st_k1; \
        *(LAS bf16x8*)(V_lds + (bf_) * SHM_V + vst0) = st_v0; *(LAS bf16x8*)(V_lds + (bf_) * SHM_V + vst1) = st_v1; } while (0)
    if (tilemask == 0ull) return;
    int j = __ffsll((long long)tilemask) - 1; tilemask &= tilemask - 1;
    if (has_pre) { st_k0 = pre.k0; st_k1 = pre.k1; st_v0 = pre.v0; st_v1 = pre.v1; } else A_LOAD(j);
    A_WRITE(0);
    LDSBAR();
    int jn = -1;
    if (tilemask) { jn = __ffsll((long long)tilemask) - 1; tilemask &= tilemask - 1; A_LOAD(jn); }
    int buf = 0; float carry = 0.f;
    for (;;) {
        const int kb = j * 64;
        const bool act = (kb <= whi) && ((long long)kb + 63 + (long long)W > (long long)wlo);
        if (act) {
            f32x16 p0, p1;
            SBAR(); qkt(p0, p1, K_lds + buf * SHM_K, r32, hi, qr); SBAR();
            const bool needm = (kb + 63 > wlo) || ((long long)kb + (long long)W <= (long long)whi);
            if (needm) { asm volatile("; boundary tile" ::: "memory"); mask_tile(p0, p1, qm - kb, W); }
            const bool rowsel = ((rowmask >> (kb >> shift)) & 1ull) != 0ull;
            const bool softsel = !needm;
            if (!softsel && !__all(rowsel)) { asm volatile("; row-select mask" ::: "memory"); const float NEG = -__builtin_inff();
#pragma unroll
                for (int r = 0; r < 16; ++r) { p0[r] = rowsel ? p0[r] : NEG; p1[r] = rowsel ? p1[r] : NEG; } }
            float pmax;
            { float m0 = fmaxf(fmaxf(p0[0], p0[1]), p0[2]), m1 = fmaxf(fmaxf(p0[3], p0[4]), p0[5]), m2 = fmaxf(fmaxf(p0[6], p0[7]), p0[8]), m3 = fmaxf(fmaxf(p0[9], p0[10]), p0[11]);
              float m4 = fmaxf(fmaxf(p0[12], p0[13]), p0[14]), m5 = fmaxf(fmaxf(p0[15], p1[0]), p1[1]), m6 = fmaxf(fmaxf(p1[2], p1[3]), p1[4]), m7 = fmaxf(fmaxf(p1[5], p1[6]), p1[7]);
              float m8 = fmaxf(fmaxf(p1[8], p1[9]), p1[10]), m9 = fmaxf(fmaxf(p1[11], p1[12]), p1[13]), ma = fmaxf(p1[14], p1[15]);
              m0 = fmaxf(fmaxf(m0, m1), m2); m3 = fmaxf(fmaxf(m3, m4), m5); m6 = fmaxf(fmaxf(m6, m7), m8); m9 = fmaxf(m9, ma);
              pmax = fmaxf(fmaxf(m0, m3), fmaxf(m6, m9)); }
            { auto rr = __builtin_amdgcn_permlane32_swap(__float_as_uint(pmax), __float_as_uint(pmax), false, false);
              pmax = fmaxf(__uint_as_float(rr[0]), __uint_as_float(rr[1])); }
            if (softsel && !rowsel) pmax = -__builtin_inff();
            float mn, alpha;
            if (__all((pmax - m_reg) * SCALE <= THR)) { mn = m_reg; alpha = 1.f; }
            else { mn = fmaxf(m_reg, pmax); alpha = __builtin_amdgcn_exp2f((m_reg - mn) * C2); m_reg = mn; }
            const bool off_ = softsel && !rowsel;
            const float mnL = off_ ? -__builtin_inff() : -mn * C2, c2e = off_ ? 0.f : C2;
#pragma unroll
            for (int r = 0; r < 16; ++r) { p0[r] = __builtin_amdgcn_exp2f(fmaf(p0[r], c2e, mnL)); p1[r] = __builtin_amdgcn_exp2f(fmaf(p1[r], c2e, mnL)); }
            float ps;
            { float s0 = (p0[0] + p0[1]) + (p0[2] + p0[3]), s1 = (p0[4] + p0[5]) + (p0[6] + p0[7]), s2 = (p0[8] + p0[9]) + (p0[10] + p0[11]), s3 = (p0[12] + p0[13]) + (p0[14] + p0[15]);
              float s4 = (p1[0] + p1[1]) + (p1[2] + p1[3]), s5_ = (p1[4] + p1[5]) + (p1[6] + p1[7]), s6 = (p1[8] + p1[9]) + (p1[10] + p1[11]), s7 = (p1[12] + p1[13]) + (p1[14] + p1[15]);
              ps = ((s0 + s1) + (s2 + s3)) + ((s4 + s5_) + (s6 + s7)); }
            { auto rr = __builtin_amdgcn_permlane32_swap(__float_as_uint(ps), __float_as_uint(ps), false, false);
              ps = __uint_as_float(rr[0]) + __uint_as_float(rr[1]); }
            l_reg = l_reg * alpha + ps;
            if (__any(alpha < 1.f)) {
                asm volatile("; rescale" ::: "memory");
                if (hi == 0) al_l[r32] = alpha;
                asm volatile("s_waitcnt lgkmcnt(0)" ::: "memory");
#pragma unroll
                for (int r = 0; r < 16; ++r) { const float a = al_l[crow(r, hi)];
#pragma unroll
                    for (int d_ = 0; d_ < 4; ++d_) o[d_][r] *= a; }
            }
            if constexpr (IMP) {
                float e3[4], f3[4], s0[4], s1[4];
#pragma unroll
                for (int q = 0; q < 4; ++q) { e3[q] = __shfl_xor(p0[4 * q + 3], 32); f3[q] = __shfl_xor(p1[4 * q + 3], 32);
                    s0[q] = (p0[4 * q] + p0[4 * q + 1]) + (p0[4 * q + 2] + p0[4 * q + 3]); s1[q] = (p1[4 * q] + p1[4 * q + 1]) + (p1[4 * q + 2] + p1[4 * q + 3]); }
                carry *= alpha;
#pragma unroll
                for (int q = 0; q < 4; ++q) {
                    s0[q] += hi ? e3[q] : (q > 0 ? e3[q > 0 ? q - 1 : 0] : carry);
                    s1[q] += hi ? f3[q] : (q > 0 ? f3[q > 0 ? q - 1 : 0] : e3[3]);
                }
                carry = f3[3];
#pragma unroll
                for (int i = 0; i < 32; ++i) imp[i] *= alpha;
#pragma unroll
                for (int tt = 0; tt < 4; ++tt) if (j == tt) {
#pragma unroll
                    for (int q = 0; q < 4; ++q) { imp[(tt * 2 + 0) * 4 + q] += s0[q]; imp[(tt * 2 + 1) * 4 + q] += s1[q]; } }
            }
            bf16x8 pa0, pa1, pa2, pa3;
#define PK4(P_, B_, OUT) do { const unsigned a0 = cvtpk(P_[B_ + 0], P_[B_ + 1]), a1 = cvtpk(P_[B_ + 2], P_[B_ + 3]); \
        const unsigned b0 = cvtpk(P_[B_ + 4], P_[B_ + 5]), b1 = cvtpk(P_[B_ + 6], P_[B_ + 7]); \
        auto r0 = __builtin_amdgcn_permlane32_swap(a0, b0, false, false); auto r1 = __builtin_amdgcn_permlane32_swap(a1, b1, false, false); \
        u32x4 w = {r0[0], r1[0], r0[1], r1[1]}; OUT = *reinterpret_cast<bf16x8*>(&w); } while (0)
            PK4(p0, 0, pa0); PK4(p0, 8, pa1); PK4(p1, 0, pa2); PK4(p1, 8, pa3);
#undef PK4
            SBAR();
            pv_tile(o, vb0 + buf * SHM_V, pa0, pa1, pa2, pa3);
        } else if (IMP) carry = 0.f;
        if (jn < 0) break;
        A_WRITE(buf ^ 1);
        LDSBAR();
        j = jn; buf ^= 1;
        if (tilemask) { jn = __ffsll((long long)tilemask) - 1; tilemask &= tilemask - 1; A_LOAD(jn); } else jn = -1;
    }
    LDSBAR();
#undef A_LOAD
#undef A_WRITE
}

template <int BR>
__device__ __forceinline__ void nsa_epi(const f32x16 (&o)[4], const float il, LAS float* li_l, unsigned (&oacc)[4][8], const float* gt, int r32, int hi, bf16* mixed, const bf16* zb) {
    asm volatile("" : "+v"(r32), "+v"(hi));
    if (hi == 0) li_l[r32] = il;
    asm volatile("s_waitcnt lgkmcnt(0)" ::: "memory");
    if constexpr (BR < 2) {
        float sv[16];
#pragma unroll
        for (int r = 0; r < 16; ++r) { const int rw = crow(r, hi); sv[r] = li_l[rw] * gt[rw * 12 + BR]; }
#pragma unroll
        for (int d0 = 0; d0 < 4; ++d0)
#pragma unroll
            for (int r = 0; r < 16; r += 2) {
                float a0 = o[d0][r] * sv[r], a1 = o[d0][r + 1] * sv[r + 1];
                if (BR == 1) { const unsigned w = oacc[d0][r >> 1]; a0 += __uint_as_float(w << 16); a1 += __uint_as_float(w & 0xffff0000u); }
                oacc[d0][r >> 1] = cvtpk(a0, a1); }
    } else {
#pragma unroll
        for (int rh = 0; rh < 2; ++rh) {
            float sv[8], zv[8][4];
#pragma unroll
            for (int q = 0; q < 8; ++q) { const int r = rh * 8 + q, rw = crow(r, hi);
                sv[q] = li_l[rw] * gt[rw * 12 + BR];
#pragma unroll
                for (int d0 = 0; d0 < 4; ++d0) zv[q][d0] = bf2f(zb[(size_t)rw * NP + d0 * 32 + r32]); }
#pragma unroll
            for (int q = 0; q < 8; ++q) { const int r = rh * 8 + q, rw = crow(r, hi);
#pragma unroll
                for (int d0 = 0; d0 < 4; ++d0) { const int col = d0 * 32 + r32;
                    const unsigned w = oacc[d0][r >> 1];
                    const float ac = (r & 1) ? __uint_as_float(w & 0xffff0000u) : __uint_as_float(w << 16);
                    const float v = (ac + o[d0][r] * sv[q]) * siluf_(zv[q][d0]);
                    const float vn = __shfl_xor(v, 1);
                    if ((r32 & 1) == 0) *(unsigned*)(mixed + (size_t)rw * DM + col) = cvtpk(v, vn); } }
            asm volatile("" ::: "memory");
        }
    }
}

__device__ __forceinline__ void nsa_unit(const Params& P, LAS unsigned char* lds, const int b, const int c) {
    const int tid = otid(), wid = __builtin_amdgcn_readfirstlane(tid >> 6), lane = tid & 63, r32 = lane & 31, hi = lane >> 5;
    const int head = wid >> 1, half = wid & 1;
    const int t_base = c * 64, trow = t_base + half * 32, pos = trow + r32;
    const bf16* proj = (const bf16*)(P.ws + WS_PROJ);
    const bf16* pb = proj + (size_t)b * SEQ * NP;
    const bf16* prow = pb + (size_t)pos * NP;
    bf16x8 qr[8];
#pragma unroll
    for (int d0 = 0; d0 < 8; ++d0) qr[d0] = *(const bf16x8*)(prow + O_NQ + head * 128 + d0 * 16 + hi * 8);
    LAS float* li_l = (LAS float*)(lds + OFF_WS) + wid * 64;
    unsigned oacc[4][8];
    const float* gt = (const float*)(P.ws + WS_GATES) + (size_t)(b * SEQ + trow) * 12 + head * 3;
    const bf16* cmpk = (const bf16*)(P.ws + WS_CMPB) + (size_t)(0 * NB + b) * 256 * 128;
    const bf16* cmpv = (const bf16*)(P.ws + WS_CMPB) + (size_t)(1 * NB + b) * 256 * 128;
    f32x16 o[4]; float m_reg, l_reg;
    float dummy[32];
    Stage4 pre_sel, pre_win;
    {
        float imp[32];
#pragma unroll
        for (int i = 0; i < 32; ++i) imp[i] = 0.f;
#pragma unroll
        for (int d = 0; d < 4; ++d) o[d] = f32x16{};
        m_reg = -1e30f; l_reg = 0.f;
        const int posc = (pos - 31) >> 4, wloc = (trow - 31) >> 4, whic = trow >> 4;
        const int maxc = (t_base + 32) >> 4;
        const int ntile = (maxc >> 6) + 1;
        attn_tiles<true>(lds, qr, cmpk, cmpv, 128, (1ull << ntile) - 1ull, posc, wloc, whic, WINF, ~0ull, 12, o, m_reg, l_reg, imp);
        const float il = l_reg > 0.f ? 1.f / l_reg : 0.f;
        pre_sel = att_preload(pb + O_KS, pb + O_VS, NP, 0); __builtin_amdgcn_sched_barrier(0);
        nsa_epi<0>(o, il, li_l, oacc, gt, r32, hi, nullptr, nullptr);
        LAS float* impH = (LAS float*)lds;
        LAS float* ih = impH + ((head * 64 + half * 32 + r32) * 64);
#pragma unroll
        for (int tt = 0; tt < 4; ++tt)
#pragma unroll
            for (int hh = 0; hh < 2; ++hh)
#pragma unroll
                for (int q = 0; q < 4; ++q) ih[tt * 16 + hh * 8 + 2 * q + hi] = imp[(tt * 2 + hh) * 4 + q] * il;
    }
    LDSBAR();
    LAS float* score = (LAS float*)(lds + OFF_X);
    LAS unsigned char* selb = lds + OFF_X + 64 * 65 * 4;
    LAS unsigned* un = (LAS unsigned*)(lds + OFF_X + 64 * 65 * 4 + 512);
    {
        const int row = tid >> 3, part = tid & 7;
        const LAS float* impH = (const LAS float*)lds;
#pragma unroll
        for (int e = 0; e < 8; ++e) { const int jj = part * 8 + e;
            float s = (impH[(0 * 64 + row) * 64 + jj] + impH[(1 * 64 + row) * 64 + jj]) + (impH[(2 * 64 + row) * 64 + jj] + impH[(3 * 64 + row) * 64 + jj]);
            if (jj > c) s = -__builtin_inff();
            if (jj == 0 || jj == c || jj == c - 1) s = __builtin_inff();
            score[row * 65 + jj] = s; }
        if (tid < 2) un[tid] = 0u;
        LDSBAR();
        float sv[64];
#pragma unroll
        for (int j2 = 0; j2 < 64; ++j2) sv[j2] = score[row * 65 + j2];
        unsigned byte = 0u;
#pragma unroll
        for (int e = 0; e < 8; ++e) { const int jj = part * 8 + e; const float sj = score[row * 65 + jj]; int rank = 0;
#pragma unroll
            for (int j2 = 0; j2 < 64; ++j2) rank += (sv[j2] > sj || (sv[j2] == sj && j2 < jj)) ? 1 : 0;
            if (rank < 16 && jj <= c) byte |= 1u << e; }
        selb[row * 8 + part] = (unsigned char)byte;
        __hip_atomic_fetch_or(&un[part >> 2], byte << (8 * (part & 3)), __ATOMIC_RELAXED, __HIP_MEMORY_SCOPE_WORKGROUP);
    }
    LDSBAR();
    const unsigned long long rowmask = *(const LAS unsigned long long*)(selb + (half * 32 + r32) * 8);
    const unsigned long long selt = (unsigned long long)un[0] | ((unsigned long long)un[1] << 32);
    {
#pragma unroll
        for (int d = 0; d < 4; ++d) o[d] = f32x16{};
        m_reg = -1e30f; l_reg = 0.f;
        attn_tiles<false>(lds, qr, pb + O_KS, pb + O_VS, NP, selt, pos, trow, trow + 31, WINF, rowmask, 6, o, m_reg, l_reg, dummy, (selt & 1ull) != 0ull, pre_sel);
        { const int lo_ = c > 8 ? c - 8 : 0; pre_win = att_preload(pb + O_KW, pb + O_VW, NP, lo_); __builtin_amdgcn_sched_barrier(0); }
        nsa_epi<1>(o, 1.f / l_reg, li_l, oacc, gt, r32, hi, nullptr, nullptr);
    }
    {
#pragma unroll
        for (int d = 0; d < 4; ++d) o[d] = f32x16{};
        m_reg = -1e30f; l_reg = 0.f;
        const int lo = c > 8 ? c - 8 : 0;
        const unsigned long long upto = (c == 63) ? ~0ull : ((1ull << (c + 1)) - 1ull);
        const unsigned long long wt = upto & ~((1ull << lo) - 1ull);
        attn_tiles<false>(lds, qr, pb + O_KW, pb + O_VW, NP, wt, pos, trow, trow + 31, 512u, ~0ull, 12, o, m_reg, l_reg, dummy, true, pre_win);
        bf16* mixed = (bf16*)(P.ws + WS_MIXED) + (size_t)(b * SEQ + trow) * DM + 512 + head * 128;
        const bf16* zb = pb + (size_t)trow * NP + O_NZ + head * 128;
        nsa_epi<2>(o, 1.f / l_reg, li_l, oacc, gt, r32, hi, mixed, zb);
    }
}

__device__ __forceinline__ void moba_unit(const Params& P, LAS unsigned char* lds, const int b, const int h, const int own) {
    const int tid = otid(), wid = __builtin_amdgcn_readfirstlane(tid >> 6), lane = tid & 63, r32 = lane & 31, hi = lane >> 5;
    const int trow = own * 256 + wid * 32, pos = trow + r32;
    const bf16* proj = (const bf16*)(P.ws + WS_PROJ);
    const bf16* pb = proj + (size_t)b * SEQ * NP;
    const bf16* prow = pb + (size_t)pos * NP;
    bf16x8 qr[8];
#pragma unroll
    for (int d0 = 0; d0 < 8; ++d0) qr[d0] = *(const bf16x8*)(prow + O_MQ + h * 128 + d0 * 16 + hi * 8);
    LAS float* li_l = (LAS float*)(lds + OFF_WS) + wid * 64;
    LAS float* kml = (LAS float*)(lds + OFF_X);
    LAS unsigned* un = (LAS unsigned*)(lds + OFF_X + 8192);
    {
        const f32x4* src = (const f32x4*)((const float*)(P.ws + WS_KMEAN) + (size_t)(b * 4 + h) * 16 * 128);
        ((LAS f32x4*)kml)[tid] = src[tid];
        if (tid == 0) un[0] = 0u;
    }
    LDSBAR();
    float g[15];
#pragma unroll
    for (int n = 0; n < 15; ++n) g[n] = 0.f;
#pragma unroll
    for (int d0 = 0; d0 < 8; ++d0) {
        float qf[8];
#pragma unroll
        for (int e = 0; e < 8; ++e) qf[e] = bf2f((bf16)qr[d0][e]);
#pragma unroll
        for (int n = 0; n < 15; ++n) if (n < own) {
            const f32x4 k0 = *(const LAS f32x4*)(kml + n * 128 + d0 * 16 + hi * 8), k1 = *(const LAS f32x4*)(kml + n * 128 + d0 * 16 + hi * 8 + 4);
            g[n] += (qf[0] * k0[0] + qf[1] * k0[1]) + (qf[2] * k0[2] + qf[3] * k0[3]) + (qf[4] * k1[0] + qf[5] * k1[1]) + (qf[6] * k1[2] + qf[7] * k1[3]);
        }
    }
#pragma unroll
    for (int n = 0; n < 15; ++n) { g[n] += __shfl_xor(g[n], 32); if (n >= own) g[n] = -__builtin_inff(); }
    unsigned sel = 1u << own;
#pragma unroll
    for (int n = 0; n < 15; ++n) { int rank = 0;
#pragma unroll
        for (int n2 = 0; n2 < 15; ++n2) rank += (g[n2] > g[n] || (g[n2] == g[n] && n2 < n)) ? 1 : 0;
        if (n < own && rank < 3) sel |= 1u << n; }
    __hip_atomic_fetch_or(&un[0], sel, __ATOMIC_RELAXED, __HIP_MEMORY_SCOPE_WORKGROUP);
    LDSBAR();
    const unsigned blocks = un[0];
    unsigned long long tmask = 0ull;
#pragma unroll
    for (int n = 0; n < 16; ++n) if ((blocks >> n) & 1u) tmask |= 0xFull << (4 * n);
    f32x16 o[4]; float m_reg = -1e30f, l_reg = 0.f; float dummy[32];
#pragma unroll
    for (int d = 0; d < 4; ++d) o[d] = f32x16{};
    attn_tiles<false>(lds, qr, pb + O_MK + h * 128, pb + O_MV + h * 128, NP, tmask, pos, trow, trow + 31, WINF, (unsigned long long)sel, 8, o, m_reg, l_reg, dummy);
    const float il = 1.f / l_reg;
    if (hi == 0) li_l[r32] = il;
    asm volatile("s_waitcnt lgkmcnt(0)" ::: "memory");
    bf16* mixed = (bf16*)(P.ws + WS_MIXED) + (size_t)(b * SEQ + trow) * DM + h * 128;
    const bf16* zb = pb + (size_t)trow * NP + O_MZ + h * 128;
#pragma unroll
    for (int rh = 0; rh < 1; ++rh) {
        float zv[16][4];
#pragma unroll
        for (int q = 0; q < 16; ++q) { const int rw = crow(q, hi);
#pragma unroll
            for (int d0 = 0; d0 < 4; ++d0) zv[q][d0] = bf2f(zb[(size_t)rw * NP + d0 * 32 + r32]); }
        asm volatile("" ::: "memory");
#pragma unroll
        for (int q = 0; q < 16; ++q) { const int r = q, rw = crow(r, hi); const float s = li_l[rw];
#pragma unroll
            for (int d0 = 0; d0 < 4; ++d0) { const int col = d0 * 32 + r32;
                const float v = o[d0][r] * s * siluf_(zv[q][d0]);
                const float vn = __shfl_xor(v, 1);
                if ((r32 & 1) == 0) *(unsigned*)(mixed + (size_t)rw * DM + col) = cvtpk(v, vn); } }
        asm volatile("" ::: "memory");
    }
}
#undef KSWZ
#undef SBAR
#undef LDSBAR
}

namespace s5 {
typedef float f32x16 __attribute__((ext_vector_type(16)));
typedef float f32x2 __attribute__((ext_vector_type(2)));
constexpr int KT_ELEMS = 65 * 256, KT_BYTES = KT_ELEMS * 2, PF_ELEMS = 131072;
constexpr int UCOL = 2064, XCOL = 272, SROW = 129;
constexpr int L_U = 0, L_KT = 32 * UCOL, L_S = L_KT + KT_BYTES, L_XB = L_S + 32 * SROW * 4, L_CARRY = L_XB + 32 * XCOL, L_END = L_CARRY + 512;
static_assert(L_END <= 147456 && (L_KT % 16) == 0 && (L_S % 16) == 0 && (L_XB % 16) == 0, "s5 lds map");

__device__ __forceinline__ void tables_task(const Params& P, LAS unsigned char* lds, const int l, const int g, const int part) {
    const int tid = otid();
    LAS f32x2* pw = (LAS f32x2*)lds;
    LAS f32x2* fz = (LAS f32x2*)(lds + 65 * 64 * 8);
    __syncthreads();
    if (tid < 64) {
        const int p = tid;
        const double dt = exp((double)P.in[23][l * 64 + g]);
        const double ar = P.in[16][l * 4096 + g * 64 + p], ai = P.in[17][l * 4096 + g * 64 + p];
        const double mag = exp(dt * ar);
        double sn, cs; dsincos(dt * ai, sn, cs);
        const double abr = mag * cs, abi = mag * sn;
        const double nr = abr - 1.0, ni = abi, den = ar * ar + ai * ai;
        fz[p] = (f32x2){(float)((nr * ar + ni * ai) / den), (float)((ni * ar - nr * ai) / den)};
        double pr = 1.0, pi = 0.0;
        for (int n = 0; n <= 64; ++n) { pw[n * 64 + p] = (f32x2){(float)pr, (float)pi}; const double t = pr * abr - pi * abi; pi = pr * abi + pi * abr; pr = t; }
        if (part == 0) ((f32x2*)(P.ws + WS_S5AL))[(l * 64 + g) * 64 + p] = pw[64 * 64 + p];
    }
    __syncthreads();
    LAS float* bre = (LAS float*)(lds + 65 * 64 * 8 + 512);
    LAS float* bim = bre + 1024;
    LAS float* cre = bim + 1024;
    LAS float* cim = cre + 1024;
    { const float* gb = P.in[18] + (size_t)l * 65536 + g * 1024; const float* gbi = P.in[19] + (size_t)l * 65536 + g * 1024;
      const float* gc = P.in[20] + (size_t)l * 65536 + g * 1024; const float* gci = P.in[21] + (size_t)l * 65536 + g * 1024;
      for (int i = tid; i < 1024; i += 512) { bre[i] = gb[i]; bim[i] = gbi[i]; cre[i] = gc[i]; cim[i] = gci[i]; } }
    __syncthreads();
    bf16* P1 = (bf16*)(P.ws + WS_S5P1) + (size_t)(l * 64 + g) * PF_ELEMS;
    bf16* P2 = (bf16*)(P.ws + WS_S5P2) + (size_t)(l * 64 + g) * PF_ELEMS;
    bf16* KT = (bf16*)(P.ws + WS_S5K) + (size_t)(l * 64 + g) * KT_ELEMS;
    if (part == 0) for (int fl = tid; fl < 16384; fl += 512) {
        const int lane = fl & 63, ks = (fl >> 6) & 63, mb = fl >> 12;
        const int row = 32 * mb + (lane & 31), p = row & 63, isim = row >> 6, c0 = 8 * (lane >> 5);
        const f32x2 w = pw[(63 - ks) * 64 + p], f = fz[p];
        const float zr = w.x * f.x - w.y * f.y, zi = w.x * f.y + w.y * f.x;
        float v[8];
#pragma unroll
        for (int j = 0; j < 8; ++j) { const float br = bre[p * 16 + c0 + j], bi = bim[p * 16 + c0 + j]; v[j] = isim ? (zr * bi + zi * br) : (zr * br - zi * bi); }
        u32x4 o; o.x = pg8::cvt_pk_bf16(v[0], v[1]); o.y = pg8::cvt_pk_bf16(v[2], v[3]); o.z = pg8::cvt_pk_bf16(v[4], v[5]); o.w = pg8::cvt_pk_bf16(v[6], v[7]);
        *(u32x4*)(P1 + (size_t)fl * 8) = o;
    }
    if (part == 1) for (int fl = tid; fl < 16384; fl += 512) {
        const int lane = fl & 63, ks = (fl >> 6) & 7, rb = fl >> 9;
        const int r = lane & 31, t = 2 * rb + (r >> 4), c = r & 15, kk0 = 16 * ks + 8 * (lane >> 5);
        float v[8];
#pragma unroll
        for (int j = 0; j < 8; ++j) { const int kk = kk0 + j, p = kk & 63; const f32x2 w = pw[(t + 1) * 64 + p];
            const float cr = cre[c * 64 + p], ci = cim[c * 64 + p];
            v[j] = (kk >> 6) ? -(cr * w.y + ci * w.x) : (cr * w.x - ci * w.y); }
        u32x4 o; o.x = pg8::cvt_pk_bf16(v[0], v[1]); o.y = pg8::cvt_pk_bf16(v[2], v[3]); o.z = pg8::cvt_pk_bf16(v[4], v[5]); o.w = pg8::cvt_pk_bf16(v[6], v[7]);
        *(u32x4*)(P2 + (size_t)fl * 8) = o;
    }
    if (part >= 2) for (int pr_ = (part - 2) * 512 + tid; pr_ < (part - 1) * 512; pr_ += 512) {
        const int tau = pr_ >> 4, c = pr_ & 15;
        float acc[16];
#pragma unroll
        for (int j = 0; j < 16; ++j) acc[j] = 0.f;
        for (int p = 0; p < 64; ++p) {
            const f32x2 w = pw[tau * 64 + p], f = fz[p];
            const float zr = w.x * f.x - w.y * f.y, zi = w.x * f.y + w.y * f.x;
            const float cr = cre[c * 64 + p], ci = cim[c * 64 + p];
            const float czr = cr * zr - ci * zi, czi = cr * zi + ci * zr;
#pragma unroll
            for (int q = 0; q < 4; ++q) { const f32x4 br4 = *(const LAS f32x4*)(bre + p * 16 + 4 * q), bi4 = *(const LAS f32x4*)(bim + p * 16 + 4 * q);
#pragma unroll
                for (int e = 0; e < 4; ++e) acc[4 * q + e] += czr * br4[e] - czi * bi4[e]; }
        }
        u32x4 o0, o1; o0.x = pg8::cvt_pk_bf16(acc[0], acc[1]); o0.y = pg8::cvt_pk_bf16(acc[2], acc[3]); o0.z = pg8::cvt_pk_bf16(acc[4], acc[5]); o0.w = pg8::cvt_pk_bf16(acc[6], acc[7]);
        o1.x = pg8::cvt_pk_bf16(acc[8], acc[9]); o1.y = pg8::cvt_pk_bf16(acc[10], acc[11]); o1.z = pg8::cvt_pk_bf16(acc[12], acc[13]); o1.w = pg8::cvt_pk_bf16(acc[14], acc[15]);
        u32x4* dst = (u32x4*)(KT + (size_t)(tau + 1) * 256 + c * 16); dst[0] = o0; dst[1] = o1;
    }
    if (part == 2 && tid < 32) ((u32x4*)KT)[tid] = (u32x4){0u, 0u, 0u, 0u};
}

__device__ __forceinline__ void unit(const Params& P, LAS unsigned char* lds, const int l, const int b, const int g) {
    const int tid = otid(), wid = __builtin_amdgcn_readfirstlane(tid >> 6), lane = tid & 63, n32 = lane & 31, hi = lane >> 5;
    const bf16* KT = (const bf16*)(P.ws + WS_S5K) + (size_t)(l * 64 + g) * KT_ELEMS;
    const bf16x8* P1 = (const bf16x8*)((const bf16*)(P.ws + WS_S5P1) + (size_t)(l * 64 + g) * PF_ELEMS);
    const bf16x8* P2 = (const bf16x8*)((const bf16*)(P.ws + WS_S5P2) + (size_t)(l * 64 + g) * PF_ELEMS);
    const f32x2* AL = (const f32x2*)(P.ws + WS_S5AL) + (l * 64 + g) * 64;
    const bf16* ub = (const bf16*)(P.out + SUG_OFF) + (size_t)(b * 64 + g) * SEQ * 16;
    bf16* yb = (bf16*)(P.ws + WS_Y5) + (size_t)b * SEQ * 1024 + g * 16;
    const float* dsk = P.in[22] + l * 1024 + g * 16;
    LAS float* Sl = (LAS float*)(lds + L_S);
    LAS float* car = (LAS float*)(lds + L_CARRY);
    __syncthreads();
    { u32x4 kt[5];
#pragma unroll
      for (int it = 0; it < 5; ++it) { const int i = tid + 512 * it; if (i < KT_BYTES / 16) kt[it] = ((const u32x4*)KT)[i]; }
      __builtin_amdgcn_sched_barrier(0);
#pragma unroll
      for (int it = 0; it < 5; ++it) { const int i = tid + 512 * it; if (i < KT_BYTES / 16) ((LAS u32x4*)(lds + L_KT))[i] = kt[it]; } }
    const f32x4 dvA = *(const f32x4*)(dsk + 4 * hi), dvB = *(const f32x4*)(dsk + 8 + 4 * hi);
    if (tid < 128) car[tid] = 0.f;
    u32x4 ua0[4], ua1[4];
#define S5_LOADU(hh_) do { _Pragma("unroll") for (int it = 0; it < 4; ++it) { const int rr = tid + 512 * it, n = rr >> 6, s = rr & 63; \
        const u32x4* src = (const u32x4*)(ub + (size_t)((32 * (hh_) + n) * 64 + s) * 16); ua0[it] = src[0]; ua1[it] = src[1]; } } while (0)
    S5_LOADU(0);
    for (int hh = 0; hh < 2; ++hh) {
        __builtin_amdgcn_sched_barrier(0);
#pragma unroll
        for (int it = 0; it < 4; ++it) { const int rr = tid + 512 * it, n = rr >> 6, s = rr & 63;
            *(LAS u32x4*)(lds + L_U + n * UCOL + s * 32) = ua0[it]; *(LAS u32x4*)(lds + L_U + n * UCOL + s * 32 + 16) = ua1[it]; }
        __syncthreads();
        {
            const int mb = wid & 3, kh = wid >> 2;
            f32x16 acc0 = f32x16{}, acc1 = f32x16{};
            const bf16x8* pa = P1 + (size_t)(mb * 64 + kh * 32) * 64 + lane;
            LAS const unsigned char* ua = lds + L_U + n32 * UCOL + hi * 16 + kh * 32 * 32;
#pragma unroll 1
            for (int kb = 0; kb < 4; ++kb) {
                const bf16x8* qa = pa + 4 * 64;
                bf16x8 fa[8];
#pragma unroll
                for (int i = 0; i < 4; ++i) { fa[i] = pa[i * 64]; fa[4 + i] = qa[i * 64]; }
                __builtin_amdgcn_sched_barrier(0);
#pragma unroll
                for (int i = 0; i < 8; i += 2) {
                    acc0 = __builtin_amdgcn_mfma_f32_32x32x16_bf16(fa[i], *(LAS const bf16x8*)(ua + i * 32), acc0, 0, 0, 0);
                    acc1 = __builtin_amdgcn_mfma_f32_32x32x16_bf16(fa[i + 1], *(LAS const bf16x8*)(ua + (i + 1) * 32), acc1, 0, 0, 0); }
                __builtin_amdgcn_sched_barrier(0);
                pa += 8 * 64; ua += 8 * 32;
            }
            acc0 += acc1;
            if (kh == 1) {
#pragma unroll
                for (int r = 0; r < 16; ++r) Sl[n32 * SROW + 32 * mb + (r & 3) + 8 * (r >> 2) + 4 * hi] = acc0[r];
            }
            __syncthreads();
            if (kh == 0) {
#pragma unroll
                for (int r = 0; r < 16; ++r) Sl[n32 * SROW + 32 * mb + (r & 3) + 8 * (r >> 2) + 4 * hi] += acc0[r];
            }
        }
        __syncthreads();
        if (tid < 64) {
            const int p = tid; const f32x2 al = AL[p];
            float xr = car[p], xi = car[64 + p];
            float sre[32], sim[32];
#pragma unroll
            for (int n = 0; n < 32; ++n) { sre[n] = Sl[n * SROW + p]; sim[n] = Sl[n * SROW + 64 + p]; }
#pragma unroll
            for (int n = 0; n < 32; ++n) {
                *(LAS bf16*)(lds + L_XB + n * XCOL + p * 2) = (bf16)f2bf(xr); *(LAS bf16*)(lds + L_XB + n * XCOL + (64 + p) * 2) = (bf16)f2bf(xi);
                const float nx = al.x * xr - al.y * xi + sre[n], ni = al.x * xi + al.y * xr + sim[n]; xr = nx; xi = ni; }
            car[p] = xr; car[64 + p] = xi;
        }
        __syncthreads();
        if (hh == 0) { S5_LOADU(1); __builtin_amdgcn_sched_barrier(0); }
        for (int q4 = 0; q4 < 4; ++q4) {
            const int rb = (q4 == 0) ? wid : (q4 == 1) ? 15 - wid : (q4 == 2) ? 16 + wid : 31 - wid;
            const int t0 = 2 * rb;
            f32x16 acc = f32x16{};
            bf16x8 pf[8];
            { const bf16x8* p2 = P2 + (size_t)(rb * 8) * 64 + lane;
#pragma unroll
              for (int ks = 0; ks < 8; ++ks) pf[ks] = p2[ks * 64]; }
            LAS const unsigned char* ka = lds + L_KT + (t0 + 1) * 512 + n32 * 32 + hi * 16;
            LAS const unsigned char* ua = lds + L_U + n32 * UCOL + hi * 16;
            f32x16 acc2 = f32x16{};
#pragma unroll 4
            for (int s0 = 0; s0 <= t0 + 1; s0 += 2) {
                acc = __builtin_amdgcn_mfma_f32_32x32x16_bf16(*(LAS const bf16x8*)(ka - s0 * 512), *(LAS const bf16x8*)(ua + s0 * 32), acc, 0, 0, 0);
                acc2 = __builtin_amdgcn_mfma_f32_32x32x16_bf16(*(LAS const bf16x8*)(ka - (s0 + 1) * 512), *(LAS const bf16x8*)(ua + (s0 + 1) * 32), acc2, 0, 0, 0); }
            LAS const unsigned char* xa = lds + L_XB + n32 * XCOL + hi * 16;
#pragma unroll
            for (int ks = 0; ks < 8; ks += 2) {
                acc = __builtin_amdgcn_mfma_f32_32x32x16_bf16(pf[ks], *(LAS const bf16x8*)(xa + ks * 32), acc, 0, 0, 0);
                acc2 = __builtin_amdgcn_mfma_f32_32x32x16_bf16(pf[ks + 1], *(LAS const bf16x8*)(xa + (ks + 1) * 32), acc2, 0, 0, 0); }
            acc += acc2;
#pragma unroll
            for (int tt = 0; tt < 2; ++tt) {
                const int t = t0 + tt;
                u32x2 wv[2];
#pragma unroll
                for (int p = 0; p < 2; ++p) { const int r4 = 2 * tt + p, c0 = 8 * p + 4 * hi;
                    const u32x2 uw = *(LAS const u32x2*)(lds + L_U + n32 * UCOL + t * 32 + c0 * 2);
                    const f32x4 dv = p ? dvB : dvA;
                    const float u0 = __uint_as_float(uw.x << 16), u1 = __uint_as_float(uw.x & 0xffff0000u), u2 = __uint_as_float(uw.y << 16), u3 = __uint_as_float(uw.y & 0xffff0000u);
                    const float y0 = geluf_(acc[4 * r4 + 0] + dv[0] * u0), y1 = geluf_(acc[4 * r4 + 1] + dv[1] * u1);
                    const float y2 = geluf_(acc[4 * r4 + 2] + dv[2] * u2), y3 = geluf_(acc[4 * r4 + 3] + dv[3] * u3);
                    wv[p].x = pk2(y0, y1); wv[p].y = pk2(y2, y3); }
                const auto rx = __builtin_amdgcn_permlane32_swap(wv[0].x, wv[1].x, false, false);
                const auto ry = __builtin_amdgcn_permlane32_swap(wv[0].y, wv[1].y, false, false);
                u32x4 w16; w16.x = rx[0]; w16.y = ry[0]; w16.z = rx[1]; w16.w = ry[1];
                st16_wt(yb + (size_t)((32 * hh + n32) * 64 + t) * 1024 + 8 * hi, w16);
            }
        }
        asm volatile("s_waitcnt lgkmcnt(0)" ::: "memory"); __builtin_amdgcn_s_barrier(); asm volatile("" ::: "memory");
    }
#undef S5_LOADU
}
}

namespace a1 {
typedef float f32x16 __attribute__((ext_vector_type(16)));
__device__ __forceinline__ void norm_task(const Params& P, LAS unsigned char* lds, const int l, const int blk, const int vec) {
    const int tid = otid(), wid = __builtin_amdgcn_readfirstlane(tid >> 6), lane = tid & 63;
    int off; const float* nw;
    if (vec < 4) { off = O_MQ + vec * 128; nw = P.in[4]; }
    else if (vec < 8) { off = O_MK + (vec - 4) * 128; nw = P.in[5]; }
    else if (vec < 12) { off = O_NQ + (vec - 8) * 128; nw = P.in[6]; }
    else if (vec == 12) { off = O_KS; nw = P.in[8]; }
    else { off = O_KW; nw = P.in[9]; }
    nw += l * 128;
    const float2* cs = (const float2*)(P.ws + WS_ROPE);
    bf16* base = (bf16*)(P.ws + WS_PROJ) + (size_t)(blk * 256 + wid * 32) * NP + off;
    const int pos0 = (blk * 256 + wid * 32) % SEQ;
    const float wa = nw[lane], wb = nw[lane + 64];
    float sa = 0.f, sb = 0.f;
#pragma unroll 4
    for (int i = 0; i < 32; ++i) {
        bf16* v = base + (size_t)i * NP;
        float a = bf2f(v[lane]), b = bf2f(v[lane + 64]);
        const float ss = wave_sum(a * a + b * b);
        const float r = 1.0f / sqrtf(ss * (1.0f / 128.0f) + EPSN);
        a = a * r * wa; b = b * r * wb;
        const float other = __shfl_xor(a, 16);
        if (lane < 32) { const float2 c = cs[(pos0 + i) * 16 + (lane & 15)]; a = (lane < 16) ? (a * c.x - other * c.y) : (a * c.x + other * c.y); }
        v[lane] = (bf16)f2bf(a); v[lane + 64] = (bf16)f2bf(b);
        sa += a; sb += b;
    }
    if (vec >= 4 && vec < 8) {
        LAS float* red = (LAS float*)lds;
        red[wid * 128 + lane] = sa; red[wid * 128 + lane + 64] = sb;
        __syncthreads();
        if (tid < 128) { float s = 0.f;
#pragma unroll
            for (int w = 0; w < 8; ++w) s += red[w * 128 + tid];
            const int b = blk >> 4, n = blk & 15, h = vec - 4;
            ((float*)(P.ws + WS_KMEAN))[((size_t)(b * 4 + h) * 16 + n) * 128 + tid] = s * (1.0f / 256.0f); }
    }
}
__device__ __forceinline__ void gates_task(const Params& P, LAS unsigned char* lds, const int l, const int task) {
    const int tid = otid(), wid = __builtin_amdgcn_readfirstlane(tid >> 6), lane = tid & 63, r32 = lane & 31, hi = lane >> 5;
    const bf16* xb = (const bf16*)(P.ws + WS_XB) + (size_t)(task * 64 + r32) * DM + wid * 256 + 8 * hi;
    const bf16x8* wf = (const bf16x8*)(P.ws + WS_WGF) + ((size_t)l * 128 + wid * 16) * 64 + lane;
    f32x16 acc0 = f32x16{}, acc1 = f32x16{};
#pragma unroll 1
    for (int kb = 0; kb < 2; ++kb) {
        bf16x8 a0[8], a1[8], bw[8];
        const bf16* xq = xb + (size_t)32 * DM;
#pragma unroll
        for (int k = 0; k < 8; ++k) { a0[k] = *(const bf16x8*)(xb + 16 * k); a1[k] = *(const bf16x8*)(xq + 16 * k); bw[k] = wf[k * 64]; }
        __builtin_amdgcn_sched_barrier(0);
#pragma unroll
        for (int k = 0; k < 8; ++k) { acc0 = __builtin_amdgcn_mfma_f32_32x32x16_bf16(a0[k], bw[k], acc0, 0, 0, 0); acc1 = __builtin_amdgcn_mfma_f32_32x32x16_bf16(a1[k], bw[k], acc1, 0, 0, 0); }
        __builtin_amdgcn_sched_barrier(0);
        xb += 128; wf += 8 * 64;
    }
    LAS float* red = (LAS float*)lds;
    LAS float* rsl = red + 8 * 64 * 12;
    if (r32 < 12) {
#pragma unroll
        for (int r = 0; r < 16; ++r) { const int rw = (r & 3) + 8 * (r >> 2) + 4 * hi;
            red[(wid * 64 + rw) * 12 + r32] = acc0[r]; red[(wid * 64 + 32 + rw) * 12 + r32] = acc1[r]; }
    }
    if (tid < 64) rsl[tid] = ((const float*)(P.ws + WS_RS))[task * 64 + tid];
    __syncthreads();
    for (int i = tid; i < 64 * 12; i += 512) { float s = 0.f;
#pragma unroll
        for (int w = 0; w < 8; ++w) s += red[w * 768 + i];
        __hip_atomic_store((unsigned*)(P.ws + WS_GATES) + (size_t)task * 768 + i, __float_as_uint(sigmoidf_(s * rsl[i / 12])), __ATOMIC_RELAXED, __HIP_MEMORY_SCOPE_AGENT); }
}
__device__ __forceinline__ void cmp_task(const Params& P, LAS unsigned char* lds, const int l, const int which, const int b, const int nb) {
    const int tid = otid(), wid = __builtin_amdgcn_readfirstlane(tid >> 6), lane = tid & 63, r32 = lane & 31, hi = lane >> 5;
    const int n0 = 32 * nb, cb = wid & 3, kh = wid >> 2;
    LAS float* red = (LAS float*)lds;
    LAS bf16* hid = (LAS bf16*)(lds + 4 * 32 * 33 * 4);
    LAS float* ot = (LAS float*)(lds + 4 * 32 * 33 * 4 + 32 * 136 * 2);
    {
        const int n = min(n0 + r32, NCMP - 1);
        const bf16* tokbase = (const bf16*)(P.ws + WS_PROJ) + (size_t)(b * SEQ + 16 * n) * NP + (which ? O_VC : O_KC) + 8 * hi;
        const bf16x8* wf = (const bf16x8*)(P.ws + WS_W1F) + ((size_t)((l * 2 + which) * 4 + cb) * 256 + kh * 128) * 64 + lane;
        const bf16* tok = tokbase + (size_t)(kh * 16) * NP;
        f32x16 acc = f32x16{}, acc2 = f32x16{};
#pragma unroll 1
        for (int t = 0; t < 16; ++t) {
            bf16x8 A[8], Bf[8];
            const bf16x8* wq = wf + 4 * 64;
#pragma unroll
            for (int k = 0; k < 4; ++k) { A[k] = *(const bf16x8*)(tok + k * 16); A[4 + k] = *(const bf16x8*)(tok + (4 + k) * 16); Bf[k] = wf[k * 64]; Bf[4 + k] = wq[k * 64]; }
            __builtin_amdgcn_sched_barrier(0);
#pragma unroll
            for (int k = 0; k < 8; k += 2) { acc = __builtin_amdgcn_mfma_f32_32x32x16_bf16(A[k], Bf[k], acc, 0, 0, 0); acc2 = __builtin_amdgcn_mfma_f32_32x32x16_bf16(A[k + 1], Bf[k + 1], acc2, 0, 0, 0); }
            __builtin_amdgcn_sched_barrier(0);
            tok += NP; wf += 8 * 64;
        }
        acc += acc2;
        if (kh == 1) {
#pragma unroll
            for (int r = 0; r < 16; ++r) red[(cb * 32 + (r & 3) + 8 * (r >> 2) + 4 * hi) * 33 + r32] = acc[r];
        }
        __syncthreads();
        if (kh == 0) { float cst = 0.f;
            { const float* cp = (const float*)(P.ws + WS_CST) + (size_t)((l * 2 + which) * 64) * 128 + cb * 32 + r32;
#pragma unroll 1
              for (int s0 = 0; s0 < 64; s0 += 16) {
                  float cv[16];
#pragma unroll
                  for (int i = 0; i < 16; ++i) cv[i] = cp[i * 128];
                  __builtin_amdgcn_sched_barrier(0);
#pragma unroll
                  for (int i = 0; i < 16; ++i) cst += cv[i];
                  __builtin_amdgcn_sched_barrier(0);
                  cp += 16 * 128; } }
#pragma unroll
            for (int r = 0; r < 16; ++r) { const int rw = (r & 3) + 8 * (r >> 2) + 4 * hi;
                hid[rw * 136 + cb * 32 + r32] = (bf16)f2bf(geluf_(acc[r] + red[(cb * 32 + rw) * 33 + r32] + cst)); } }
        __syncthreads();
    }
    if (wid < 4) {
        const bf16x8* w2f = (const bf16x8*)(P.ws + WS_W2F) + ((size_t)((l * 2 + which) * 4 + wid) * 8) * 64 + lane;
        f32x16 acc = f32x16{};
        bf16x8 wb[8];
#pragma unroll
        for (int ks = 0; ks < 8; ++ks) wb[ks] = w2f[ks * 64];
        __builtin_amdgcn_sched_barrier(0);
#pragma unroll
        for (int ks = 0; ks < 8; ++ks) acc = __builtin_amdgcn_mfma_f32_32x32x16_bf16(*(const LAS bf16x8*)(hid + r32 * 136 + 16 * ks + 8 * hi), wb[ks], acc, 0, 0, 0);
#pragma unroll
        for (int r = 0; r < 16; ++r) ot[((r & 3) + 8 * (r >> 2) + 4 * hi) * 132 + wid * 32 + r32] = acc[r];
    }
    __syncthreads();
    {
        const int r = tid >> 4, jg = tid & 15, j2 = jg * 8;
        float o[8];
        { const f32x4 oa = *(const LAS f32x4*)(ot + r * 132 + j2), ob = *(const LAS f32x4*)(ot + r * 132 + j2 + 4);
#pragma unroll
          for (int e = 0; e < 4; ++e) { o[e] = oa[e]; o[4 + e] = ob[e]; } }
        const int n = n0 + r;
        if (which == 0) {
            float ss = 0.f;
#pragma unroll
            for (int e = 0; e < 8; ++e) ss += o[e] * o[e];
            ss += __shfl_xor(ss, 1); ss += __shfl_xor(ss, 2); ss += __shfl_xor(ss, 4); ss += __shfl_xor(ss, 8);
            const float rs = 1.0f / sqrtf(ss * (1.0f / 128.0f) + EPSN);
            const float* kcn = P.in[7] + l * 128 + j2;
            const float2* cs = (const float2*)(P.ws + WS_ROPE) + (size_t)min(16 * n + 31, SEQ - 1) * 16 + (jg & 1) * 8;
#pragma unroll
            for (int e = 0; e < 8; ++e) { o[e] = o[e] * rs * kcn[e];
                const float other = __shfl_xor(o[e], 2);
                if (jg < 4) { const float2 c = cs[e]; o[e] = (jg < 2) ? (o[e] * c.x - other * c.y) : (o[e] * c.x + other * c.y); } }
        }
        u32x4 w; w.x = pk2(o[0], o[1]); w.y = pk2(o[2], o[3]); w.z = pk2(o[4], o[5]); w.w = pk2(o[6], o[7]);
        if (n >= NCMP) w = (u32x4){0u, 0u, 0u, 0u};
        { bf16* dst = (bf16*)(P.ws + WS_CMPB) + ((size_t)(which * NB + b) * 256 + n) * 128 + j2;
          st16_wt(dst, w); }
    }
}
__device__ __forceinline__ void prep_w1(const Params& P, LAS unsigned char* lds) {
    const int tid = otid();
    const int gt = blockIdx.x * 512 + tid, GT = gridDim.x * 512;
    for (int fl = gt; fl < NL * 2 * 65536; fl += GT) {
        const int lw = fl >> 16, rem = fl & 65535, lane = rem & 63, ks = (rem >> 6) & 255, cb = rem >> 14;
        const float* w1 = P.in[(lw & 1) ? 14 : 12] + (size_t)(lw >> 1) * 4096 * 128;
        const float* src = w1 + (size_t)(16 * ks + 8 * (lane >> 5)) * 128 + 32 * cb + (lane & 31);
        u32x4 o; o.x = pk2(src[0], src[128]); o.y = pk2(src[256], src[384]); o.z = pk2(src[512], src[640]); o.w = pk2(src[768], src[896]);
        *(u32x4*)((bf16*)(P.ws + WS_W1F) + (size_t)fl * 8) = o;
    }
    for (int fl = gt; fl < NL * 2 * 4 * 8 * 64; fl += GT) {
        const int lw = fl >> 11, cb = (fl >> 9) & 3, ks = (fl >> 6) & 7, lane = fl & 63;
        const float* w2 = P.in[(lw & 1) ? 15 : 13] + (size_t)(lw >> 1) * 16384 + (size_t)(16 * ks + 8 * (lane >> 5)) * 128 + 32 * cb + (lane & 31);
        u32x4 o; o.x = pk2(w2[0], w2[128]); o.y = pk2(w2[256], w2[384]); o.z = pk2(w2[512], w2[640]); o.w = pk2(w2[768], w2[896]);
        *(u32x4*)((bf16*)(P.ws + WS_W2F) + (size_t)fl * 8) = o;
    }
    for (int fl = gt; fl < NL * 128 * 64; fl += GT) {
        const int l = fl >> 13, ks = (fl >> 6) & 127, lane = fl & 63, n = lane & 31, k0 = 16 * ks + 8 * (lane >> 5);
        float v[8];
#pragma unroll
        for (int e = 0; e < 8; ++e) v[e] = (n < 12) ? P.in[1][l * DM + k0 + e] * P.in[2][(size_t)l * DM * INW + (size_t)(k0 + e) * INW + SRC_NG + n] : 0.f;
        u32x4 o; o.x = pk2(v[0], v[1]); o.y = pk2(v[2], v[3]); o.z = pk2(v[4], v[5]); o.w = pk2(v[6], v[7]);
        *(u32x4*)((bf16*)(P.ws + WS_WGF) + (size_t)fl * 8) = o;
    }
    for (int t = blockIdx.x; t < NL * 2 * 64; t += gridDim.x) {
        const int lw = t >> 6, sl = t & 63;
        const float* w1 = P.in[(lw & 1) ? 14 : 12] + (size_t)(lw >> 1) * 4096 * 128;
        const float* pe = P.in[(lw & 1) ? 11 : 10] + (size_t)(lw >> 1) * 4096;
        const int j = tid & 127, kq = tid >> 7;
        float s = 0.f;
#pragma unroll
        for (int i = 0; i < 16; ++i) { const int k = sl * 64 + kq * 16 + i; s += pe[k] * w1[(size_t)k * 128 + j]; }
        LAS float* red = (LAS float*)lds;
        __syncthreads();
        red[tid] = s;
        __syncthreads();
        if (tid < 128) ((float*)(P.ws + WS_CST))[(size_t)t * 128 + tid] = (red[tid] + red[128 + tid]) + (red[256 + tid] + red[384 + tid]);
    }
}
}

__device__ __forceinline__ void unit_done(unsigned* cnt) {
    asm volatile("s_waitcnt vmcnt(0)" ::: "memory");
    __syncthreads();
    if (otid() == 0) { __builtin_amdgcn_fence(__ATOMIC_RELEASE, "agent"); asm volatile("s_waitcnt vmcnt(0)" ::: "memory");
        __hip_atomic_fetch_add(cnt, 1u, __ATOMIC_RELAXED, __HIP_MEMORY_SCOPE_AGENT); }
}
__device__ __forceinline__ void unit_done_wt(unsigned* cnt) {
    asm volatile("s_waitcnt vmcnt(0)" ::: "memory");
    __syncthreads();
    if (otid() == 0) __hip_atomic_fetch_add(cnt, 1u, __ATOMIC_RELAXED, __HIP_MEMORY_SCOPE_AGENT);
}
__device__ __forceinline__ void unit_wait(unsigned* cnt, unsigned target) {
    if (otid() == 0) { unsigned sp = 0u;
        while (__hip_atomic_load(cnt, __ATOMIC_RELAXED, __HIP_MEMORY_SCOPE_AGENT) < target) { __builtin_amdgcn_s_sleep(4); if (++sp > (1u << 22)) break; }
        __builtin_amdgcn_fence(__ATOMIC_ACQUIRE, "agent"); asm volatile("s_waitcnt vmcnt(0)" ::: "memory"); }
    __syncthreads();
}
struct OneUnit { int pm, pn; __device__ __forceinline__ bool next(int i, pg8::Unit& u) const { if (i != 0) return false; u.pm = pm; u.pn = pn; return true; } };

__device__ __forceinline__ void phase_mid(const Params& P, LAS unsigned char* lds, int l) {
    unsigned* ctl = (unsigned*)(P.ws + WS_CTL) + 64 * 8 * l;
    const int* order = (const int*)(P.ws + WS_ORDER);
    LAS int* slot = (LAS int*)(lds + LDS_BYTES - 64);
    bool small_ok = false; unsigned s5_ok = 0u;
    for (;;) {
        asm volatile("s_waitcnt lgkmcnt(0)" ::: "memory"); __builtin_amdgcn_s_barrier(); asm volatile("" ::: "memory");
        if (otid() == 0) slot[0] = (int)__hip_atomic_fetch_add(ctl, 1u, __ATOMIC_RELAXED, __HIP_MEMORY_SCOPE_AGENT);
        asm volatile("s_waitcnt lgkmcnt(0)" ::: "memory"); __builtin_amdgcn_s_barrier(); asm volatile("" ::: "memory");
        const int u = slot[0];
        if (u >= 1344) break;
        if (u < 64) { a1::cmp_task(P, lds, l, u >> 5, (u >> 3) & 3, u & 7); unit_done_wt(ctl + 64); }
        else if (u < 320) { a1::gates_task(P, lds, l, u - 64); unit_done_wt(ctl + 64); }
        else if (u < 576) { const int v = u - 320; s5::unit(P, lds, l, v >> 6, v & 63); unit_done_wt(ctl + 128 + 64 * (v >> 6)); }
        else if (u < 1088) { const int id = order[u - 576];
            if (id < 256) { if (!small_ok) { unit_wait(ctl + 64, 320u); small_ok = true; } att::nsa_unit(P, lds, id >> 6, id & 63); }
            else { const int v = id - 256; att::moba_unit(P, lds, v >> 6, (v >> 4) & 3, v & 15); } }
        else { const int t = u - 1088, pm = t >> 2, b = pm >> 4;
            if (!((s5_ok >> b) & 1u)) { unit_wait(ctl + 128 + 64 * b, 64u); s5_ok |= 1u << b; }
            pg8::Gemm g{(const bf16*)(P.ws + WS_Y5), (const bf16*)(P.ws + WS_GLU + l * GLU_BYTES), NT, 1024, 1024, 1024};
            OneUnit S{pm, t & 3};
            EpiGlu E{(bf16*)(P.ws + WS_MIXED), (const bf16*)(P.ws + WS_Y5), (const bf16*)(P.ws + WS_PROJ)};
            pg8::gemm_phase<EpiGlu, OneUnit>(lds, g, S, E); }
    }
}

#define XB_TMO      128
#define XB_XCNT(j)  (256  + 64 * (j))
#define XB_XSUB(j)  (1280 + 64 * (j))
#define XB_XGEN(j)  (2304 + 64 * (j))
#define XB_TOP      3328
#define XB_TOPGEN   3392
#define XCD_BAR_WORDS 3456
#define XB_SPIN_CAP (1u << 18)
__device__ __forceinline__ unsigned xb_ld(unsigned* p)              { return __hip_atomic_load(p, __ATOMIC_RELAXED, __HIP_MEMORY_SCOPE_AGENT); }
__device__ __forceinline__ unsigned xb_add(unsigned* p, unsigned v) { return __hip_atomic_fetch_add(p, v, __ATOMIC_RELAXED, __HIP_MEMORY_SCOPE_AGENT); }
__device__ __forceinline__ unsigned xb_xcc_id() { return (unsigned)__builtin_amdgcn_s_getreg((3 << 11) | 20) & 0xFu; }
#define XB_SPIN(cond, bar) do { unsigned _sp = 0; while (cond) { __builtin_amdgcn_s_sleep(1); \
    if ((++_sp & 255u) == 0u) { if (xb_ld(&(bar)[XB_TMO])) break; if (_sp > XB_SPIN_CAP) { atomicAdd(&(bar)[XB_TMO], 1u); break; } } } } while (0)
struct XcdBarrier { unsigned* bar; unsigned x; volatile LAS unsigned* st; };
__device__ __forceinline__ XcdBarrier xcd_barrier_post(unsigned* bar, volatile LAS unsigned* st) {
    XcdBarrier b; b.bar = bar; b.x = xb_xcc_id(); b.st = st;
    if (threadIdx.x == 0) (void)xb_add(&bar[XB_XCNT(b.x)], 1u);
    return b;
}
__device__ __forceinline__ void xcd_barrier_complete(unsigned* bar, unsigned x, unsigned& nloc, unsigned& nx) {
    const unsigned G = gridDim.x * gridDim.y * gridDim.z;
    const unsigned lane = (unsigned)otid() & 63u;
    unsigned sum, cnt, mine, sp = 0u;
    for (;;) {
        const unsigned c = (lane < 16u) ? xb_ld(&bar[XB_XCNT(lane)]) : 0u;
        sum = c;
#pragma unroll
        for (int o = 1; o < 16; o <<= 1) sum += __shfl_xor(sum, o);
        sum = __shfl(sum, 0);
        cnt = (unsigned)__popcll(__ballot(c > 0u));
        mine = __shfl(c, (int)x);
        if (sum == G) break;
        __builtin_amdgcn_s_sleep(1);
        if ((++sp & 255u) == 0u) { if (xb_ld(&bar[XB_TMO])) break; if (sp > XB_SPIN_CAP) { if (lane == 0u) atomicAdd(&bar[XB_TMO], 1u); break; } }
    }
    nloc = mine > 0u ? mine : 1u; nx = cnt > 0u ? cnt : 1u;
}
__device__ __forceinline__ void xcd_barrier(const XcdBarrier& b) {
    asm volatile("s_waitcnt vmcnt(0)" ::: "memory");
    __syncthreads();
    if (threadIdx.x < 64 && b.st[0] == 0u) {
        unsigned nloc0, nx0; xcd_barrier_complete(b.bar, b.x, nloc0, nx0);
        if (threadIdx.x == 0) { b.st[0] = nloc0; b.st[1] = nx0; }
        asm volatile("s_waitcnt lgkmcnt(0)" ::: "memory");
    }
    if (threadIdx.x == 0) {
        unsigned* bar = b.bar;
        __builtin_amdgcn_s_waitcnt(0);
        unsigned nloc = b.st[0], nx = b.st[1];
        const unsigned old = xb_add(&bar[XB_XSUB(b.x)], 1u);
        const unsigned gen = old / nloc;
        if (old + 1u == (gen + 1u) * nloc) {
            __builtin_amdgcn_fence(__ATOMIC_RELEASE, "agent");
            asm volatile("s_waitcnt vmcnt(0)" ::: "memory");
            const unsigned og = xb_add(&bar[XB_TOP], 1u);
            const unsigned tg = og / nx;
            if (og + 1u == (tg + 1u) * nx) xb_add(&bar[XB_TOPGEN], 1u);
            else XB_SPIN(xb_ld(&bar[XB_TOPGEN]) == tg, bar);
            xb_add(&bar[XB_XGEN(b.x)], 1u);
            __builtin_amdgcn_fence(__ATOMIC_ACQUIRE, "agent");
            asm volatile("s_waitcnt vmcnt(0)" ::: "memory");
        } else {
            XB_SPIN(xb_ld(&bar[XB_XGEN(b.x)]) == gen, bar);
            __builtin_amdgcn_fence(__ATOMIC_ACQUIRE, "agent");
            asm volatile("s_waitcnt vmcnt(0)" ::: "memory");
        }
    }
    __syncthreads();
}

__global__ void __launch_bounds__(512, 2) k_mega(Params P) {
    extern __shared__ __attribute__((aligned(16))) unsigned char lds_raw[];
    LAS unsigned char* lds = (LAS unsigned char*)lds_raw;
    const int lo = P.ph_lo, hi = P.ph_hi;
#define IN(k) (lo <= (k) && (k) < hi)
    volatile LAS unsigned* bst = (volatile LAS unsigned*)(lds + LDS_BYTES - 32);
    if (threadIdx.x < 2) bst[threadIdx.x] = 0u;
    __syncthreads();
    const XcdBarrier bar = xcd_barrier_post((unsigned*)(P.ws + WS_CTL) + 4096, bst);
#define SEAM(k) do { if (IN(k) && IN((k) + 1)) xcd_barrier(bar); } while (0)
    if (IN(0)) phase_prep(P, lds);
    SEAM(0);
    for (int l = 0; l < NL; ++l) {
        if (IN(1 + 3 * l)) phase_gemm1(P, lds, l);
        SEAM(1 + 3 * l);
        if (IN(2 + 3 * l)) phase_mid(P, lds, l);
        SEAM(2 + 3 * l);
        if (IN(3 + 3 * l)) phase_out(P, lds, l);
        SEAM(3 + 3 * l);
    }
#undef SEAM
#undef IN
}

extern "C" void kernel_launch(void* const* d_in, const int* in_sizes, int n_in, void* d_out, int out_size, void* d_ws, size_t ws_size, hipStream_t stream) {
    static int grid = 0;
    if (grid == 0) {
        if (ws_size < WS_END) { fprintf(stderr, "kernel_launch: workspace too small (%zu < %zu)\n", ws_size, (size_t)WS_END); grid = -1; return; }
        int dev = 0, cus = 0;
        hipGetDevice(&dev); hipDeviceGetAttribute(&cus, hipDeviceAttributeMultiprocessorCount, dev);
        hipFuncSetAttribute((const void*)k_mega, hipFuncAttributeMaxDynamicSharedMemorySize, LDS_BYTES);
        int per_cu = 0;
        hipOccupancyMaxActiveBlocksPerMultiprocessor(&per_cu, (const void*)k_mega, 512, LDS_BYTES);
        if (per_cu < 1) { fprintf(stderr, "kernel_launch: occupancy query says %d blocks per CU\n", per_cu); per_cu = 1; }
        grid = (cus > 0 ? cus : 256) * 1;
    }
    if (grid < 0) return;
    unsigned char* ws = (unsigned char*)d_ws;
    Params P{};
    for (int i = 0; i < 25; ++i) P.in[i] = (const float*)d_in[i];
    P.out = (float*)d_out; P.ws = ws;
    hipMemsetAsync(ws + WS_CTL, 0, 32768, stream);
    P.ph_lo = 0; P.ph_hi = 7;
    void* args[] = {&P};
    hipError_t e = hipLaunchCooperativeKernel((const void*)k_mega, dim3(grid), dim3(512), args, LDS_BYTES, stream);
    if (e != hipSuccess) fprintf(stderr, "kernel_launch: cooperative launch failed: %s (grid %d)\n", hipGetErrorString(e), grid);
}
```
